# Optimizing an MI355X kernel written in HIP

```python
import jax, jax.numpy as jnp
from jax import lax
import numpy as np

D_MODEL = 1024
BATCH = 16
SEQ = 2048
DEPTH = 2

EPS = 1e-6
N_BRANCH = 3
BRANCH_WIDTH = D_MODEL // 2
GLA_HEADS = 4
GLA_DV = BRANCH_WIDTH // GLA_HEADS
GLA_DK = GLA_DV // 2
GLA_RANK = 16
GLA_TAU = 16.0
GLA_CHUNK = 16
GLA_QK = GLA_HEADS * GLA_DK
GLA_V = GLA_HEADS * GLA_DV
SC_WIDTH = BRANCH_WIDTH
CONV_K = 3
DIL_PATTERNS = ((128, 1), (512, 4), (2048, 16))
DIL_GROUPS = len(DIL_PATTERNS)
DIL_HEADS = 4
DIL_HD = BRANCH_WIDTH // DIL_HEADS
DIL_W = DIL_GROUPS * DIL_HEADS * DIL_HD
DIL_BLOCK = 128
ROPE_THETA = 10000.0
D_FF = 2816

IN_SIZES = (GLA_QK, GLA_QK, GLA_V, GLA_V, GLA_RANK,
            SC_WIDTH, SC_WIDTH, SC_WIDTH,
            DIL_W, DIL_W, DIL_W)
IN_COLS = sum(IN_SIZES)

kernel_name = "hybrid_gated_gla_shortconv_dilated_attn"


def rmsnorm(x, g):
    xf = x.astype(jnp.float32)
    r = lax.rsqrt(jnp.mean(xf * xf, axis=-1, keepdims=True) + EPS)
    return (xf * r).astype(x.dtype) * g


def causal_dwconv(u, w):
    K = w.shape[0]
    S = u.shape[1]
    up = jnp.pad(u, ((0, 0), (K - 1, 0), (0, 0)))
    y = w[0] * up[:, 0:S]
    for k in range(1, K):
        y = y + w[k] * up[:, k:k + S]
    return y


def rope(x, pos):
    hd = x.shape[-1]
    inv = ROPE_THETA ** (-jnp.arange(0, hd, 2, dtype=jnp.float32) / hd)
    ang = pos.astype(jnp.float32)[..., None] * inv
    cos = jnp.cos(ang)[:, :, None, None, :]
    sin = jnp.sin(ang)[:, :, None, None, :]
    xf = x.astype(jnp.float32)
    x1, x2 = xf[..., :hd // 2], xf[..., hd // 2:]
    return jnp.concatenate([x1 * cos - x2 * sin, x2 * cos + x1 * sin], axis=-1).astype(x.dtype)


def gla_branch(q, k, v, g, a_low, w_a_up, b_a, norm_g):
    B, S, _ = q.shape
    H, C = GLA_HEADS, GLA_CHUNK
    N = S // C
    f32 = jnp.float32
    loga = jax.nn.log_sigmoid((a_low.astype(f32) @ w_a_up.astype(f32)) + b_a.astype(f32)) / GLA_TAU

    def chunks(t, d):
        return t.astype(f32).reshape(B, N, C, H, d).transpose(0, 3, 1, 2, 4)

    qc = chunks(q, GLA_DK) * (GLA_DK ** -0.5)
    kc = chunks(k, GLA_DK)
    vc = chunks(v, GLA_DV)
    lc = jnp.cumsum(chunks(loga, GLA_DK), axis=3)

    causal = jnp.tril(jnp.ones((C, C), dtype=bool))
    rel = lc[..., :, None, :] - lc[..., None, :, :]
    decay = jnp.exp(jnp.where(causal[:, :, None], rel, -jnp.inf))
    scores = jnp.einsum('bhnid,bhnjd,bhnijd->bhnij', qc, kc, decay)
    o_intra = jnp.einsum('bhnij,bhnje->bhnie', scores, vc)

    lend = lc[..., -1:, :]
    q_in = qc * jnp.exp(lc)
    k_in = kc * jnp.exp(lend - lc)
    dec_chunk = jnp.exp(lend[..., 0, :])

    def step(state, xs):
        qn, kn, vn, dn = xs
        o = jnp.einsum('bhid,bhde->bhie', qn, state)
        state = state * dn[..., None] + jnp.einsum('bhjd,bhje->bhde', kn, vn)
        return state, o

    xs = (jnp.moveaxis(q_in, 2, 0), jnp.moveaxis(k_in, 2, 0),
          jnp.moveaxis(vc, 2, 0), jnp.moveaxis(dec_chunk, 2, 0))
    s0 = jnp.zeros((B, H, GLA_DK, GLA_DV), f32)
    _, o_inter = lax.scan(step, s0, xs)
    o = o_intra + jnp.moveaxis(o_inter, 0, 2)
    o = o.transpose(0, 2, 3, 1, 4).reshape(B, S, H, GLA_DV).astype(v.dtype)
    o = rmsnorm(o, norm_g).reshape(B, S, GLA_V)
    return o * jax.nn.silu(g)


def strided_window_attn(q, k, v, span, dil):
    B, S, H, D = q.shape
    L = S // dil
    BLK = DIL_BLOCK
    nb = -(-L // BLK)
    Lp = nb * BLK

    def to_sub(t):
        return t.reshape(B, L, dil, H, D).transpose(0, 2, 3, 1, 4)

    qs, ks, vs = to_sub(q), to_sub(k), to_sub(v)
    qb = jnp.pad(qs, ((0, 0), (0, 0), (0, 0), (0, Lp - L), (0, 0))).reshape(B, dil, H, nb, BLK, D)

    def kv_blocks(t):
        tp = jnp.pad(t, ((0, 0), (0, 0), (0, 0), (BLK, Lp - L), (0, 0)))
        prev = tp[:, :, :, :Lp].reshape(B, dil, H, nb, BLK, D)
        cur = tp[:, :, :, BLK:].reshape(B, dil, H, nb, BLK, D)
        return jnp.concatenate([prev, cur], axis=4)

    kb, vb = kv_blocks(ks), kv_blocks(vs)
    i = jnp.arange(BLK)[:, None]
    m = jnp.arange(2 * BLK)[None, :]
    blk = jnp.arange(nb)[:, None, None]
    dist = i + BLK - m
    key_idx = (blk - 1) * BLK + m
    valid = (dist >= 0) & (dist <= span) & (key_idx >= 0)

    s = jnp.einsum('brhnid,brhnmd->brhnim', qb, kb).astype(jnp.float32) * (D ** -0.5)
    s = jnp.where(valid, s, -jnp.inf)
    mx = jnp.max(s, axis=-1, keepdims=True)
    p = jnp.exp(s - mx)
    den = jnp.sum(p, axis=-1, keepdims=True)
    o = jnp.einsum('brhnim,brhnmd->brhnid', p, vb.astype(jnp.float32)) / den
    lse = (mx + jnp.log(den))[..., 0]

    o = o.reshape(B, dil, H, Lp, D)[:, :, :, :L].transpose(0, 3, 1, 2, 4).reshape(B, S, H, D)
    lse = lse.reshape(B, dil, H, Lp)[:, :, :, :L].transpose(0, 3, 1, 2).reshape(B, S, H)
    return o, lse


def dilated_branch(dq, dk, dv, pos):
    B, S, _ = dq.shape
    shp = (B, S, DIL_GROUPS, DIL_HEADS, DIL_HD)
    q = rope(dq.reshape(shp), pos)
    k = rope(dk.reshape(shp), pos)
    v = dv.reshape(shp)
    outs, lses = [], []
    for gi, (win, dil) in enumerate(DIL_PATTERNS):
        o, lse = strided_window_attn(q[:, :, gi], k[:, :, gi], v[:, :, gi], win // dil, dil)
        outs.append(o)
        lses.append(lse)
    w = jax.nn.softmax(jnp.stack(lses, axis=0), axis=0)
    o = jnp.sum(w[..., None] * jnp.stack(outs, axis=0), axis=0)
    return o.reshape(B, S, DIL_HEADS * DIL_HD).astype(dq.dtype)


def setup_inputs(seed: int = 0) -> dict:
    key = jax.random.key(seed)
    ks = jax.random.split(key, 24)
    f32 = jnp.float32

    def nrm(k, shape, scale):
        return jax.random.normal(k, shape, f32) * scale

    def gain(k, shape):
        return 1.0 + 0.02 * jax.random.normal(k, shape, f32)

    x = jax.random.normal(ks[0], (BATCH, SEQ, D_MODEL), f32)
    offset = jax.random.randint(ks[1], (BATCH, 1), 0, 4096, dtype=jnp.int32)
    positions = (offset + jnp.arange(SEQ, dtype=jnp.int32)[None, :]).astype(jnp.int32)
    return {
        "x": x,
        "positions": positions,
        "w_in": nrm(ks[2], (DEPTH, D_MODEL, IN_COLS), D_MODEL ** -0.5),
        "w_alpha_up": nrm(ks[3], (DEPTH, GLA_RANK, GLA_QK), GLA_RANK ** -0.5),
        "b_alpha": nrm(ks[4], (DEPTH, GLA_QK), 0.1),
        "gla_norm_g": gain(ks[5], (DEPTH, GLA_DV)),
        "sc_conv_w": nrm(ks[6], (DEPTH, CONV_K, SC_WIDTH), CONV_K ** -0.5),
        "w_gate": nrm(ks[7], (DEPTH, D_MODEL, N_BRANCH * D_MODEL), D_MODEL ** -0.5),
        "b_gate": nrm(ks[8], (DEPTH, N_BRANCH * D_MODEL), 0.02),
        "w_branch": nrm(ks[9], (DEPTH, N_BRANCH, BRANCH_WIDTH, D_MODEL), BRANCH_WIDTH ** -0.5),
        "w_mix_out": nrm(ks[10], (DEPTH, D_MODEL, D_MODEL), D_MODEL ** -0.5),
        "pre_mix_g": gain(ks[11], (DEPTH, D_MODEL)),
        "post_mix_g": gain(ks[12], (DEPTH, D_MODEL)),
        "pre_ffn_g": gain(ks[13], (DEPTH, D_MODEL)),
        "post_ffn_g": gain(ks[14], (DEPTH, D_MODEL)),
        "w_ff_gate": nrm(ks[15], (DEPTH, D_MODEL, D_FF), D_MODEL ** -0.5),
        "w_ff_up": nrm(ks[16], (DEPTH, D_MODEL, D_FF), D_MODEL ** -0.5),
        "ff_conv_w": nrm(ks[17], (DEPTH, CONV_K, D_FF), CONV_K ** -0.5),
        "ff_conv_b": nrm(ks[18], (DEPTH, D_FF), 0.02),
        "w_ff_down": nrm(ks[19], (DEPTH, D_FF, D_MODEL), D_FF ** -0.5),
    }


def reference(x, positions, w_in, w_alpha_up, b_alpha, gla_norm_g, sc_conv_w, w_gate, b_gate,
              w_branch, w_mix_out, pre_mix_g, post_mix_g, pre_ffn_g, post_ffn_g,
              w_ff_gate, w_ff_up, ff_conv_w, ff_conv_b, w_ff_down):
    B, S, _ = x.shape
    split_points = np.cumsum(np.array(IN_SIZES))[:-1].tolist()
    for l in range(DEPTH):
        h = rmsnorm(x, pre_mix_g[l])
        z = h @ w_in[l]
        (g_q, g_k, g_v, g_o, a_low, sc_b, sc_c, sc_x,
         d_q, d_k, d_v) = jnp.split(z, split_points, axis=-1)

        y_gla = gla_branch(g_q, g_k, g_v, g_o, a_low, w_alpha_up[l], b_alpha[l], gla_norm_g[l])
        y_sc = sc_b * causal_dwconv(sc_c * sc_x, sc_conv_w[l])
        y_dil = dilated_branch(d_q, d_k, d_v, positions)

        br = jnp.stack([y_gla, y_sc, y_dil], axis=2)
        proj = jnp.einsum('bsgc,gcd->bsgd', br, w_branch[l])
        gates = jax.nn.sigmoid(h @ w_gate[l] + b_gate[l]).reshape(B, S, N_BRANCH, D_MODEL)
        merged = jnp.sum(gates * proj, axis=2)
        x = x + rmsnorm(merged @ w_mix_out[l], post_mix_g[l])

        h = rmsnorm(x, pre_ffn_g[l])
        gt = causal_dwconv(h @ w_ff_gate[l], ff_conv_w[l]) + ff_conv_b[l]
        y = (jax.nn.gelu(gt, approximate=True) * (h @ w_ff_up[l])) @ w_ff_down[l]
        x = x + rmsnorm(y, post_ffn_g[l])
    return x
```

```cpp
#include <hip/hip_runtime.h>
#include <hip/hip_cooperative_groups.h>
#include <cstdint>
#include <cstdio>
namespace cg = cooperative_groups;

#define LAS __attribute__((address_space(3)))
typedef unsigned short bf16_t;
typedef short bf16x8 __attribute__((ext_vector_type(8)));
typedef float f32x4 __attribute__((ext_vector_type(4)));
typedef float f32x2 __attribute__((ext_vector_type(2)));
typedef unsigned u32x4 __attribute__((ext_vector_type(4)));
typedef unsigned u32x2 __attribute__((ext_vector_type(2)));

constexpr int T_ALL = 32768, TH = 16384, DM = 1024, ZC = 7680, GC = 3072, FF = 2816;
constexpr int ZQ = 0, ZK = 256, ZV = 512, ZG = 1024, ZSC = 1536, ZSB = 2048, ZSX = 2560, ZDQ = 3072, ZDK = 4608, ZDV = 6144;
constexpr int IN_COLS = 7696;
constexpr float EPS = 1e-6f;
constexpr int NTHR = 512;
constexpr int LDS_BYTES = 147456;
constexpr int LDS_SLOT = LDS_BYTES - 16;

constexpr size_t WS_CTL = 0;
constexpr size_t WS_BAR = 4096;
constexpr size_t WS_W1 = 32768;
constexpr size_t WS_WBR = WS_W1 + (size_t)10752 * 1024 * 2;
constexpr size_t WS_WMO = WS_WBR + (size_t)3 * 1024 * 512 * 2;
constexpr size_t WS_WFF = WS_WMO + (size_t)1024 * 1024 * 2;
constexpr size_t WS_WD = WS_WFF + (size_t)5632 * 1024 * 2;
constexpr size_t WS_RC = WS_WD + (size_t)1024 * 2816 * 2;
constexpr size_t WS_XS = WS_RC + (size_t)1024 * 1024;
constexpr size_t WS_RS = WS_RC + (size_t)T_ALL * 64 * 4;
constexpr size_t WS_H = WS_RS + (size_t)T_ALL * 64 * 4;
constexpr size_t WS_ALOW = WS_H + (size_t)T_ALL * 1024 * 2;
constexpr size_t WS_LSE = WS_ALOW + (size_t)TH * 16 * 4;
constexpr size_t WS_DSEG = WS_LSE + (size_t)TH * 12 * 4;
constexpr size_t WS_BIG = WS_DSEG + (size_t)256 * 64 * 4;
constexpr size_t WS_Z = WS_BIG;
constexpr size_t WS_GT = WS_Z + (size_t)TH * ZC * 2;
constexpr size_t WS_MG = WS_GT + (size_t)TH * GC * 2;
constexpr size_t WS_END = WS_MG + (size_t)TH * 1024 * 2;
constexpr size_t WS_Y = WS_BIG;
constexpr size_t WS_G = WS_BIG;
constexpr size_t WS_U = WS_BIG + (size_t)T_ALL * FF * 2;
constexpr size_t WS_Y2 = WS_BIG;
constexpr size_t WS_HG = WS_BIG + (size_t)T_ALL * 1024 * 4;
constexpr size_t WS_HU = WS_HG + (size_t)128 * 4 * FF * 4;
static_assert(WS_HU + (size_t)128 * 2 * FF * 4 <= WS_U, "halo fits between Y2 and the activation buffer");
static_assert(WS_U + (size_t)T_ALL * FF * 2 <= WS_END, "ffn overlay");

struct Params {
    const float* x; const int* pos; const float* w_in; const float* w_alpha_up; const float* b_alpha; const float* gla_norm_g; const float* sc_conv_w;
    const float* w_gate; const float* b_gate; const float* w_branch; const float* w_mix_out; const float* pre_mix_g; const float* post_mix_g;
    const float* pre_ffn_g; const float* post_ffn_g; const float* w_ff_gate; const float* w_ff_up; const float* ff_conv_w; const float* ff_conv_b; const float* w_ff_down;
    float* out; unsigned char* ws; int ph_lo, ph_hi;
};

__device__ __forceinline__ int get_tid() { int t = threadIdx.x; asm volatile("" : "+v"(t)); return t; }
__device__ __forceinline__ unsigned cvt_pk_bf16(float lo, float hi) { unsigned r; asm volatile("v_cvt_pk_bf16_f32 %0, %1, %2" : "=v"(r) : "v"(lo), "v"(hi)); return r; }
__device__ __forceinline__ float bflo(unsigned w) { return __uint_as_float(w << 16); }
__device__ __forceinline__ float bfhi(unsigned w) { return __uint_as_float(w & 0xffff0000u); }
__device__ __forceinline__ float bf2f(unsigned short b) { return __uint_as_float(((unsigned)b) << 16); }
__device__ __forceinline__ unsigned short f2bf(float f) { return (unsigned short)(cvt_pk_bf16(f, 0.f) & 0xffffu); }
__device__ __forceinline__ void unpack8(const u32x4 w, float (&f)[8]) { f[0] = bflo(w.x); f[1] = bfhi(w.x); f[2] = bflo(w.y); f[3] = bfhi(w.y); f[4] = bflo(w.z); f[5] = bfhi(w.z); f[6] = bflo(w.w); f[7] = bfhi(w.w); }
__device__ __forceinline__ u32x4 pack8(const float (&f)[8]) { u32x4 w; w.x = cvt_pk_bf16(f[0], f[1]); w.y = cvt_pk_bf16(f[2], f[3]); w.z = cvt_pk_bf16(f[4], f[5]); w.w = cvt_pk_bf16(f[6], f[7]); return w; }
__device__ __forceinline__ bf16x8 as_bf16x8(const u32x4 w) { union { u32x4 u; bf16x8 b; } c; c.u = w; return c.b; }

namespace pg8 {
constexpr int BM = 256, BK = 64, HALF = 128, HTB = HALF * BK * 2, STAGE_BYTES = 8 * HTB, NXCD = 8, WGM = 8;
__device__ __forceinline__ int lds_byte(int r, int c) { const int st = (r >> 4) * 2 + (c >> 5), rr = r & 15, cc = c & 31, ob = rr * 64 + cc * 2; return st * 1024 + (ob ^ (((ob >> 9) & 1) << 5)); }
__device__ __forceinline__ void stage_rc(int b, int& R, int& C) { const int st = b / 1024, sb = b % 1024, swz = sb ^ (((sb >> 9) & 1) << 5); R = (st >> 1) * 16 + swz / 64; C = (st & 1) * 32 + (swz % 64) / 2; }
__device__ __forceinline__ int perm32(int rho) { const int n = rho >> 4, i = rho & 15; return 8 * (i >> 2) + 4 * n + (i & 3); }

struct Unit { int pm, pn, g; };
struct Gemm { const bf16_t* A; const bf16_t* Bt; int lda, ldb, K; size_t gA, gB; };

struct Order {
    int nM, nN, nwg, G, c, ng;
    __device__ void init(int M, int N, int G_, int c_, int ng_) { nM = M / BM; nN = N / BM; nwg = nM * nN; G = G_; c = c_; ng = ng_; }
    __device__ bool next(int i, Unit& u) const {
        const int ti = i / ng; u.g = i - ti * ng;
        const long L = (long)ti * G + c; if (L >= nwg) return false;
        int wgid = (int)L; { const int q = nwg / NXCD, r = nwg % NXCD, xcd = wgid % NXCD, off = wgid / NXCD; wgid = (xcd < r ? xcd * (q + 1) : r * (q + 1) + (xcd - r) * q) + off; }
        const int nig = WGM * nN, gid = wgid / nig, fm = gid * WGM, gsz = (nM - fm) < WGM ? (nM - fm) : WGM;
        u.pm = fm + ((wgid % nig) % gsz); u.pn = (wgid % nig) / gsz; return true;
    }
};

template <class Epi>
__device__ __forceinline__ void gemm_phase(LAS unsigned char* lds, const Gemm g, const Order& S, const Epi& E) {
    const int tid = get_tid(), wid = __builtin_amdgcn_readfirstlane(tid >> 6), lane = tid & 63, wr = wid >> 2, wc = wid & 3, fr = lane & 15, fq = lane >> 4;
    const int K = g.K, nt = K / BK;
    unsigned voffA[2], voffB[2];
#pragma unroll
    for (int i = 0; i < 2; ++i) { int R, C; stage_rc(tid * 16 + i * 8192, R, C); const int Rb = Epi::PERM ? ((R & ~31) + perm32(R & 31)) : R;
        voffA[i] = (unsigned)(R * g.lda + C) * 2u; voffB[i] = (unsigned)(Rb * g.ldb + C) * 2u; }
    const size_t kstep = (size_t)(BK * 2);
    const size_t hstepA = (size_t)HALF * g.lda * 2, hstepB = (size_t)HALF * g.ldb * 2;
    const size_t tstepA = 2 * hstepA, tstepB = 2 * hstepB;
    const unsigned ldsw = (unsigned)wid * 1024u;
    const int aoff = lds_byte(wr * 64 + fr, fq * 8), boff = lds_byte(wc * 32 + fr, fq * 8);
#define PG8_SA(b, h) (((b) * 2 + (h)) * HTB)
#define PG8_SB(b, h) ((4 + (b) * 2 + (h)) * HTB)
#define PG8_STAGE(bufoff, gbase, voff) do { _Pragma("unroll") for (int _i = 0; _i < 2; ++_i) \
        __builtin_amdgcn_global_load_lds((const unsigned*)((const char*)(gbase) + (voff)[_i]), (LAS unsigned*)(lds + (bufoff) + ldsw + _i * 8192), 16, 0, 0); } while (0)
#define PG8_LDA(dst, b, h) do { _Pragma("unroll") for (int m = 0; m < 4; ++m) _Pragma("unroll") for (int k = 0; k < 2; ++k) dst[m][k] = *(const LAS bf16x8*)(lds + PG8_SA(b, h) + aoff + m * 2048 + k * 1024); } while (0)
#define PG8_LDB(dst, b, h) do { _Pragma("unroll") for (int n = 0; n < 2; ++n) _Pragma("unroll") for (int k = 0; k < 2; ++k) dst[n][k] = *(const LAS bf16x8*)(lds + PG8_SB(b, h) + boff + n * 2048 + k * 1024); } while (0)
#define PG8_MMA(ai, bj, At, Bt) do { __builtin_amdgcn_s_setprio(1); _Pragma("unroll") for (int m = 0; m < 4; ++m) _Pragma("unroll") for (int n = 0; n < 2; ++n) _Pragma("unroll") for (int k = 0; k < 2; ++k) \
        acc[ai][bj][m][n] = __builtin_amdgcn_mfma_f32_16x16x32_bf16(Bt[n][k], At[m][k], acc[ai][bj][m][n], 0, 0, 0); __builtin_amdgcn_s_setprio(0); } while (0)
#define PG8_WAIT_V(n) asm volatile("s_waitcnt vmcnt(" #n ")" ::: "memory")
#define PG8_WAIT_L(n) asm volatile("s_waitcnt lgkmcnt(" #n ")" ::: "memory")
#define PG8_BAR __builtin_amdgcn_s_barrier()
#define PG8_SCHED __builtin_amdgcn_sched_barrier(0)
    Unit cur, nxt; int ui = 0;
    if (!S.next(0, cur)) return;
    f32x4 acc[2][2][4][2];
#pragma unroll
    for (int a = 0; a < 2; ++a)
#pragma unroll
        for (int b = 0; b < 2; ++b)
#pragma unroll
            for (int m = 0; m < 4; ++m)
#pragma unroll
                for (int n = 0; n < 2; ++n) acc[a][b][m][n] = (f32x4){0.f, 0.f, 0.f, 0.f};
    bf16x8 At[4][2], B0[2][2], B1[2][2];
    const char* cA = (const char*)(g.A + (size_t)cur.g * g.gA) + (size_t)cur.pm * tstepA; const char* cB = (const char*)(g.Bt + (size_t)cur.g * g.gB) + (size_t)cur.pn * tstepB;
    PG8_STAGE(PG8_SB(0, 0), cB, voffB); PG8_STAGE(PG8_SB(0, 1), cB + hstepB, voffB); PG8_STAGE(PG8_SA(0, 0), cA, voffA); PG8_STAGE(PG8_SA(0, 1), cA + hstepA, voffA);
    if (wr == 1) PG8_BAR;
    PG8_WAIT_V(2); PG8_BAR;
    PG8_STAGE(PG8_SB(1, 0), cB + kstep, voffB); PG8_STAGE(PG8_SA(1, 0), cA + kstep, voffA); PG8_STAGE(PG8_SB(1, 1), cB + hstepB + kstep, voffB);
    PG8_WAIT_V(6); PG8_BAR;
    for (;;) {
        const bool has_next = S.next(ui + 1, nxt);
        const char* nA = has_next ? (const char*)(g.A + (size_t)nxt.g * g.gA) + (size_t)nxt.pm * tstepA : cA; const char* nB = has_next ? (const char*)(g.Bt + (size_t)nxt.g * g.gB) + (size_t)nxt.pn * tstepB : cB;
        for (int t = 0; t < nt; t += 2) {
            const bool last = (t == nt - 2);
            const char* a1 = cA + (size_t)(t + 1) * kstep;
            const char* a2 = last ? nA : cA + (size_t)(t + 2) * kstep; const char* b2 = last ? nB : cB + (size_t)(t + 2) * kstep;
            const char* a3 = a2 + kstep; const char* b3 = b2 + kstep;
            PG8_LDB(B0, 0, 0); PG8_LDB(B1, 0, 1); PG8_SCHED; PG8_LDA(At, 0, 0); PG8_STAGE(PG8_SA(1, 1), a1 + hstepA, voffA);
            PG8_WAIT_V(8); PG8_WAIT_L(0); PG8_BAR; PG8_MMA(0, 0, At, B0); PG8_MMA(0, 1, At, B1); PG8_BAR; PG8_SCHED;
            PG8_LDA(At, 0, 1); PG8_STAGE(PG8_SB(0, 0), b2, voffB); PG8_STAGE(PG8_SB(0, 1), b2 + hstepB, voffB); PG8_STAGE(PG8_SA(0, 0), a2, voffA);
            PG8_WAIT_V(8); PG8_WAIT_L(0); PG8_BAR; PG8_MMA(1, 0, At, B0); PG8_MMA(1, 1, At, B1); PG8_BAR; PG8_SCHED;
            PG8_LDB(B0, 1, 0); PG8_LDB(B1, 1, 1); PG8_SCHED; PG8_LDA(At, 1, 0); PG8_STAGE(PG8_SA(0, 1), a2 + hstepA, voffA);
            PG8_WAIT_V(8); PG8_WAIT_L(0); PG8_BAR; PG8_MMA(0, 0, At, B0); PG8_MMA(0, 1, At, B1); PG8_BAR; PG8_SCHED;
            PG8_LDA(At, 1, 1); PG8_STAGE(PG8_SB(1, 0), b3, voffB); PG8_STAGE(PG8_SB(1, 1), b3 + hstepB, voffB); PG8_STAGE(PG8_SA(1, 0), a3, voffA);
            PG8_WAIT_V(8); PG8_WAIT_L(0); PG8_BAR; PG8_MMA(1, 0, At, B0); PG8_MMA(1, 1, At, B1); PG8_BAR; PG8_SCHED;
        }
        if (wr == 0) PG8_BAR;
        if constexpr (!Epi::AFTER_DRAIN) E(acc, cur, wr, wc, fr, fq);
        if (!has_next) break;
        if constexpr (!Epi::KEEP_ACC) {
#pragma unroll
        for (int a = 0; a < 2; ++a)
#pragma unroll
            for (int b = 0; b < 2; ++b)
#pragma unroll
                for (int m = 0; m < 4; ++m)
#pragma unroll
                    for (int n = 0; n < 2; ++n) acc[a][b][m][n] = (f32x4){0.f, 0.f, 0.f, 0.f};
        }
        cur = nxt; cA = nA; cB = nB; ++ui;
        if (wr == 1) PG8_BAR;
    }
    PG8_WAIT_V(0);
    PG8_BAR;
    if constexpr (Epi::AFTER_DRAIN) E.fused(acc, cur, wr, wc, fr, fq, lds);
#undef PG8_SA
#undef PG8_SB
#undef PG8_STAGE
#undef PG8_LDA
#undef PG8_LDB
#undef PG8_MMA
#undef PG8_WAIT_V
#undef PG8_WAIT_L
#undef PG8_BAR
#undef PG8_SCHED
}

struct EpiF32 {
    static constexpr bool PERM = false, AFTER_DRAIN = false, KEEP_ACC = false;
    float* C; int ldc;
    __device__ __forceinline__ void operator()(const f32x4 (&acc)[2][2][4][2], const Unit& u, int wr, int wc, int fr, int fq) const {
        const int row0 = u.pm * BM + wr * 64 + fr, col0 = u.pn * BM + wc * 32 + 4 * fq;
#pragma unroll
        for (int ai = 0; ai < 2; ++ai)
#pragma unroll
            for (int m = 0; m < 4; ++m) { float* rowp = C + (size_t)(row0 + ai * HALF + m * 16) * ldc + col0;
#pragma unroll
                for (int bj = 0; bj < 2; ++bj)
#pragma unroll
                    for (int n = 0; n < 2; ++n) *(f32x4*)(rowp + bj * HALF + n * 16) = acc[ai][bj][m][n]; }
    }
};
struct EpiSplit {
    static constexpr bool PERM = true, AFTER_DRAIN = false, KEEP_ACC = false;
    bf16_t* O0; int ld0; bf16_t* O1; int ld1; int split; const float* bias1;
    __device__ __forceinline__ void operator()(const f32x4 (&acc)[2][2][4][2], const Unit& u, int wr, int wc, int fr, int fq) const {
        const int row0 = u.pm * BM + wr * 64 + fr;
        const bool second = u.pn >= split;
        bf16_t* base = second ? O1 : O0; const int ld = second ? ld1 : ld0;
        const int col0 = (second ? (u.pn - split) : u.pn) * BM + wc * 32 + 8 * fq;
        const bool sig = second && (bias1 != nullptr);
        f32x4 bv[2][2];
#pragma unroll
        for (int bj = 0; bj < 2; ++bj)
#pragma unroll
            for (int n = 0; n < 2; ++n) bv[bj][n] = sig ? *(const f32x4*)(bias1 + col0 + bj * HALF + 4 * n) : (f32x4){0.f, 0.f, 0.f, 0.f};
#pragma unroll
        for (int ai = 0; ai < 2; ++ai)
#pragma unroll
            for (int m = 0; m < 4; ++m) { bf16_t* rowp = base + (size_t)(row0 + ai * HALF + m * 16) * ld + col0;
#pragma unroll
                for (int bj = 0; bj < 2; ++bj) { f32x4 v0 = acc[ai][bj][m][0] + bv[bj][0], v1 = acc[ai][bj][m][1] + bv[bj][1];
                    if (sig) {
#pragma unroll
                        for (int j = 0; j < 4; ++j) { v0[j] = __builtin_amdgcn_rcpf(1.0f + __expf(-v0[j])); v1[j] = __builtin_amdgcn_rcpf(1.0f + __expf(-v1[j])); } }
                    u32x4 w; w.x = cvt_pk_bf16(v0[0], v0[1]); w.y = cvt_pk_bf16(v0[2], v0[3]); w.z = cvt_pk_bf16(v1[0], v1[1]); w.w = cvt_pk_bf16(v1[2], v1[3]);
                    *(u32x4*)(rowp + bj * HALF) = w; } }
    }
};
struct EpiMerge {
    static constexpr bool PERM = true, AFTER_DRAIN = false, KEEP_ACC = true;
    const bf16_t* GT; bf16_t* MG;
    __device__ __forceinline__ void operator()(f32x4 (&acc)[2][2][4][2], const Unit& u, int wr, int wc, int fr, int fq) const {
        const int row0 = u.pm * BM + wr * 64 + fr, col0 = u.pn * BM + wc * 32 + 8 * fq;
        const bool last = (u.g == 2);
#pragma unroll
        for (int ai = 0; ai < 2; ++ai) {
            u32x4 gw[4][2], gn[4][2];
#pragma unroll
            for (int m = 0; m < 4; ++m)
#pragma unroll
                for (int bj = 0; bj < 2; ++bj) { const size_t row = (size_t)(row0 + ai * HALF + m * 16); const int col = col0 + bj * HALF;
                    gw[m][bj] = *(const u32x4*)(GT + row * GC + u.g * 1024 + col);
                    gn[m][bj] = last ? (u32x4){0x3f803f80u, 0x3f803f80u, 0x3f803f80u, 0x3f803f80u} : *(const u32x4*)(GT + row * GC + (u.g + 1) * 1024 + col); }
#pragma unroll
            for (int m = 0; m < 4; ++m)
#pragma unroll
                for (int bj = 0; bj < 2; ++bj) { const size_t row = (size_t)(row0 + ai * HALF + m * 16); const int col = col0 + bj * HALF;
                    float gf[8], nf[8], v[8]; unpack8(gw[m][bj], gf); unpack8(gn[m][bj], nf);
#pragma unroll
                    for (int j = 0; j < 4; ++j) { v[j] = gf[j] * acc[ai][bj][m][0][j]; v[4 + j] = gf[4 + j] * acc[ai][bj][m][1][j]; }
                    if (last) { *(u32x4*)(MG + row * 1024 + col) = pack8(v); acc[ai][bj][m][0] = (f32x4){0.f, 0.f, 0.f, 0.f}; acc[ai][bj][m][1] = (f32x4){0.f, 0.f, 0.f, 0.f}; }
                    else {
#pragma unroll
                        for (int j = 0; j < 4; ++j) { acc[ai][bj][m][0][j] = v[j] * __builtin_amdgcn_rcpf(fmaxf(nf[j], 1e-30f)); acc[ai][bj][m][1][j] = v[4 + j] * __builtin_amdgcn_rcpf(fmaxf(nf[4 + j], 1e-30f)); } }
                }
        }
    }
};

__device__ __forceinline__ float dpp_row_shr1(float x) { return __int_as_float(__builtin_amdgcn_update_dpp(0, __float_as_int(x), 0x111, 0xf, 0xf, false)); }
__device__ __forceinline__ float dpp_row_shr2(float x) { return __int_as_float(__builtin_amdgcn_update_dpp(0, __float_as_int(x), 0x112, 0xf, 0xf, false)); }
__device__ __forceinline__ float dpp_row_ror1(float x) { return __int_as_float(__builtin_amdgcn_update_dpp(0, __float_as_int(x), 0x121, 0xf, 0xf, false)); }
__device__ __forceinline__ float dpp_row_ror2(float x) { return __int_as_float(__builtin_amdgcn_update_dpp(0, __float_as_int(x), 0x122, 0xf, 0xf, false)); }
__device__ __forceinline__ float gelu_tanh_mul(float gt, float up) {
    const float uu = 0.7978845608028654f * (gt + 0.044715f * gt * gt * gt);
    return gt * __builtin_amdgcn_rcpf(1.0f + __expf(-2.0f * uu)) * up;
}
struct EpiFFN {
    static constexpr bool PERM = true, AFTER_DRAIN = false, KEEP_ACC = false;
    bf16_t* ACT; float* HG; float* HU; const float* cw; const float* cb; LAS unsigned char* xlds;
    __device__ __forceinline__ void operator()(const f32x4 (&acc)[2][2][4][2], const Unit& u, int wr, int wc, int fr, int fq) const {
        const int chl = wc * 32 + 8 * fq, chg = u.pn * 128 + chl;
        LAS float* XG = (LAS float*)xlds;
        if (fr >= 14) {
#pragma unroll
            for (int ai = 0; ai < 2; ++ai) { LAS float* p = XG + ((2 * ai + wr) * 2 + (fr - 14)) * 128 + chl; *(LAS f32x4*)p = acc[ai][0][3][0]; *(LAS f32x4*)(p + 4) = acc[ai][0][3][1]; }
            if (wr == 1) { float* hp = HG + ((size_t)u.pm * 4 + 2 + (fr - 14)) * FF + chg; *(f32x4*)hp = acc[1][0][3][0]; *(f32x4*)(hp + 4) = acc[1][0][3][1]; }
        }
        if (fr < 2 && wr == 0) {
            float* hp = HG + ((size_t)u.pm * 4 + fr) * FF + chg; *(f32x4*)hp = acc[0][0][0][0]; *(f32x4*)(hp + 4) = acc[0][0][0][1];
            float* up = HU + ((size_t)u.pm * 2 + fr) * FF + chg; *(f32x4*)up = acc[0][1][0][0]; *(f32x4*)(up + 4) = acc[0][1][0][1];
        }
        asm volatile("s_waitcnt lgkmcnt(0)" ::: "memory"); __builtin_amdgcn_s_barrier(); asm volatile("" ::: "memory");
        float w0[8], w1[8], w2[8], bb[8];
        { const f32x4 a0 = *(const f32x4*)(cw + chg), a1 = *(const f32x4*)(cw + chg + 4), b0 = *(const f32x4*)(cw + FF + chg), b1 = *(const f32x4*)(cw + FF + chg + 4),
                      c0 = *(const f32x4*)(cw + 2 * FF + chg), c1 = *(const f32x4*)(cw + 2 * FF + chg + 4), d0 = *(const f32x4*)(cb + chg), d1 = *(const f32x4*)(cb + chg + 4);
#pragma unroll
          for (int j = 0; j < 4; ++j) { w0[j] = a0[j]; w0[4 + j] = a1[j]; w1[j] = b0[j]; w1[4 + j] = b1[j]; w2[j] = c0[j]; w2[4 + j] = c1[j]; bb[j] = d0[j]; bb[4 + j] = d1[j]; } }
#pragma unroll
        for (int ai = 0; ai < 2; ++ai)
#pragma unroll
            for (int m = 0; m < 4; ++m) {
                const int B = 2 * ai + wr;
                float g8[8], u8[8], q15[8], q14[8], o[8];
#pragma unroll
                for (int j = 0; j < 4; ++j) { g8[j] = acc[ai][0][m][0][j]; g8[4 + j] = acc[ai][0][m][1][j]; u8[j] = acc[ai][1][m][0][j]; u8[4 + j] = acc[ai][1][m][1][j]; }
                if (m == 0) {
                    if (B > 0) { const LAS float* p = XG + ((B - 1) * 2) * 128 + chl; const f32x4 r0a = *(const LAS f32x4*)p, r0b = *(const LAS f32x4*)(p + 4), r1a = *(const LAS f32x4*)(p + 128), r1b = *(const LAS f32x4*)(p + 132);
#pragma unroll
                        for (int j = 0; j < 4; ++j) { q14[j] = r0a[j]; q14[4 + j] = r0b[j]; q15[j] = r1a[j]; q15[4 + j] = r1b[j]; } }
                    else {
#pragma unroll
                        for (int j = 0; j < 8; ++j) { q14[j] = 0.f; q15[j] = 0.f; } }
#pragma unroll
                    for (int e = 0; e < 8; ++e) { const float s1 = dpp_row_shr1(g8[e]), s2 = dpp_row_shr2(g8[e]);
                        const float p1 = (fr >= 1) ? s1 : q15[e], p2 = (fr >= 2) ? s2 : ((fr == 1) ? q15[e] : q14[e]);
                        o[e] = gelu_tanh_mul(w0[e] * p2 + w1[e] * p1 + w2[e] * g8[e] + bb[e], u8[e]); }
                } else {
#pragma unroll
                    for (int e = 0; e < 8; ++e) { const float pv = (e < 4) ? acc[ai][0][m - 1][0][e & 3] : acc[ai][0][m - 1][1][e & 3];
                        const float s1 = dpp_row_shr1(g8[e]), s2 = dpp_row_shr2(g8[e]), r1 = dpp_row_ror1(pv), r2 = dpp_row_ror2(pv);
                        const float p1 = (fr >= 1) ? s1 : r1, p2 = (fr >= 2) ? s2 : r2;
                        o[e] = gelu_tanh_mul(w0[e] * p2 + w1[e] * p1 + w2[e] * g8[e] + bb[e], u8[e]); }
                }
                const int rloc = 128 * ai + 64 * wr + 16 * m + fr;
                if (!(B == 0 && m == 0 && fr < 2)) *(u32x4*)(ACT + (size_t)(u.pm * BM + rloc) * FF + chg) = pack8(o);
            }
    }
};

struct EpiNormRes {
    static constexpr bool PERM = false, AFTER_DRAIN = true, KEEP_ACC = false;
    const float* xin; float* xout; bf16_t* H2; const float* g1; const float* g2; unsigned* xs1; unsigned* xs2; unsigned* cnt1; unsigned* cnt2;
    __device__ __forceinline__ void exchange(const f32x4 (&v)[2][2][4][2], const Unit& u, int wr, int wc, int fr, int fq, LAS unsigned char* lds, unsigned* xs, unsigned* cnt) const {
        LAS float* Pp = (LAS float*)lds;
        LAS float* S = (LAS float*)(lds + 4096);
        const int tid = get_tid();
#pragma unroll
        for (int ai = 0; ai < 2; ++ai)
#pragma unroll
            for (int m = 0; m < 4; ++m) { float sq = 0.f;
#pragma unroll
                for (int bj = 0; bj < 2; ++bj)
#pragma unroll
                    for (int n = 0; n < 2; ++n) { const f32x4 x = v[ai][bj][m][n]; sq += (x[0] * x[0] + x[1] * x[1]) + (x[2] * x[2] + x[3] * x[3]); }
                sq += __shfl_xor(sq, 16); sq += __shfl_xor(sq, 32);
                if (fq == 0) Pp[(ai * HALF + wr * 64 + m * 16 + fr) * 4 + wc] = sq; }
        asm volatile("s_waitcnt lgkmcnt(0)" ::: "memory"); __builtin_amdgcn_s_barrier(); asm volatile("" ::: "memory");
        if (tid < 256) { const f32x4 p = *(const LAS f32x4*)(Pp + tid * 4);
            __hip_atomic_store(xs + ((size_t)(u.pm * BM + tid)) * 4 + u.pn, __float_as_uint((p[0] + p[1]) + (p[2] + p[3])), __ATOMIC_RELAXED, __HIP_MEMORY_SCOPE_AGENT); }
        asm volatile("s_waitcnt vmcnt(0)" ::: "memory");
        __syncthreads();
        if (tid == 0) {
            __hip_atomic_fetch_add(cnt + u.pm * 4, 1u, __ATOMIC_RELAXED, __HIP_MEMORY_SCOPE_AGENT);
            unsigned sp = 0u;
            while (__hip_atomic_load(cnt + u.pm * 4, __ATOMIC_RELAXED, __HIP_MEMORY_SCOPE_AGENT) < 4u) { __builtin_amdgcn_s_sleep(1); if (++sp > (1u << 22)) break; }
            __builtin_amdgcn_fence(__ATOMIC_ACQUIRE, "agent");
            asm volatile("s_waitcnt vmcnt(0)" ::: "memory");
        }
        __syncthreads();
        if (tid < 256) { const unsigned* q = xs + ((size_t)(u.pm * BM + tid)) * 4; float t = 0.f;
#pragma unroll
            for (int k = 0; k < 4; ++k) t += __uint_as_float(__hip_atomic_load(q + k, __ATOMIC_RELAXED, __HIP_MEMORY_SCOPE_AGENT));
            S[tid] = rsqrtf(t * (1.0f / 1024.0f) + EPS); }
        asm volatile("s_waitcnt lgkmcnt(0)" ::: "memory"); __syncthreads();
    }
    __device__ __forceinline__ void fused(f32x4 (&acc)[2][2][4][2], const Unit& u, int wr, int wc, int fr, int fq, LAS unsigned char* lds) const {
        const LAS float* S = (const LAS float*)(lds + 4096);
        const int col0 = u.pn * BM + wc * 32 + 4 * fq;
        exchange(acc, u, wr, wc, fr, fq, lds, xs1, cnt1);
        {
            f32x4 gv[2][2];
#pragma unroll
            for (int bj = 0; bj < 2; ++bj)
#pragma unroll
                for (int n = 0; n < 2; ++n) gv[bj][n] = *(const f32x4*)(g1 + col0 + bj * HALF + n * 16);
#pragma unroll
            for (int ai = 0; ai < 2; ++ai) {
                f32x4 xv[4][2][2];
#pragma unroll
                for (int m = 0; m < 4; ++m)
#pragma unroll
                    for (int bj = 0; bj < 2; ++bj)
#pragma unroll
                        for (int n = 0; n < 2; ++n) xv[m][bj][n] = *(const f32x4*)(xin + (size_t)(u.pm * BM + ai * HALF + wr * 64 + m * 16 + fr) * DM + col0 + bj * HALF + n * 16);
#pragma unroll
                for (int m = 0; m < 4; ++m) { const int r = ai * HALF + wr * 64 + m * 16 + fr; const float r1 = S[r];
#pragma unroll
                    for (int bj = 0; bj < 2; ++bj)
#pragma unroll
                        for (int n = 0; n < 2; ++n) { acc[ai][bj][m][n] = xv[m][bj][n] + acc[ai][bj][m][n] * r1 * gv[bj][n];
                            *(f32x4*)(xout + (size_t)(u.pm * BM + r) * DM + col0 + bj * HALF + n * 16) = acc[ai][bj][m][n]; } }
            }
        }
        asm volatile("s_waitcnt lgkmcnt(0)" ::: "memory"); __syncthreads();
        exchange(acc, u, wr, wc, fr, fq, lds, xs2, cnt2);
        {
            f32x4 gv[2][2];
#pragma unroll
            for (int bj = 0; bj < 2; ++bj)
#pragma unroll
                for (int n = 0; n < 2; ++n) gv[bj][n] = *(const f32x4*)(g2 + col0 + bj * HALF + n * 16);
#pragma unroll
            for (int ai = 0; ai < 2; ++ai)
#pragma unroll
                for (int m = 0; m < 4; ++m) { const int r = ai * HALF + wr * 64 + m * 16 + fr; const float r2 = S[r];
#pragma unroll
                    for (int bj = 0; bj < 2; ++bj)
#pragma unroll
                        for (int n = 0; n < 2; ++n) { const f32x4 h = acc[ai][bj][m][n] * r2 * gv[bj][n]; u32x2 w; w.x = cvt_pk_bf16(h[0], h[1]); w.y = cvt_pk_bf16(h[2], h[3]);
                            *(u32x2*)(H2 + (size_t)(u.pm * BM + r) * DM + col0 + bj * HALF + n * 16) = w; } }
        }
        asm volatile("s_waitcnt lgkmcnt(0)" ::: "memory"); __syncthreads();
    }
    __device__ __forceinline__ void operator()(const f32x4 (&)[2][2][4][2], const Unit&, int, int, int, int) const {}
};
}

__device__ __forceinline__ void transpose_tile(const float* src, int ld, int k0, int n0s, bf16_t* dst, int dk, int n0d, LAS float* tile) {
    const int tid = get_tid();
    { const int r = tid >> 4, c4 = (tid & 15) * 4;
#pragma unroll
      for (int i = 0; i < 2; ++i) { const f32x4 v = *(const f32x4*)(src + (size_t)(k0 + r + 32 * i) * ld + n0s + c4);
          LAS float* t = tile + (r + 32 * i) * 65 + c4; t[0] = v[0]; t[1] = v[1]; t[2] = v[2]; t[3] = v[3]; } }
    __syncthreads();
    { const int n = tid >> 3, ks = (tid & 7) * 8; float e[8];
#pragma unroll
      for (int j = 0; j < 8; ++j) e[j] = tile[(ks + j) * 65 + n];
      *(u32x4*)(dst + (size_t)(n0d + n) * dk + k0 + ks) = pack8(e); }
    __syncthreads();
}

__device__ void phase_convert(const Params& P, int l, LAS unsigned char* lds) {
    LAS float* tile = (LAS float*)lds;
    unsigned char* ws = P.ws;
    bf16_t* W1 = (bf16_t*)(ws + WS_W1); bf16_t* WBR = (bf16_t*)(ws + WS_WBR); bf16_t* WMO = (bf16_t*)(ws + WS_WMO); bf16_t* WFF = (bf16_t*)(ws + WS_WFF); bf16_t* WD = (bf16_t*)(ws + WS_WD);
    const float* win = P.w_in + (size_t)l * 1024 * IN_COLS;
#define SEG(src, ld, ktiles, ntiles, n0s, dst, dk, n0d) if (r < (ktiles) * (ntiles)) { const int kt = r / (ntiles), ntl = r % (ntiles); transpose_tile(src, ld, kt * 64, (n0s) + ntl * 64, dst, dk, (n0d) + ntl * 64, tile); continue; } r -= (ktiles) * (ntiles);
    constexpr int total = 16 * 120 + 16 * 48 + 3 * 8 * 16 + 16 * 16 + 16 * 44 + 16 * 44 + 44 * 16;
    for (int it = blockIdx.x; it < total; it += gridDim.x) {
        int r = it;
        SEG(win, IN_COLS, 16, 8, 0, W1, 1024, ZQ)
        SEG(win, IN_COLS, 16, 8, 512, W1, 1024, ZV)
        SEG(win, IN_COLS, 16, 8, 1024, W1, 1024, ZG)
        SEG(win, IN_COLS, 16, 8, 1552, W1, 1024, ZSB)
        SEG(win, IN_COLS, 16, 8, 2064, W1, 1024, ZSC)
        SEG(win, IN_COLS, 16, 8, 2576, W1, 1024, ZSX)
        SEG(win, IN_COLS, 16, 72, 3088, W1, 1024, ZDQ)
        SEG(P.w_gate + (size_t)l * 1024 * 3072, 3072, 16, 48, 0, W1, 1024, 7680)
        SEG(P.w_branch + ((size_t)l * 3 + 0) * 512 * 1024, 1024, 8, 16, 0, WBR, 512, 0)
        SEG(P.w_branch + ((size_t)l * 3 + 1) * 512 * 1024, 1024, 8, 16, 0, WBR + (size_t)1024 * 512, 512, 0)
        SEG(P.w_branch + ((size_t)l * 3 + 2) * 512 * 1024, 1024, 8, 16, 0, WBR + (size_t)2 * 1024 * 512, 512, 0)
        SEG(P.w_mix_out + (size_t)l * 1024 * 1024, 1024, 16, 16, 0, WMO, 1024, 0)
        if (r < 16 * 44) { const int kt = r / 44, ntl = r % 44; transpose_tile(P.w_ff_gate + (size_t)l * 1024 * FF, FF, kt * 64, ntl * 64, WFF, 1024, 256 * (ntl >> 1) + 64 * (ntl & 1), tile); continue; } r -= 16 * 44;
        if (r < 16 * 44) { const int kt = r / 44, ntl = r % 44; transpose_tile(P.w_ff_up + (size_t)l * 1024 * FF, FF, kt * 64, ntl * 64, WFF, 1024, 256 * (ntl >> 1) + 128 + 64 * (ntl & 1), tile); continue; } r -= 16 * 44;
        SEG(P.w_ff_down + (size_t)l * FF * 1024, 1024, 44, 16, 0, WD, FF, 0)
    }
#undef SEG
    { const int t = get_tid();
      if (l == 0 && blockIdx.x == 0 && t < 64) ((float*)(ws + WS_RC))[t] = exp2f(-(float)t * (13.287712379549449f / 64.0f)); }
}

__device__ __forceinline__ float wave_sum(float v) {
#pragma unroll
    for (int o = 32; o >= 1; o >>= 1) v += __shfl_xor(v, o);
    return v;
}

__device__ void phase_norm_alow(const Params& P, int l, int half, LAS unsigned char* lds) {
    const int tid = get_tid(), lane = tid & 63, wave = tid >> 6;
    LAS float* WaT = (LAS float*)lds;
    const float* win = P.w_in + (size_t)l * 1024 * IN_COLS + 1536;
    for (int i = tid; i < 1024 * 4; i += NTHR) { const int k = i >> 2, c4 = (i & 3) * 4; const f32x4 v = *(const f32x4*)(win + (size_t)k * IN_COLS + c4);
        WaT[(c4 + 0) * 1024 + k] = v[0]; WaT[(c4 + 1) * 1024 + k] = v[1]; WaT[(c4 + 2) * 1024 + k] = v[2]; WaT[(c4 + 3) * 1024 + k] = v[3]; }
    __syncthreads();
    const float* xs = (l == 0 ? P.x : P.out) + (size_t)half * TH * DM;
    const float* gg = P.pre_mix_g + (size_t)l * DM;
    bf16_t* H = (bf16_t*)(P.ws + WS_H) + (size_t)half * TH * DM; float* AL = (float*)(P.ws + WS_ALOW);
    f32x4 gv[4];
#pragma unroll
    for (int i = 0; i < 4; ++i) gv[i] = *(const f32x4*)(gg + i * 256 + lane * 4);
    const int rstride = gridDim.x * 8;
    int row = blockIdx.x * 8 + wave;
    f32x4 nv[4];
    if (row < TH) {
#pragma unroll
        for (int i = 0; i < 4; ++i) nv[i] = *(const f32x4*)(xs + (size_t)row * DM + i * 256 + lane * 4);
    }
    for (; row < TH; row += rstride) {
        f32x4 v[4]; float ss = 0.f;
#pragma unroll
        for (int i = 0; i < 4; ++i) { v[i] = nv[i]; ss += v[i][0] * v[i][0] + v[i][1] * v[i][1] + v[i][2] * v[i][2] + v[i][3] * v[i][3]; }
        if (row + rstride < TH) {
#pragma unroll
            for (int i = 0; i < 4; ++i) nv[i] = *(const f32x4*)(xs + (size_t)(row + rstride) * DM + i * 256 + lane * 4);
        }
        ss = wave_sum(ss);
        const float r = rsqrtf(ss * (1.0f / DM) + EPS);
        float a[16];
#pragma unroll
        for (int c = 0; c < 16; ++c) a[c] = 0.f;
#pragma unroll
        for (int i = 0; i < 4; ++i) { f32x4 h = v[i] * r * gv[i];
            u32x2 w; w.x = cvt_pk_bf16(h[0], h[1]); w.y = cvt_pk_bf16(h[2], h[3]);
            *(u32x2*)(H + (size_t)row * DM + i * 256 + lane * 4) = w;
#pragma unroll
            for (int c = 0; c < 16; ++c) { const f32x4 wv = *(const LAS f32x4*)(WaT + c * 1024 + i * 256 + lane * 4); a[c] += h[0] * wv[0] + h[1] * wv[1] + h[2] * wv[2] + h[3] * wv[3]; } }
        float b8[8], b4[4], b2[2], b1;
        { const bool up = (lane & 32) != 0;
#pragma unroll
          for (int c = 0; c < 8; ++c) { const float keep = up ? a[c + 8] : a[c], send = up ? a[c] : a[c + 8]; b8[c] = keep + __shfl_xor(send, 32); } }
        { const bool up = (lane & 16) != 0;
#pragma unroll
          for (int c = 0; c < 4; ++c) { const float keep = up ? b8[c + 4] : b8[c], send = up ? b8[c] : b8[c + 4]; b4[c] = keep + __shfl_xor(send, 16); } }
        { const bool up = (lane & 8) != 0;
#pragma unroll
          for (int c = 0; c < 2; ++c) { const float keep = up ? b4[c + 2] : b4[c], send = up ? b4[c] : b4[c + 2]; b2[c] = keep + __shfl_xor(send, 8); } }
        { const bool up = (lane & 4) != 0; const float keep = up ? b2[1] : b2[0], send = up ? b2[0] : b2[1]; b1 = keep + __shfl_xor(send, 4); }
        b1 += __shfl_xor(b1, 2); b1 += __shfl_xor(b1, 1);
        if ((lane & 3) == 0) { const int co = ((lane >> 5) & 1) * 8 + ((lane >> 4) & 1) * 4 + ((lane >> 3) & 1) * 2 + ((lane >> 2) & 1); AL[(size_t)row * 16 + co] = b1; }
    }
}

__device__ void phase_resid(const float* xin, float* xout, const bf16_t* Y, const float* pg, const float* ng, bf16_t* H2, int nrows) {
    const int tid = get_tid(), lane = tid & 63, wave = tid >> 6;
    f32x4 pgv[4], ngv[4];
#pragma unroll
    for (int i = 0; i < 4; ++i) { pgv[i] = *(const f32x4*)(pg + i * 256 + lane * 4); ngv[i] = ng ? *(const f32x4*)(ng + i * 256 + lane * 4) : (f32x4){0.f, 0.f, 0.f, 0.f}; }
    const int stride = gridDim.x * 8;
    int row = blockIdx.x * 8 + wave;
    u32x2 ny[4]; f32x4 nx[4];
    if (row < nrows) {
#pragma unroll
        for (int i = 0; i < 4; ++i) { ny[i] = *(const u32x2*)(Y + (size_t)row * DM + i * 256 + lane * 4); nx[i] = *(const f32x4*)(xin + (size_t)row * DM + i * 256 + lane * 4); }
    }
    for (; row < nrows; row += stride) {
        f32x4 y[4], xv[4];
#pragma unroll
        for (int i = 0; i < 4; ++i) { y[i] = (f32x4){bflo(ny[i].x), bfhi(ny[i].x), bflo(ny[i].y), bfhi(ny[i].y)}; xv[i] = nx[i]; }
        const int rn = row + stride;
        if (rn < nrows) {
#pragma unroll
            for (int i = 0; i < 4; ++i) { ny[i] = *(const u32x2*)(Y + (size_t)rn * DM + i * 256 + lane * 4); nx[i] = *(const f32x4*)(xin + (size_t)rn * DM + i * 256 + lane * 4); }
        }
        float ss = 0.f;
#pragma unroll
        for (int i = 0; i < 4; ++i) ss += y[i][0] * y[i][0] + y[i][1] * y[i][1] + y[i][2] * y[i][2] + y[i][3] * y[i][3];
        ss = wave_sum(ss);
        const float r = rsqrtf(ss * (1.0f / DM) + EPS);
        float s2 = 0.f;
#pragma unroll
        for (int i = 0; i < 4; ++i) { xv[i] = xv[i] + y[i] * r * pgv[i]; *(f32x4*)(xout + (size_t)row * DM + i * 256 + lane * 4) = xv[i];
            s2 += xv[i][0] * xv[i][0] + xv[i][1] * xv[i][1] + xv[i][2] * xv[i][2] + xv[i][3] * xv[i][3]; }
        if (ng) {
            s2 = wave_sum(s2);
            const float r2 = rsqrtf(s2 * (1.0f / DM) + EPS);
#pragma unroll
            for (int i = 0; i < 4; ++i) { const f32x4 h = xv[i] * r2 * ngv[i]; u32x2 w; w.x = cvt_pk_bf16(h[0], h[1]); w.y = cvt_pk_bf16(h[2], h[3]);
                *(u32x2*)(H2 + (size_t)row * DM + i * 256 + lane * 4) = w; }
        }
    }
}

__device__ void phase_combine(const Params& P) {
    bf16_t* Z = (bf16_t*)(P.ws + WS_Z); const float* LSE = (const float*)(P.ws + WS_LSE);
    const int stride = gridDim.x * NTHR;
    for (int idx0 = blockIdx.x * NTHR + get_tid(); idx0 < TH * 64; idx0 += 2 * stride) {
        float lw[2][3]; u32x4 va[2], vb[2], vc[2]; bf16_t* pp[2]; bool ok[2];
#pragma unroll
        for (int k = 0; k < 2; ++k) { const int idx = idx0 + k * stride; ok[k] = idx < TH * 64; const int id2 = ok[k] ? idx : idx0;
            const int tok = id2 >> 6, c8 = id2 & 63, hh = c8 >> 4, d0 = (c8 & 15) * 8;
            lw[k][0] = LSE[tok * 12 + hh]; lw[k][1] = LSE[tok * 12 + 4 + hh]; lw[k][2] = LSE[tok * 12 + 8 + hh];
            pp[k] = Z + (size_t)tok * ZC + ZDQ + hh * 128 + d0;
            va[k] = *(const u32x4*)pp[k]; vb[k] = *(const u32x4*)(pp[k] + 512); vc[k] = *(const u32x4*)(pp[k] + 1024); }
#pragma unroll
        for (int k = 0; k < 2; ++k) {
            const float mx = fmaxf(lw[k][0], fmaxf(lw[k][1], lw[k][2]));
            float w0 = __expf(lw[k][0] - mx), w1 = __expf(lw[k][1] - mx), w2 = __expf(lw[k][2] - mx);
            const float inv = 1.0f / (w0 + w1 + w2); w0 *= inv; w1 *= inv; w2 *= inv;
            float a[8], b[8], c[8], o[8];
            unpack8(va[k], a); unpack8(vb[k], b); unpack8(vc[k], c);
#pragma unroll
            for (int j = 0; j < 8; ++j) o[j] = w0 * a[j] + w1 * b[j] + w2 * c[j];
            if (ok[k]) *(u32x4*)pp[k] = pack8(o);
        }
    }
}

__device__ void phase_ffn_fix(const Params& P, int l) {
    bf16_t* ACT = (bf16_t*)(P.ws + WS_U); const float* HG = (const float*)(P.ws + WS_HG); const float* HU = (const float*)(P.ws + WS_HU);
    const float* cw = P.ff_conv_w + (size_t)l * 3 * FF; const float* cb = P.ff_conv_b + (size_t)l * FF;
    for (int idx = blockIdx.x * NTHR + get_tid(); idx < 128 * (FF / 8); idx += gridDim.x * NTHR) {
        const int pm = idx / (FF / 8), c0 = (idx % (FF / 8)) * 8;
        float o0[8], o1[8];
#pragma unroll
        for (int hf = 0; hf < 2; ++hf) {
            const int c = c0 + 4 * hf;
            const f32x4 z = (f32x4){0.f, 0.f, 0.f, 0.f};
            const bool first = (pm & 7) == 0;
            const f32x4 gm2 = first ? z : *(const f32x4*)(HG + ((size_t)(pm - 1) * 4 + 2) * FF + c), gm1 = first ? z : *(const f32x4*)(HG + ((size_t)(pm - 1) * 4 + 3) * FF + c);
            const f32x4 g0 = *(const f32x4*)(HG + ((size_t)pm * 4 + 0) * FF + c), g1 = *(const f32x4*)(HG + ((size_t)pm * 4 + 1) * FF + c);
            const f32x4 u0 = *(const f32x4*)(HU + ((size_t)pm * 2 + 0) * FF + c), u1 = *(const f32x4*)(HU + ((size_t)pm * 2 + 1) * FF + c);
            const f32x4 w0 = *(const f32x4*)(cw + c), w1 = *(const f32x4*)(cw + FF + c), w2 = *(const f32x4*)(cw + 2 * FF + c), bb = *(const f32x4*)(cb + c);
#pragma unroll
            for (int j = 0; j < 4; ++j) { o0[4 * hf + j] = pg8::gelu_tanh_mul(w0[j] * gm2[j] + w1[j] * gm1[j] + w2[j] * g0[j] + bb[j], u0[j]);
                                          o1[4 * hf + j] = pg8::gelu_tanh_mul(w0[j] * gm1[j] + w1[j] * g0[j] + w2[j] * g1[j] + bb[j], u1[j]); }
        }
        *(u32x4*)(ACT + (size_t)(pm * 256 + 0) * FF + c0) = pack8(o0);
        *(u32x4*)(ACT + (size_t)(pm * 256 + 1) * FF + c0) = pack8(o1);
    }
}

__device__ __forceinline__ void sc_item(const Params& P, int l, int si) {
    bf16_t* Z = (bf16_t*)(P.ws + WS_Z);
    const int tid = get_tid(), cgi = tid & 63, run = tid >> 6, c0 = cgi * 8, t0 = si * 128 + run * 16;
    const float* cw = P.sc_conv_w + (size_t)l * 3 * 512;
    float w0[8], w1[8], w2[8];
#pragma unroll
    for (int j = 0; j < 8; ++j) { w0[j] = cw[c0 + j]; w1[j] = cw[512 + c0 + j]; w2[j] = cw[1024 + c0 + j]; }
    float p1[8], p2[8];
    if ((t0 & 2047) != 0) {
        float a[8], b[8];
        unpack8(*(const u32x4*)(Z + (size_t)(t0 - 1) * ZC + ZSC + c0), a); unpack8(*(const u32x4*)(Z + (size_t)(t0 - 1) * ZC + ZSX + c0), b);
#pragma unroll
        for (int j = 0; j < 8; ++j) p1[j] = a[j] * b[j];
        unpack8(*(const u32x4*)(Z + (size_t)(t0 - 2) * ZC + ZSC + c0), a); unpack8(*(const u32x4*)(Z + (size_t)(t0 - 2) * ZC + ZSX + c0), b);
#pragma unroll
        for (int j = 0; j < 8; ++j) p2[j] = a[j] * b[j];
    } else {
#pragma unroll
        for (int j = 0; j < 8; ++j) { p1[j] = 0.f; p2[j] = 0.f; } }
    for (int tt = 0; tt < 16; tt += 4) {
        u32x4 va[4], vb[4], vs[4];
#pragma unroll
        for (int k = 0; k < 4; ++k) { const bf16_t* zr = Z + (size_t)(t0 + tt + k) * ZC; va[k] = *(const u32x4*)(zr + ZSC + c0); vb[k] = *(const u32x4*)(zr + ZSX + c0); vs[k] = *(const u32x4*)(zr + ZSB + c0); }
#pragma unroll
        for (int k = 0; k < 4; ++k) {
            float a[8], b[8], sb[8], o[8];
            unpack8(va[k], a); unpack8(vb[k], b); unpack8(vs[k], sb);
#pragma unroll
            for (int j = 0; j < 8; ++j) { const float p0 = a[j] * b[j]; o[j] = sb[j] * (w0[j] * p2[j] + w1[j] * p1[j] + w2[j] * p0); p2[j] = p1[j]; p1[j] = p0; }
            *(u32x4*)(Z + (size_t)(t0 + tt + k) * ZC + ZSB + c0) = pack8(o);
        }
    }
}

__device__ __forceinline__ void attn_item(const Params& P, int half, int item, LAS unsigned char* lds, unsigned* ctr) {
    const int tid = get_tid(), lane = tid & 63, w = __builtin_amdgcn_readfirstlane(tid >> 6), g = lane >> 4, c = lane & 15;
    const int b = item / 192, rem = item % 192, gi = rem / 64, r2 = rem % 64;
    const int dil = (gi == 0) ? 1 : (gi == 1 ? 4 : 16), nb = 16 / dil;
    const int n = r2 % nb, t2 = r2 / nb, hh = t2 & 3, rr = t2 >> 2;
    bf16_t* Z = (bf16_t*)(P.ws + WS_Z);
    const float* RC = (const float*)(P.ws + WS_RC); const float* RS = (const float*)(P.ws + WS_RS);
    float* LSE = (float*)(P.ws + WS_LSE);
    const int colq = ZDQ + gi * 512 + hh * 128, colk = ZDK + gi * 512 + hh * 128, colv = ZDV + gi * 512 + hh * 128;
    const int rowb = b * 2048, gtb = half * TH;
    constexpr int KSTR = 272, VSTR = 528;
    LAS unsigned char* Ks = lds; LAS unsigned char* Vt = lds + 256 * KSTR;
    constexpr float QSCALE = 0.08838834764831845f * 1.4426950408889634f;

    const int km = tid >> 1, khf = tid & 1, klk = (n - 1) * 128 + km;
    const int vkb = tid & 31, vdb = tid >> 5, vlk0 = (n - 1) * 128 + vkb * 8;
    const int qi = 16 * w + c, qrow = rowb + (n * 128 + qi) * dil + rr;
    u32x4 kx1[4], kx2[4]; f32x4 kinv[8]; float kpos = 0.f;
    u32x4 rv[8];
    u32x4 qx1[2], qx2[2]; f32x4 qinv[4]; float qpos;
    if (klk >= 0) {
        const int krow = rowb + klk * dil + rr;
        const bf16_t* kp = Z + (size_t)krow * ZC + colk + khf * 32;
        kpos = (float)P.pos[gtb + krow];
#pragma unroll
        for (int cc = 0; cc < 4; ++cc) { kx1[cc] = *(const u32x4*)(kp + cc * 8); kx2[cc] = *(const u32x4*)(kp + 64 + cc * 8);
            kinv[2 * cc] = *(const f32x4*)(RC + khf * 32 + cc * 8); kinv[2 * cc + 1] = *(const f32x4*)(RC + khf * 32 + cc * 8 + 4); }
    } else {
#pragma unroll
        for (int cc = 0; cc < 4; ++cc) { kx1[cc] = (u32x4){0u, 0u, 0u, 0u}; kx2[cc] = (u32x4){0u, 0u, 0u, 0u};
            kinv[2 * cc] = (f32x4){0.f, 0.f, 0.f, 0.f}; kinv[2 * cc + 1] = (f32x4){0.f, 0.f, 0.f, 0.f}; }
    }
    if (vlk0 >= 0) {
#pragma unroll
        for (int kk = 0; kk < 8; ++kk) { const int row = rowb + (vlk0 + kk) * dil + rr; rv[kk] = *(const u32x4*)(Z + (size_t)row * ZC + colv + vdb * 8); }
    } else {
#pragma unroll
        for (int kk = 0; kk < 8; ++kk) rv[kk] = (u32x4){0u, 0u, 0u, 0u};
    }
    {
        const bf16_t* qp = Z + (size_t)qrow * ZC + colq + 8 * g;
        qpos = (float)P.pos[gtb + qrow];
#pragma unroll
        for (int kh = 0; kh < 2; ++kh) { qx1[kh] = *(const u32x4*)(qp + kh * 32); qx2[kh] = *(const u32x4*)(qp + 64 + kh * 32);
            qinv[2 * kh] = *(const f32x4*)(RC + kh * 32 + 8 * g); qinv[2 * kh + 1] = *(const f32x4*)(RC + kh * 32 + 8 * g + 4); }
    }
    {
        LAS unsigned char* kd = Ks + km * KSTR;
#pragma unroll
        for (int cc = 0; cc < 4; ++cc) {
            float x1[8], x2[8], o1[8], o2[8];
            unpack8(kx1[cc], x1); unpack8(kx2[cc], x2);
            f32x4 c0, c1, s0, s1;
#pragma unroll
            for (int j = 0; j < 4; ++j) { const float r0 = __builtin_amdgcn_fractf(kpos * kinv[2 * cc][j] * 0.15915494309189535f), r1 = __builtin_amdgcn_fractf(kpos * kinv[2 * cc + 1][j] * 0.15915494309189535f);
                c0[j] = __builtin_amdgcn_cosf(r0); s0[j] = __builtin_amdgcn_sinf(r0); c1[j] = __builtin_amdgcn_cosf(r1); s1[j] = __builtin_amdgcn_sinf(r1); }
#pragma unroll
            for (int j = 0; j < 4; ++j) { o1[j] = x1[j] * c0[j] - x2[j] * s0[j]; o2[j] = x2[j] * c0[j] + x1[j] * s0[j];
                o1[4 + j] = x1[4 + j] * c1[j] - x2[4 + j] * s1[j]; o2[4 + j] = x2[4 + j] * c1[j] + x1[4 + j] * s1[j]; }
            *(LAS u32x4*)(kd + (khf * 32 + cc * 8) * 2) = pack8(o1); *(LAS u32x4*)(kd + (64 + khf * 32 + cc * 8) * 2) = pack8(o2);
        }
    }
    {
#pragma unroll
        for (int dd = 0; dd < 8; ++dd) {
            const int wi = dd >> 1; u32x4 o;
            if (dd & 1) { o.x = __builtin_amdgcn_perm(rv[1][wi], rv[0][wi], 0x07060302u); o.y = __builtin_amdgcn_perm(rv[3][wi], rv[2][wi], 0x07060302u); o.z = __builtin_amdgcn_perm(rv[5][wi], rv[4][wi], 0x07060302u); o.w = __builtin_amdgcn_perm(rv[7][wi], rv[6][wi], 0x07060302u); }
            else { o.x = __builtin_amdgcn_perm(rv[1][wi], rv[0][wi], 0x05040100u); o.y = __builtin_amdgcn_perm(rv[3][wi], rv[2][wi], 0x05040100u); o.z = __builtin_amdgcn_perm(rv[5][wi], rv[4][wi], 0x05040100u); o.w = __builtin_amdgcn_perm(rv[7][wi], rv[6][wi], 0x05040100u); }
            *(LAS u32x4*)(Vt + (vdb * 8 + dd) * VSTR + vkb * 16) = o;
        }
    }
    bf16x8 Qf[4];
    {
#pragma unroll
        for (int kh = 0; kh < 2; ++kh) {
            float x1[8], x2[8], o1[8], o2[8];
            unpack8(qx1[kh], x1); unpack8(qx2[kh], x2);
            f32x4 c0, c1, s0, s1;
#pragma unroll
            for (int j = 0; j < 4; ++j) { const float r0 = __builtin_amdgcn_fractf(qpos * qinv[2 * kh][j] * 0.15915494309189535f), r1 = __builtin_amdgcn_fractf(qpos * qinv[2 * kh + 1][j] * 0.15915494309189535f);
                c0[j] = __builtin_amdgcn_cosf(r0); s0[j] = __builtin_amdgcn_sinf(r0); c1[j] = __builtin_amdgcn_cosf(r1); s1[j] = __builtin_amdgcn_sinf(r1); }
#pragma unroll
            for (int j = 0; j < 4; ++j) { o1[j] = (x1[j] * c0[j] - x2[j] * s0[j]) * QSCALE; o2[j] = (x2[j] * c0[j] + x1[j] * s0[j]) * QSCALE;
                o1[4 + j] = (x1[4 + j] * c1[j] - x2[4 + j] * s1[j]) * QSCALE; o2[4 + j] = (x2[4 + j] * c1[j] + x1[4 + j] * s1[j]) * QSCALE; }
            Qf[kh] = as_bf16x8(pack8(o1)); Qf[kh + 2] = as_bf16x8(pack8(o2));
        }
    }
    __syncthreads();
    unsigned nxt_id = 0u;
    if (tid == 0) nxt_id = atomicAdd(ctr, 1u);
    const int m0 = (16 * w < 96) ? 16 * w : 96;
    f32x4 S[10];
#pragma unroll
    for (int jt = 0; jt < 10; ++jt) {
        S[jt] = (f32x4){0.f, 0.f, 0.f, 0.f};
        const LAS unsigned char* kr = Ks + (m0 + jt * 16 + c) * KSTR + 16 * g;
#pragma unroll
        for (int ks = 0; ks < 4; ++ks) { const bf16x8 a = *(const LAS bf16x8*)(kr + ks * 64); S[jt] = __builtin_amdgcn_mfma_f32_16x16x32_bf16(a, Qf[ks], S[jt], 0, 0, 0); }
    }
    float mx = -INFINITY;
#pragma unroll
    for (int jt = 0; jt < 10; ++jt)
#pragma unroll
        for (int jj = 0; jj < 4; ++jj) { const int m = m0 + jt * 16 + 4 * g + jj, dist = qi + 128 - m; const bool ok = (dist >= 0) && (dist <= 128) && ((n - 1) * 128 + m >= 0);
            const float s = ok ? S[jt][jj] : -INFINITY; S[jt][jj] = s; mx = fmaxf(mx, s); }
    mx = fmaxf(mx, __shfl_xor(mx, 16)); mx = fmaxf(mx, __shfl_xor(mx, 32));
    float den = 0.f;
#pragma unroll
    for (int jt = 0; jt < 10; ++jt)
#pragma unroll
        for (int jj = 0; jj < 4; ++jj) { const float p = __builtin_amdgcn_exp2f(S[jt][jj] - mx); S[jt][jj] = p; den += p; }
    den += __shfl_xor(den, 16); den += __shfl_xor(den, 32);
    bf16x8 Pf[5];
#pragma unroll
    for (int k5 = 0; k5 < 5; ++k5) { u32x4 pw; pw.x = cvt_pk_bf16(S[2 * k5][0], S[2 * k5][1]); pw.y = cvt_pk_bf16(S[2 * k5][2], S[2 * k5][3]); pw.z = cvt_pk_bf16(S[2 * k5 + 1][0], S[2 * k5 + 1][1]); pw.w = cvt_pk_bf16(S[2 * k5 + 1][2], S[2 * k5 + 1][3]); Pf[k5] = as_bf16x8(pw); }
    const float inv = 1.0f / den;
    bf16_t* op = Z + (size_t)qrow * ZC + colq + 4 * g;
#pragma unroll
    for (int dt = 0; dt < 8; ++dt) {
        f32x4 O = (f32x4){0.f, 0.f, 0.f, 0.f};
        const LAS unsigned char* vr = Vt + (dt * 16 + c) * VSTR + (m0 + 4 * g) * 2;
#pragma unroll
        for (int k5 = 0; k5 < 5; ++k5) { const u32x2 lo = *(const LAS u32x2*)(vr + k5 * 64), hi = *(const LAS u32x2*)(vr + k5 * 64 + 32);
            const bf16x8 a = as_bf16x8((u32x4){lo.x, lo.y, hi.x, hi.y}); O = __builtin_amdgcn_mfma_f32_16x16x32_bf16(a, Pf[k5], O, 0, 0, 0); }
        u32x2 ow; ow.x = cvt_pk_bf16(O[0] * inv, O[1] * inv); ow.y = cvt_pk_bf16(O[2] * inv, O[3] * inv);
        *(u32x2*)(op + dt * 16) = ow;
    }
    if (g == 0) LSE[(size_t)qrow * 12 + gi * 4 + hh] = (mx + __builtin_amdgcn_logf(den)) * 0.6931471805599453f;
    if (tid == 0) *(LAS unsigned*)(lds + LDS_SLOT) = nxt_id;
    __syncthreads();
}

__device__ __forceinline__ float logsig16(float x) { return (fminf(x, 0.f) - __logf(1.0f + __expf(-fabsf(x)))) * (1.0f / 16.0f); }

#define LBAR() do { asm volatile("s_waitcnt lgkmcnt(0)" ::: "memory"); __builtin_amdgcn_s_barrier(); asm volatile("" ::: "memory"); } while (0)
__device__ void gla_item(const Params& P, int l, int b, int h, int seg, LAS unsigned char* lds) {
    const int tid = get_tid(), lane = tid & 63, w = __builtin_amdgcn_readfirstlane(tid >> 6), g = lane >> 4, c = lane & 15;
    bf16_t* Z = (bf16_t*)(P.ws + WS_Z); const float* AL = (const float*)(P.ws + WS_ALOW);
    LAS float* WUP = (LAS float*)(lds + 0);
    LAS float* BUP = (LAS float*)(lds + 4096);
    LAS float* ARAW = (LAS float*)(lds + 4352);
    LAS float* LC = (LAS float*)(lds + 8448);
    LAS float* SEG = (LAS float*)(lds + 24832);
    LAS float* DEC = (LAS float*)(lds + 26880);
    LAS unsigned char* QP = lds + 29184;
    LAS unsigned char* KP = lds + 38400;
    LAS unsigned char* KPP = lds + 47616;
    LAS unsigned char* AIN = lds + 56832;
    LAS unsigned char* VS = lds + 66048;
    LAS unsigned char* OT = lds + 83456;
    constexpr int QS = 144, VSS = 272;
    for (int i = tid; i < 1024; i += NTHR) { const int r = i >> 6, d = i & 63; WUP[i] = P.w_alpha_up[((size_t)l * 16 + r) * 256 + h * 64 + d]; }
    if (tid < 64) BUP[tid] = P.b_alpha[(size_t)l * 256 + h * 64 + tid];
    f32x4 Sacc[4];
#pragma unroll
    for (int dt = 0; dt < 4; ++dt) Sacc[dt] = (f32x4){0.f, 0.f, 0.f, 0.f};
    const int rowb = b * 2048 + seg * 256;
    const int t_ = tid >> 3, d8 = (tid & 7) * 8;
    u32x4 nq, nk, nv0, nv1; f32x4 na = (f32x4){0.f, 0.f, 0.f, 0.f};
    {
        const size_t r0 = (size_t)(rowb + t_) * ZC;
        nq = *(const u32x4*)(Z + r0 + ZQ + h * 64 + d8); nk = *(const u32x4*)(Z + r0 + ZK + h * 64 + d8);
        nv0 = *(const u32x4*)(Z + (size_t)(rowb + (tid >> 4)) * ZC + ZV + h * 128 + (tid & 15) * 8);
        nv1 = *(const u32x4*)(Z + (size_t)(rowb + 32 + (tid >> 4)) * ZC + ZV + h * 128 + (tid & 15) * 8);
        if (tid < 256) na = *(const f32x4*)(AL + (size_t)(rowb + (tid >> 2)) * 16 + (tid & 3) * 4);
    }
    float Lseg[8];
#pragma unroll
    for (int j = 0; j < 8; ++j) Lseg[j] = 0.f;
    float* DSEG = (float*)(P.ws + WS_DSEG);
    for (int n = 0; n < 4; ++n) {
        if ((n & 3) == 0) {
#pragma unroll
            for (int dt = 0; dt < 4; ++dt) Sacc[dt] = (f32x4){0.f, 0.f, 0.f, 0.f};
#pragma unroll
            for (int j = 0; j < 8; ++j) Lseg[j] = 0.f;
        }
        const int row0 = rowb + n * 64;
        const u32x4 cq = nq, ck = nk;
        *(LAS u32x4*)(VS + (tid >> 4) * VSS + (tid & 15) * 16) = nv0;
        *(LAS u32x4*)(VS + (32 + (tid >> 4)) * VSS + (tid & 15) * 16) = nv1;
        if (tid < 256) *(LAS f32x4*)(ARAW + (tid >> 2) * 16 + (tid & 3) * 4) = na;
        if (n + 1 < 4) {
            const int rn = row0 + 64; const size_t r0 = (size_t)(rn + t_) * ZC;
            nq = *(const u32x4*)(Z + r0 + ZQ + h * 64 + d8); nk = *(const u32x4*)(Z + r0 + ZK + h * 64 + d8);
            nv0 = *(const u32x4*)(Z + (size_t)(rn + (tid >> 4)) * ZC + ZV + h * 128 + (tid & 15) * 8);
            nv1 = *(const u32x4*)(Z + (size_t)(rn + 32 + (tid >> 4)) * ZC + ZV + h * 128 + (tid & 15) * 8);
            if (tid < 256) na = *(const f32x4*)(AL + (size_t)(rn + (tid >> 2)) * 16 + (tid & 3) * 4);
        }
        LBAR();
        {
            float x[8];
#pragma unroll
            for (int j = 0; j < 8; ++j) x[j] = BUP[d8 + j];
#pragma unroll
            for (int r = 0; r < 16; ++r) { const float a = ARAW[t_ * 16 + r]; const f32x4 w0 = *(const LAS f32x4*)(WUP + r * 64 + d8), w1 = *(const LAS f32x4*)(WUP + r * 64 + d8 + 4);
#pragma unroll
                for (int j = 0; j < 4; ++j) { x[j] += a * w0[j]; x[4 + j] += a * w1[j]; } }
            f32x4 o0, o1;
#pragma unroll
            for (int j = 0; j < 4; ++j) { o0[j] = logsig16(x[j]); o1[j] = logsig16(x[4 + j]); }
            *(LAS f32x4*)(LC + t_ * 64 + d8) = o0; *(LAS f32x4*)(LC + t_ * 64 + d8 + 4) = o1;
        }
        LBAR();
        {
            const int d = tid & 63, sg = tid >> 6; float cum[8]; float run = 0.f;
#pragma unroll
            for (int i = 0; i < 8; ++i) { run += LC[(sg * 8 + i) * 64 + d]; cum[i] = run; }
            SEG[sg * 64 + d] = run;
            LBAR();
            float off = 0.f;
#pragma unroll
            for (int s = 0; s < 7; ++s) off += (s < sg) ? SEG[s * 64 + d] : 0.f;
#pragma unroll
            for (int i = 0; i < 8; ++i) LC[(sg * 8 + i) * 64 + d] = cum[i] + off;
        }
        LBAR();
        {
            const f32x4 L0 = *(const LAS f32x4*)(LC + t_ * 64 + d8), L1 = *(const LAS f32x4*)(LC + t_ * 64 + d8 + 4);
            const f32x4 E0 = *(const LAS f32x4*)(LC + 63 * 64 + d8), E1 = *(const LAS f32x4*)(LC + 63 * 64 + d8 + 4);
            float qf[8], kf[8], qo[8], ko[8], k2[8], q2[8];
            unpack8(cq, qf); unpack8(ck, kf);
#pragma unroll
            for (int j = 0; j < 8; ++j) { const float L = (j < 4) ? L0[j & 3] : L1[j & 3], Le = (j < 4) ? E0[j & 3] : E1[j & 3];
                qo[j] = qf[j] * __expf(L) * 0.125f; ko[j] = kf[j] * __expf(-L); k2[j] = kf[j] * __expf(Le - L); q2[j] = qf[j] * __expf(L + Lseg[j]) * 0.125f; Lseg[j] += Le; }
            *(LAS u32x4*)(QP + t_ * QS + d8 * 2) = pack8(qo); *(LAS u32x4*)(KP + t_ * QS + d8 * 2) = pack8(ko); *(LAS u32x4*)(KPP + t_ * QS + d8 * 2) = pack8(k2);
            *(u32x4*)(Z + (size_t)(row0 + t_) * ZC + ZQ + h * 64 + d8) = pack8(q2);
            if (t_ == 0) {
#pragma unroll
                for (int j = 0; j < 8; ++j) DEC[d8 + j] = __expf((j < 4) ? E0[j & 3] : E1[j & 3]); }
        }
        LBAR();
#pragma unroll
        for (int q = 0; q < 2; ++q) {
            const int idx = 2 * w + q, it = idx >> 2, jt = idx & 3;
            f32x4 A = (f32x4){0.f, 0.f, 0.f, 0.f};
            if (jt <= it) {
#pragma unroll
                for (int ks = 0; ks < 2; ++ks) { const bf16x8 a = *(const LAS bf16x8*)(QP + (it * 16 + c) * QS + (ks * 32 + 8 * g) * 2), bb = *(const LAS bf16x8*)(KP + (jt * 16 + c) * QS + (ks * 32 + 8 * g) * 2);
                    A = __builtin_amdgcn_mfma_f32_16x16x32_bf16(a, bb, A, 0, 0, 0); }
            }
#pragma unroll
            for (int jj = 0; jj < 4; ++jj) { const int i = it * 16 + 4 * g + jj, j = jt * 16 + c; const float v = (j <= i) ? A[jj] : 0.f;
                *(LAS unsigned short*)(AIN + i * QS + j * 2) = f2bf(v); }
        }
        LBAR();
        bf16x8 Vb[2];
#pragma unroll
        for (int ks = 0; ks < 2; ++ks) { unsigned short e[8];
#pragma unroll
            for (int j = 0; j < 8; ++j) e[j] = *(const LAS unsigned short*)(VS + (ks * 32 + 8 * g + j) * VSS + (16 * w + c) * 2);
            u32x4 pw; pw.x = e[0] | ((unsigned)e[1] << 16); pw.y = e[2] | ((unsigned)e[3] << 16); pw.z = e[4] | ((unsigned)e[5] << 16); pw.w = e[6] | ((unsigned)e[7] << 16); Vb[ks] = as_bf16x8(pw); }
        bf16x8 Sb[2];
#pragma unroll
        for (int k2 = 0; k2 < 2; ++k2) { u32x4 pw; pw.x = cvt_pk_bf16(Sacc[2 * k2][0], Sacc[2 * k2][1]); pw.y = cvt_pk_bf16(Sacc[2 * k2][2], Sacc[2 * k2][3]);
            pw.z = cvt_pk_bf16(Sacc[2 * k2 + 1][0], Sacc[2 * k2 + 1][1]); pw.w = cvt_pk_bf16(Sacc[2 * k2 + 1][2], Sacc[2 * k2 + 1][3]); Sb[k2] = as_bf16x8(pw); }
        f32x4 Oacc[4];
#pragma unroll
        for (int it = 0; it < 4; ++it) {
            Oacc[it] = (f32x4){0.f, 0.f, 0.f, 0.f};
#pragma unroll
            for (int ks = 0; ks < 2; ++ks) { const bf16x8 a = *(const LAS bf16x8*)(AIN + (it * 16 + c) * QS + (ks * 32 + 8 * g) * 2); Oacc[it] = __builtin_amdgcn_mfma_f32_16x16x32_bf16(a, Vb[ks], Oacc[it], 0, 0, 0); }
#pragma unroll
            for (int k2 = 0; k2 < 2; ++k2) { const u32x2 lo = *(const LAS u32x2*)(QP + (it * 16 + c) * QS + (32 * k2 + 4 * g) * 2), hi = *(const LAS u32x2*)(QP + (it * 16 + c) * QS + (32 * k2 + 16 + 4 * g) * 2);
                const bf16x8 a = as_bf16x8((u32x4){lo.x, lo.y, hi.x, hi.y}); Oacc[it] = __builtin_amdgcn_mfma_f32_16x16x32_bf16(a, Sb[k2], Oacc[it], 0, 0, 0); }
        }
#pragma unroll
        for (int dt = 0; dt < 4; ++dt) {
            const f32x4 dc = *(const LAS f32x4*)(DEC + dt * 16 + 4 * g);
            Sacc[dt] = Sacc[dt] * dc;
#pragma unroll
            for (int ks = 0; ks < 2; ++ks) { unsigned short e[8];
#pragma unroll
                for (int j = 0; j < 8; ++j) e[j] = *(const LAS unsigned short*)(KPP + (ks * 32 + 8 * g + j) * QS + (dt * 16 + c) * 2);
                u32x4 pw; pw.x = e[0] | ((unsigned)e[1] << 16); pw.y = e[2] | ((unsigned)e[3] << 16); pw.z = e[4] | ((unsigned)e[5] << 16); pw.w = e[6] | ((unsigned)e[7] << 16);
                Sacc[dt] = __builtin_amdgcn_mfma_f32_16x16x32_bf16(as_bf16x8(pw), Vb[ks], Sacc[dt], 0, 0, 0); }
        }
#pragma unroll
        for (int it = 0; it < 4; ++it)
#pragma unroll
            for (int jj = 0; jj < 4; ++jj) *(LAS unsigned short*)(OT + (it * 16 + 4 * g + jj) * VSS + (16 * w + c) * 2) = f2bf(Oacc[it][jj]);
        LBAR();
        {
            const u32x4 o0 = *(const LAS u32x4*)(OT + (tid >> 4) * VSS + (tid & 15) * 16), o1 = *(const LAS u32x4*)(OT + (32 + (tid >> 4)) * VSS + (tid & 15) * 16);
            *(u32x4*)(Z + (size_t)(row0 + (tid >> 4)) * ZC + ZV + h * 128 + (tid & 15) * 8) = o0;
            *(u32x4*)(Z + (size_t)(row0 + 32 + (tid >> 4)) * ZC + ZV + h * 128 + (tid & 15) * 8) = o1;
        }
        if ((n & 3) == 3) {
            const int rs0 = rowb;
#pragma unroll
            for (int dt = 0; dt < 4; ++dt)
#pragma unroll
                for (int jj = 0; jj < 4; ++jj) { const int d = dt * 16 + 4 * g + jj, dv = 16 * w + c; *((float*)(Z + (size_t)(rs0 + d * 4 + (dv >> 5)) * ZC + ZK + h * 64) + (dv & 31)) = Sacc[dt][jj]; }            if (t_ == 0) {
#pragma unroll
                for (int j = 0; j < 8; ++j) DSEG[(size_t)((b * 4 + h) * 8 + seg) * 64 + d8 + j] = __expf(Lseg[j]); }
        }
    }
    __syncthreads();
}


__device__ void gla_C(const Params& P, int l, int item, LAS unsigned char* lds) {
    const int tid = get_tid(), lane = tid & 63, w = __builtin_amdgcn_readfirstlane(tid >> 6), g = lane >> 4, c = lane & 15;
    const int seg = item & 7, bh = item >> 3, b = bh >> 2, h = bh & 3;
    bf16_t* Z = (bf16_t*)(P.ws + WS_Z);
    LAS float* SSQ = (LAS float*)lds;
    LAS unsigned char* OT = lds + 8192;
    const float ng = P.gla_norm_g[(size_t)l * 128 + 16 * w + c];
    const float* DSEG = (const float*)(P.ws + WS_DSEG);
    float Sin[2][8];
#pragma unroll
    for (int ks = 0; ks < 2; ++ks)
#pragma unroll
        for (int e = 0; e < 8; ++e) Sin[ks][e] = 0.f;
    for (int sq = 0; sq < seg; ++sq) {
        const int rs0 = b * 2048 + sq * 256; const size_t it2 = (size_t)bh * 8 + sq;
#pragma unroll
        for (int ks = 0; ks < 2; ++ks)
#pragma unroll
            for (int e = 0; e < 8; ++e) { const int d = ks * 32 + 8 * g + e, dv = 16 * w + c;
                Sin[ks][e] = DSEG[it2 * 64 + d] * Sin[ks][e] + *((const float*)(Z + (size_t)(rs0 + d * 4 + (dv >> 5)) * ZC + ZK + h * 64) + (dv & 31)); }
    }
    bf16x8 Sb[2];
#pragma unroll
    for (int ks = 0; ks < 2; ++ks) Sb[ks] = as_bf16x8(pack8(Sin[ks]));
    const int row0 = b * 2048 + seg * 256;
    unsigned short gtr[16][4], olr[16][4];
#pragma unroll
    for (int rt = 0; rt < 16; ++rt)
#pragma unroll
        for (int jj = 0; jj < 4; ++jj) { const bf16_t* zr = Z + (size_t)(row0 + rt * 16 + 4 * g + jj) * ZC + h * 128 + 16 * w + c; gtr[rt][jj] = zr[ZG]; olr[rt][jj] = zr[ZV]; }
    f32x4 O[16];
#pragma unroll
    for (int rt = 0; rt < 16; ++rt) {
#pragma unroll
        for (int jj = 0; jj < 4; ++jj) O[rt][jj] = bf2f(olr[rt][jj]);
        if (seg > 0) {
#pragma unroll
            for (int ks = 0; ks < 2; ++ks) { const bf16x8 a = as_bf16x8(*(const u32x4*)(Z + (size_t)(row0 + rt * 16 + c) * ZC + ZQ + h * 64 + ks * 32 + 8 * g)); O[rt] = __builtin_amdgcn_mfma_f32_16x16x32_bf16(a, Sb[ks], O[rt], 0, 0, 0); }
        }
    }
    {
#pragma unroll
        for (int rt = 0; rt < 16; ++rt) {
            float sv[4];
#pragma unroll
            for (int jj = 0; jj < 4; ++jj) sv[jj] = O[rt][jj] * O[rt][jj];
#pragma unroll
            for (int m = 1; m <= 8; m <<= 1)
#pragma unroll
                for (int jj = 0; jj < 4; ++jj) sv[jj] += __shfl_xor(sv[jj], m);
            if (c == 0) {
#pragma unroll
                for (int jj = 0; jj < 4; ++jj) SSQ[w * 256 + rt * 16 + 4 * g + jj] = sv[jj]; }
        }
    }
    __syncthreads();
#pragma unroll
    for (int rt = 0; rt < 16; ++rt)
#pragma unroll
        for (int jj = 0; jj < 4; ++jj) { const int t = rt * 16 + 4 * g + jj; float tot = 0.f;
#pragma unroll
            for (int ww = 0; ww < 8; ++ww) tot += SSQ[ww * 256 + t];
            const float rs = rsqrtf(tot * (1.0f / 128.0f) + EPS);
            const float gt = bf2f(gtr[rt][jj]);
            *(LAS unsigned short*)(OT + t * 272 + (16 * w + c) * 2) = f2bf(O[rt][jj] * rs * ng * (gt * __builtin_amdgcn_rcpf(1.0f + __expf(-gt)))); }
    __syncthreads();
#pragma unroll
    for (int i = 0; i < 8; ++i) { const int p = tid + i * NTHR, r = p >> 4, sg = p & 15;
        *(u32x4*)(Z + (size_t)(row0 + r) * ZC + ZG + h * 128 + sg * 8) = *(const LAS u32x4*)(OT + r * 272 + sg * 16); }
    __syncthreads();
}

__device__ __forceinline__ int next_item(unsigned* ctr, LAS unsigned char* lds) {
    __syncthreads();
    if (threadIdx.x == 0) *(LAS unsigned*)(lds + LDS_SLOT) = atomicAdd(ctr, 1u);
    __syncthreads();
    return (int)*(LAS unsigned*)(lds + LDS_SLOT);
}

__device__ void phase_branches(const Params& P, int l, int half, LAS unsigned char* lds) {
    unsigned* ctr = (unsigned*)(P.ws + WS_CTL) + 64 * (l * 2 + half);
    for (int it = blockIdx.x; it < 256; it += gridDim.x) gla_item(P, l, it >> 5, (it >> 3) & 3, it & 7, lds);
    int it = next_item(ctr, lds);
    while (it < 1536 + 128) {
        if (it < 1536) { attn_item(P, half, it, lds, ctr); it = (int)*(LAS unsigned*)(lds + LDS_SLOT); }
        else { sc_item(P, l, it - 1536); it = next_item(ctr, lds); }
    }
}


#define XB_TMO      128
#define XB_XCNT(j)  (256  + 64 * (j))
#define XB_XSUB(j)  (1280 + 64 * (j))
#define XB_XGEN(j)  (2304 + 64 * (j))
#define XB_TOP      3328
#define XB_TOPGEN   3392
#define XCD_BAR_WORDS 3456
#define XB_SPIN_CAP (1u << 20)
__device__ __forceinline__ unsigned xb_ld(unsigned* p)              { return __hip_atomic_load(p, __ATOMIC_RELAXED, __HIP_MEMORY_SCOPE_AGENT); }
__device__ __forceinline__ unsigned xb_add(unsigned* p, unsigned v) { return __hip_atomic_fetch_add(p, v, __ATOMIC_RELAXED, __HIP_MEMORY_SCOPE_AGENT); }
__device__ __forceinline__ unsigned xb_xcc_id() { return (unsigned)__builtin_amdgcn_s_getreg((3 << 11) | 20) & 0xFu; }
#define XB_SPIN(cond, bar) do { unsigned _sp = 0; while (cond) { __builtin_amdgcn_s_sleep(1); \
    if ((++_sp & 255u) == 0u) { if (xb_ld(&(bar)[XB_TMO])) break; if (_sp > XB_SPIN_CAP) { atomicAdd(&(bar)[XB_TMO], 1u); break; } } } } while (0)
struct XcdBarrier { unsigned* bar; unsigned x; volatile LAS unsigned* st; };
__device__ __forceinline__ XcdBarrier xcd_barrier_post(unsigned* bar, volatile LAS unsigned* st) {
    XcdBarrier b; b.bar = bar; b.x = xb_xcc_id(); b.st = st;
    if (threadIdx.x == 0) (void)xb_add(&bar[XB_XCNT(b.x)], 1u);
    return b;
}
__device__ __forceinline__ void xcd_barrier_complete(unsigned* bar, unsigned x, unsigned& nloc, unsigned& nx) {
    const unsigned G = gridDim.x * gridDim.y * gridDim.z;
    unsigned sum, cnt, mine, sp = 0u;
    for (;;) {
        sum = 0u; cnt = 0u; mine = 0u;
#pragma unroll
        for (unsigned j = 0; j < 16; ++j) { const unsigned c = xb_ld(&bar[XB_XCNT(j)]); sum += c; cnt += (c > 0u) ? 1u : 0u; mine = (j == x) ? c : mine; }
        if (sum == G) break;
        __builtin_amdgcn_s_sleep(1);
        if ((++sp & 255u) == 0u) { if (xb_ld(&bar[XB_TMO])) break; if (sp > XB_SPIN_CAP) { atomicAdd(&bar[XB_TMO], 1u); break; } }
    }
    nloc = mine > 0u ? mine : 1u; nx = cnt > 0u ? cnt : 1u;
}
__device__ __forceinline__ void xcd_barrier(const XcdBarrier& b) {
    asm volatile("s_waitcnt vmcnt(0)" ::: "memory");
    __syncthreads();
    if (threadIdx.x == 0) {
        unsigned* bar = b.bar;
        __builtin_amdgcn_s_waitcnt(0);
        unsigned nloc = b.st[0], nx = b.st[1];
        if (nloc == 0u) { xcd_barrier_complete(bar, b.x, nloc, nx); b.st[0] = nloc; b.st[1] = nx; }
        const unsigned old = xb_add(&bar[XB_XSUB(b.x)], 1u);
        const unsigned gen = old / nloc;
        if (old + 1u == (gen + 1u) * nloc) {
            __builtin_amdgcn_fence(__ATOMIC_RELEASE, "agent");
            asm volatile("s_waitcnt vmcnt(0)" ::: "memory");
            const unsigned og = xb_add(&bar[XB_TOP], 1u);
            const unsigned tg = og / nx;
            if (og + 1u == (tg + 1u) * nx) xb_add(&bar[XB_TOPGEN], 1u);
            else XB_SPIN(xb_ld(&bar[XB_TOPGEN]) == tg, bar);
            __builtin_amdgcn_fence(__ATOMIC_ACQUIRE, "agent");
            xb_add(&bar[XB_XGEN(b.x)], 1u);
            asm volatile("s_waitcnt vmcnt(0)" ::: "memory");
        } else {
            XB_SPIN(xb_ld(&bar[XB_XGEN(b.x)]) == gen, bar);
            __builtin_amdgcn_fence(__ATOMIC_ACQUIRE, "agent");
            asm volatile("s_waitcnt vmcnt(0)" ::: "memory");
        }
    }
    __syncthreads();
}

__global__ void __launch_bounds__(NTHR, 2) fwd_kernel(Params P) {
    extern __shared__ __attribute__((aligned(16))) unsigned char smem[];
    LAS unsigned char* lds = (LAS unsigned char*)smem;
    cg::grid_group grid = cg::this_grid();
    if (threadIdx.x < 4) ((LAS unsigned*)(lds + LDS_BYTES - 32))[threadIdx.x] = 0u;
    __syncthreads();
    const XcdBarrier xb = xcd_barrier_post((unsigned*)(P.ws + WS_BAR), (volatile LAS unsigned*)(lds + LDS_BYTES - 32));
    unsigned char* ws = P.ws;
    const int lo = P.ph_lo, hi = P.ph_hi;
    const bool fuse = (gridDim.x == 256);
    for (int ph = lo; ph < hi; ++ph) {
        const int l = ph / 19, q = ph % 19;
        const int half = (q >= 8 && q <= 14) ? 1 : 0;
        const int k = (q == 0) ? 0 : (q <= 14 ? 1 + (q - 1) % 7 : q - 7);
        switch (k) {
        case 0: if (l == 0) { phase_convert(P, l, lds); phase_norm_alow(P, 0, 0, lds); } break;
        case 1: break;
        case 2: { pg8::Gemm g{(const bf16_t*)(ws + WS_H) + (size_t)half * TH * DM, (const bf16_t*)(ws + WS_W1), 1024, 1024, 1024, 0, 0}; pg8::Order S; S.init(TH, 10752, gridDim.x, blockIdx.x, 1);
                  pg8::EpiSplit E{(bf16_t*)(ws + WS_Z), ZC, (bf16_t*)(ws + WS_GT), GC, 30, P.b_gate + (size_t)l * GC}; pg8::gemm_phase(lds, g, S, E); } break;
        case 3: phase_branches(P, l, half, lds); break;
        case 4: for (int it = blockIdx.x; it < 256; it += gridDim.x) gla_C(P, l, it, lds); phase_combine(P); break;
        case 5: { pg8::Gemm g{(const bf16_t*)(ws + WS_Z) + ZG, (const bf16_t*)(ws + WS_WBR), ZC, 512, 512, (size_t)1024, (size_t)1024 * 512};
                  pg8::Order S; S.init(TH, 1024, gridDim.x, blockIdx.x, 3);
                  pg8::EpiMerge E{(const bf16_t*)(ws + WS_GT), (bf16_t*)(ws + WS_MG)}; pg8::gemm_phase(lds, g, S, E); } break;
        case 6: if (fuse) {
                      const int inst = l * 2 + half;
                      pg8::Gemm g{(const bf16_t*)(ws + WS_MG), (const bf16_t*)(ws + WS_WMO), 1024, 1024, 1024, 0, 0}; pg8::Order S; S.init(TH, 1024, gridDim.x, blockIdx.x, 1);
                      pg8::EpiNormRes E{(l == 0 ? P.x : P.out) + (size_t)half * TH * DM, P.out + (size_t)half * TH * DM, (bf16_t*)(ws + WS_H) + (size_t)half * TH * DM,
                                        P.post_mix_g + (size_t)l * DM, P.pre_ffn_g + (size_t)l * DM,
                                        (unsigned*)(ws + WS_XS) + (size_t)(inst * 2) * TH * 4, (unsigned*)(ws + WS_XS) + (size_t)(inst * 2 + 1) * TH * 4,
                                        (unsigned*)(ws + WS_CTL) + 4608 + (inst * 2) * 256, (unsigned*)(ws + WS_CTL) + 4608 + (inst * 2 + 1) * 256};
                      pg8::gemm_phase(lds, g, S, E);
                      if (half == 0) phase_norm_alow(P, l, 1, lds);
                  } else { pg8::Gemm g{(const bf16_t*)(ws + WS_MG), (const bf16_t*)(ws + WS_WMO), 1024, 1024, 1024, 0, 0}; pg8::Order S; S.init(TH, 1024, gridDim.x, blockIdx.x, 1);
                      pg8::EpiSplit E{(bf16_t*)(ws + WS_Y), 1024, (bf16_t*)(ws + WS_Y), 1024, 1 << 20, nullptr}; pg8::gemm_phase(lds, g, S, E); } break;
        case 7: if (!fuse) { phase_resid((l == 0 ? P.x : P.out) + (size_t)half * TH * DM, P.out + (size_t)half * TH * DM, (const bf16_t*)(ws + WS_Y), P.post_mix_g + (size_t)l * DM, P.pre_ffn_g + (size_t)l * DM,
                            (bf16_t*)(ws + WS_H) + (size_t)half * TH * DM, TH);
                if (half == 0) phase_norm_alow(P, l, 1, lds); }
                break;
        case 8: { pg8::Gemm g{(const bf16_t*)(ws + WS_H), (const bf16_t*)(ws + WS_WFF), 1024, 1024, 1024, 0, 0}; pg8::Order S; S.init(T_ALL, 5632, gridDim.x, blockIdx.x, 1);
                  pg8::EpiFFN E{(bf16_t*)(ws + WS_U), (float*)(ws + WS_HG), (float*)(ws + WS_HU), P.ff_conv_w + (size_t)l * 3 * FF, P.ff_conv_b + (size_t)l * FF, lds + pg8::STAGE_BYTES};
                  pg8::gemm_phase(lds, g, S, E); } break;
        case 9: phase_ffn_fix(P, l); break;
        case 10: { pg8::Gemm g{(const bf16_t*)(ws + WS_U), (const bf16_t*)(ws + WS_WD), FF, FF, FF, 0, 0}; pg8::Order S; S.init(T_ALL, 1024, gridDim.x, blockIdx.x, 1);
                   pg8::EpiSplit E{(bf16_t*)(ws + WS_Y2), 1024, (bf16_t*)(ws + WS_Y2), 1024, 1 << 20, nullptr}; pg8::gemm_phase(lds, g, S, E); } break;
        default: phase_resid(P.out, P.out, (const bf16_t*)(ws + WS_Y2), P.post_ffn_g + (size_t)l * DM, nullptr, nullptr, T_ALL);
                 if (l == 0) { phase_convert(P, 1, lds); phase_norm_alow(P, 1, 0, lds); }
                 break;
        }
        const bool empty = (k == 0 && l == 1) || (k == 1) || (k == 7 && fuse);
        if (ph + 1 < hi && !empty) { if (hi < lo) grid.sync(); else xcd_barrier(xb); }
    }
}

constexpr int N_PHASES = 2 * (1 + 2 * 7 + 4);

#ifndef MULTI_LAUNCH
#define MULTI_LAUNCH 0
#endif

extern "C" void kernel_launch(void* const* d_in, const int* in_sizes, int n_in, void* d_out, int out_size, void* d_ws, size_t ws_size, hipStream_t stream) {
    static int grid = 0;
    if (grid == 0) {
        if (n_in != 20 || ws_size < WS_END) { fprintf(stderr, "kernel_launch: unexpected n_in %d / ws_size %zu (need %zu)\n", n_in, ws_size, (size_t)WS_END); grid = -1; return; }
        int dev = 0, cus = 0, per_cu = 0;
        hipGetDevice(&dev); hipDeviceGetAttribute(&cus, hipDeviceAttributeMultiprocessorCount, dev);
        if (hipFuncSetAttribute((const void*)fwd_kernel, hipFuncAttributeMaxDynamicSharedMemorySize, LDS_BYTES) != hipSuccess) { fprintf(stderr, "kernel_launch: hipFuncSetAttribute failed\n"); grid = -1; return; }
        if (hipOccupancyMaxActiveBlocksPerMultiprocessor(&per_cu, (const void*)fwd_kernel, NTHR, LDS_BYTES) != hipSuccess || per_cu < 1) per_cu = 1;
        (void)hipGetLastError();
        grid = cus * per_cu;
        if (grid > 256) grid = 256;
    }
    if (grid < 0) return;
    hipMemsetAsync((char*)d_ws + WS_CTL, 0, 32768, stream);
    Params p{};
    p.x = (const float*)d_in[0]; p.pos = (const int*)d_in[1]; p.w_in = (const float*)d_in[2]; p.w_alpha_up = (const float*)d_in[3]; p.b_alpha = (const float*)d_in[4];
    p.gla_norm_g = (const float*)d_in[5]; p.sc_conv_w = (const float*)d_in[6]; p.w_gate = (const float*)d_in[7]; p.b_gate = (const float*)d_in[8]; p.w_branch = (const float*)d_in[9];
    p.w_mix_out = (const float*)d_in[10]; p.pre_mix_g = (const float*)d_in[11]; p.post_mix_g = (const float*)d_in[12]; p.pre_ffn_g = (const float*)d_in[13]; p.post_ffn_g = (const float*)d_in[14];
    p.w_ff_gate = (const float*)d_in[15]; p.w_ff_up = (const float*)d_in[16]; p.ff_conv_w = (const float*)d_in[17]; p.ff_conv_b = (const float*)d_in[18]; p.w_ff_down = (const float*)d_in[19];
    p.out = (float*)d_out; p.ws = (unsigned char*)d_ws;
#if MULTI_LAUNCH
    for (int ph = 0; ph < N_PHASES; ++ph) { p.ph_lo = ph; p.ph_hi = ph + 1; hipLaunchKernelGGL(fwd_kernel, dim3(grid), dim3(NTHR), LDS_BYTES, stream, p); }
#else
    p.ph_lo = 0; p.ph_hi = N_PHASES;
    void* args[] = {&p};
    hipError_t e = hipLaunchCooperativeKernel((const void*)fwd_kernel, dim3(grid), dim3(NTHR), args, LDS_BYTES, stream);
    if (e != hipSuccess) fprintf(stderr, "cooperative launch failed: %s (grid %d)\n", hipGetErrorString(e), grid);
#endif
}
```

```cpp
#include <hip/hip_runtime.h>
#include <hip/hip_cooperative_groups.h>
#include <cstdint>
#include <cstdio>
namespace cg = cooperative_groups;

#define LAS __attribute__((address_space(3)))
typedef unsigned short bf16_t;
typedef short bf16x8 __attribute__((ext_vector_type(8)));
typedef float f32x4 __attribute__((ext_vector_type(4)));
typedef float f32x2 __attribute__((ext_vector_type(2)));
typedef unsigned u32x4 __attribute__((ext_vector_type(4)));
typedef unsigned u32x2 __attribute__((ext_vector_type(2)));

constexpr int T_ALL = 32768, TH = 16384, DM = 1024, ZC = 7680, GC = 3072, FF = 2816;
constexpr int ZQ = 0, ZK = 256, ZV = 512, ZG = 1024, ZSC = 1536, ZSB = 2048, ZSX = 2560, ZDQ = 3072, ZDK = 4608, ZDV = 6144;
constexpr int IN_COLS = 7696;
constexpr float EPS = 1e-6f;
constexpr int NTHR = 512;
constexpr int LDS_BYTES = 147456;
constexpr int LDS_SLOT = LDS_BYTES - 16;

constexpr size_t WS_CTL = 0;
constexpr size_t WS_BAR = 4096;
constexpr size_t WS_W1 = 32768;
constexpr size_t WS_WBR = WS_W1 + (size_t)10752 * 1024 * 2;
constexpr size_t WS_WMO = WS_WBR + (size_t)3 * 1024 * 512 * 2;
constexpr size_t WS_WFF = WS_WMO + (size_t)1024 * 1024 * 2;
constexpr size_t WS_WD = WS_WFF + (size_t)5632 * 1024 * 2;
constexpr size_t WS_RC = WS_WD + (size_t)1024 * 2816 * 2;
constexpr size_t WS_XS = WS_RC + (size_t)1024 * 1024;
constexpr size_t WS_RS = WS_RC + (size_t)T_ALL * 64 * 4;
constexpr size_t WS_H = WS_RS + (size_t)T_ALL * 64 * 4;
constexpr size_t WS_ALOW = WS_H + (size_t)T_ALL * 1024 * 2;
constexpr size_t WS_LSE = WS_ALOW + (size_t)TH * 16 * 4;
constexpr size_t WS_DSEG = WS_LSE + (size_t)TH * 12 * 4;
constexpr size_t WS_BIG = WS_DSEG + (size_t)256 * 64 * 4;
constexpr size_t WS_Z = WS_BIG;
constexpr size_t WS_GT = WS_Z + (size_t)TH * ZC * 2;
constexpr size_t WS_MG = WS_GT + (size_t)TH * GC * 2;
constexpr size_t WS_END = WS_MG + (size_t)TH * 1024 * 2;
constexpr size_t WS_Y = WS_BIG;
constexpr size_t WS_G = WS_BIG;
constexpr size_t WS_U = WS_BIG + (size_t)T_ALL * FF * 2;
constexpr size_t WS_Y2 = WS_BIG;
constexpr size_t WS_HG = WS_BIG + (size_t)T_ALL * 1024 * 4;
constexpr size_t WS_HU = WS_HG + (size_t)128 * 4 * FF * 4;
static_assert(WS_HU + (size_t)128 * 2 * FF * 4 <= WS_U, "halo fits between Y2 and the activation buffer");
static_assert(WS_U + (size_t)T_ALL * FF * 2 <= WS_END, "ffn overlay");

struct Params {
    const float* x; const int* pos; const float* w_in; const float* w_alpha_up; const float* b_alpha; const float* gla_norm_g; const float* sc_conv_w;
    const float* w_gate; const float* b_gate; const float* w_branch; const float* w_mix_out; const float* pre_mix_g; const float* post_mix_g;
    const float* pre_ffn_g; const float* post_ffn_g; const float* w_ff_gate; const float* w_ff_up; const float* ff_conv_w; const float* ff_conv_b; const float* w_ff_down;
    float* out; unsigned char* ws; int ph_lo, ph_hi;
};

__device__ __forceinline__ int get_tid() { int t = threadIdx.x; asm volatile("" : "+v"(t)); return t; }
__device__ __forceinline__ unsigned cvt_pk_bf16(float lo, float hi) { unsigned r; asm volatile("v_cvt_pk_bf16_f32 %0, %1, %2" : "=v"(r) : "v"(lo), "v"(hi)); return r; }
__device__ __forceinline__ float bflo(unsigned w) { return __uint_as_float(w << 16); }
__device__ __forceinline__ float bfhi(unsigned w) { return __uint_as_float(w & 0xffff0000u); }
__device__ __forceinline__ float bf2f(unsigned short b) { return __uint_as_float(((unsigned)b) << 16); }
__device__ __forceinline__ unsigned short f2bf(float f) { return (unsigned short)(cvt_pk_bf16(f, 0.f) & 0xffffu); }
__device__ __forceinline__ void unpack8(const u32x4 w, float (&f)[8]) { f[0] = bflo(w.x); f[1] = bfhi(w.x); f[2] = bflo(w.y); f[3] = bfhi(w.y); f[4] = bflo(w.z); f[5] = bfhi(w.z); f[6] = bflo(w.w); f[7] = bfhi(w.w); }
__device__ __forceinline__ u32x4 pack8(const float (&f)[8]) { u32x4 w; w.x = cvt_pk_bf16(f[0], f[1]); w.y = cvt_pk_bf16(f[2], f[3]); w.z = cvt_pk_bf16(f[4], f[5]); w.w = cvt_pk_bf16(f[6], f[7]); return w; }
__device__ __forceinline__ bf16x8 as_bf16x8(const u32x4 w) { union { u32x4 u; bf16x8 b; } c; c.u = w; return c.b; }

namespace pg8 {
constexpr int BM = 256, BK = 64, HALF = 128, HTB = HALF * BK * 2, STAGE_BYTES = 8 * HTB, NXCD = 8, WGM = 8;
__device__ __forceinline__ int lds_byte(int r, int c) { const int st = (r >> 4) * 2 + (c >> 5), rr = r & 15, cc = c & 31, ob = rr * 64 + cc * 2; return st * 1024 + (ob ^ (((ob >> 9) & 1) << 5)); }
__device__ __forceinline__ void stage_rc(int b, int& R, int& C) { const int st = b / 1024, sb = b % 1024, swz = sb ^ (((sb >> 9) & 1) << 5); R = (st >> 1) * 16 + swz / 64; C = (st & 1) * 32 + (swz % 64) / 2; }
__device__ __forceinline__ int perm32(int rho) { const int n = rho >> 4, i = rho & 15; return 8 * (i >> 2) + 4 * n + (i & 3); }

struct Unit { int pm, pn, g; };
struct Gemm { const bf16_t* A; const bf16_t* Bt; int lda, ldb, K; size_t gA, gB; };

struct Order {
    int nM, nN, nwg, G, c, ng;
    __device__ void init(int M, int N, int G_, int c_, int ng_) { nM = M / BM; nN = N / BM; nwg = nM * nN; G = G_; c = c_; ng = ng_; }
    __device__ bool next(int i, Unit& u) const {
        const int ti = i / ng; u.g = i - ti * ng;
        const long L = (long)ti * G + c; if (L >= nwg) return false;
        int wgid = (int)L; { const int q = nwg / NXCD, r = nwg % NXCD, xcd = wgid % NXCD, off = wgid / NXCD; wgid = (xcd < r ? xcd * (q + 1) : r * (q + 1) + (xcd - r) * q) + off; }
        const int nig = WGM * nN, gid = wgid / nig, fm = gid * WGM, gsz = (nM - fm) < WGM ? (nM - fm) : WGM;
        u.pm = fm + ((wgid % nig) % gsz); u.pn = (wgid % nig) / gsz; return true;
    }
};

template <class Epi>
__device__ __forceinline__ void gemm_phase(LAS unsigned char* lds, const Gemm g, const Order& S, const Epi& E) {
    const int tid = get_tid(), wid = __builtin_amdgcn_readfirstlane(tid >> 6), lane = tid & 63, wr = wid >> 2, wc = wid & 3, fr = lane & 15, fq = lane >> 4;
    const int K = g.K, nt = K / BK;
    unsigned voffA[2], voffB[2];
#pragma unroll
    for (int i = 0; i < 2; ++i) { int R, C; stage_rc(tid * 16 + i * 8192, R, C); const int Rb = Epi::PERM ? ((R & ~31) + perm32(R & 31)) : R;
        voffA[i] = (unsigned)(R * g.lda + C) * 2u; voffB[i] = (unsigned)(Rb * g.ldb + C) * 2u; }
    const size_t kstep = (size_t)(BK * 2);
    const size_t hstepA = (size_t)HALF * g.lda * 2, hstepB = (size_t)HALF * g.ldb * 2;
    const size_t tstepA = 2 * hstepA, tstepB = 2 * hstepB;
    const unsigned ldsw = (unsigned)wid * 1024u;
    const int aoff = lds_byte(wr * 64 + fr, fq * 8), boff = lds_byte(wc * 32 + fr, fq * 8);
#define PG8_SA(b, h) (((b) * 2 + (h)) * HTB)
#define PG8_SB(b, h) ((4 + (b) * 2 + (h)) * HTB)
#define PG8_STAGE(bufoff, gbase, voff) do { _Pragma("unroll") for (int _i = 0; _i < 2; ++_i) \
        __builtin_amdgcn_global_load_lds((const unsigned*)((const char*)(gbase) + (voff)[_i]), (LAS unsigned*)(lds + (bufoff) + ldsw + _i * 8192), 16, 0, 0); } while (0)
#define PG8_LDA(dst, b, h) do { _Pragma("unroll") for (int m = 0; m < 4; ++m) _Pragma("unroll") for (int k = 0; k < 2; ++k) dst[m][k] = *(const LAS bf16x8*)(lds + PG8_SA(b, h) + aoff + m * 2048 + k * 1024); } while (0)
#define PG8_LDB(dst, b, h) do { _Pragma("unroll") for (int n = 0; n < 2; ++n) _Pragma("unroll") for (int k = 0; k < 2; ++k) dst[n][k] = *(const LAS bf16x8*)(lds + PG8_SB(b, h) + boff + n * 2048 + k * 1024); } while (0)
#define PG8_MMA(ai, bj, At, Bt) do { __builtin_amdgcn_s_setprio(1); _Pragma("unroll") for (int m = 0; m < 4; ++m) _Pragma("unroll") for (int n = 0; n < 2; ++n) _Pragma("unroll") for (int k = 0; k < 2; ++k) \
        acc[ai][bj][m][n] = __builtin_amdgcn_mfma_f32_16x16x32_bf16(Bt[n][k], At[m][k], acc[ai][bj][m][n], 0, 0, 0); __builtin_amdgcn_s_setprio(0); } while (0)
#define PG8_WAIT_V(n) asm volatile("s_waitcnt vmcnt(" #n ")" ::: "memory")
#define PG8_WAIT_L(n) asm volatile("s_waitcnt lgkmcnt(" #n ")" ::: "memory")
#define PG8_BAR __builtin_amdgcn_s_barrier()
#define PG8_SCHED __builtin_amdgcn_sched_barrier(0)
    Unit cur, nxt; int ui = 0;
    if (!S.next(0, cur)) return;
    f32x4 acc[2][2][4][2];
#pragma unroll
    for (int a = 0; a < 2; ++a)
#pragma unroll
        for (int b = 0; b < 2; ++b)
#pragma unroll
            for (int m = 0; m < 4; ++m)
#pragma unroll
                for (int n = 0; n < 2; ++n) acc[a][b][m][n] = (f32x4){0.f, 0.f, 0.f, 0.f};
    bf16x8 At[4][2], B0[2][2], B1[2][2];
    const char* cA = (const char*)(g.A + (size_t)cur.g * g.gA) + (size_t)cur.pm * tstepA; const char* cB = (const char*)(g.Bt + (size_t)cur.g * g.gB) + (size_t)cur.pn * tstepB;
    PG8_STAGE(PG8_SB(0, 0), cB, voffB); PG8_STAGE(PG8_SB(0, 1), cB + hstepB, voffB); PG8_STAGE(PG8_SA(0, 0), cA, voffA); PG8_STAGE(PG8_SA(0, 1), cA + hstepA, voffA);
    if (wr == 1) PG8_BAR;
    PG8_WAIT_V(2); PG8_BAR;
    PG8_STAGE(PG8_SB(1, 0), cB + kstep, voffB); PG8_STAGE(PG8_SA(1, 0), cA + kstep, voffA); PG8_STAGE(PG8_SB(1, 1), cB + hstepB + kstep, voffB);
    PG8_WAIT_V(6); PG8_BAR;
    for (;;) {
        const bool has_next = S.next(ui + 1, nxt);
        const char* nA = has_next ? (const char*)(g.A + (size_t)nxt.g * g.gA) + (size_t)nxt.pm * tstepA : cA; const char* nB = has_next ? (const char*)(g.Bt + (size_t)nxt.g * g.gB) + (size_t)nxt.pn * tstepB : cB;
        for (int t = 0; t < nt; t += 2) {
            const bool last = (t == nt - 2);
            const char* a1 = cA + (size_t)(t + 1) * kstep;
            const char* a2 = last ? nA : cA + (size_t)(t + 2) * kstep; const char* b2 = last ? nB : cB + (size_t)(t + 2) * kstep;
            const char* a3 = a2 + kstep; const char* b3 = b2 + kstep;
            PG8_LDB(B0, 0, 0); PG8_LDB(B1, 0, 1); PG8_SCHED; PG8_LDA(At, 0, 0); PG8_STAGE(PG8_SA(1, 1), a1 + hstepA, voffA);
            PG8_WAIT_V(8); PG8_WAIT_L(0); PG8_BAR; PG8_MMA(0, 0, At, B0); PG8_MMA(0, 1, At, B1); PG8_BAR; PG8_SCHED;
            PG8_LDA(At, 0, 1); PG8_STAGE(PG8_SB(0, 0), b2, voffB); PG8_STAGE(PG8_SB(0, 1), b2 + hstepB, voffB); PG8_STAGE(PG8_SA(0, 0), a2, voffA);
            PG8_WAIT_V(8); PG8_WAIT_L(0); PG8_BAR; PG8_MMA(1, 0, At, B0); PG8_MMA(1, 1, At, B1); PG8_BAR; PG8_SCHED;
            PG8_LDB(B0, 1, 0); PG8_LDB(B1, 1, 1); PG8_SCHED; PG8_LDA(At, 1, 0); PG8_STAGE(PG8_SA(0, 1), a2 + hstepA, voffA);
            PG8_WAIT_V(8); PG8_WAIT_L(0); PG8_BAR; PG8_MMA(0, 0, At, B0); PG8_MMA(0, 1, At, B1); PG8_BAR; PG8_SCHED;
            PG8_LDA(At, 1, 1); PG8_STAGE(PG8_SB(1, 0), b3, voffB); PG8_STAGE(PG8_SB(1, 1), b3 + hstepB, voffB); PG8_STAGE(PG8_SA(1, 0), a3, voffA);
            PG8_WAIT_V(8); PG8_WAIT_L(0); PG8_BAR; PG8_MMA(1, 0, At, B0); PG8_MMA(1, 1, At, B1); PG8_BAR; PG8_SCHED;
        }
        if (wr == 0) PG8_BAR;
        if constexpr (!Epi::AFTER_DRAIN) E(acc, cur, wr, wc, fr, fq);
        if (!has_next) break;
        if constexpr (!Epi::KEEP_ACC) {
#pragma unroll
        for (int a = 0; a < 2; ++a)
#pragma unroll
            for (int b = 0; b < 2; ++b)
#pragma unroll
                for (int m = 0; m < 4; ++m)
#pragma unroll
                    for (int n = 0; n < 2; ++n) acc[a][b][m][n] = (f32x4){0.f, 0.f, 0.f, 0.f};
        }
        cur = nxt; cA = nA; cB = nB; ++ui;
        if (wr == 1) PG8_BAR;
    }
    PG8_WAIT_V(0);
    PG8_BAR;
    if constexpr (Epi::AFTER_DRAIN) E.fused(acc, cur, wr, wc, fr, fq, lds);
#undef PG8_SA
#undef PG8_SB
#undef PG8_STAGE
#undef PG8_LDA
#undef PG8_LDB
#undef PG8_MMA
#undef PG8_WAIT_V
#undef PG8_WAIT_L
#undef PG8_BAR
#undef PG8_SCHED
}

struct EpiF32 {
    static constexpr bool PERM = false, AFTER_DRAIN = false, KEEP_ACC = false;
    float* C; int ldc;
    __device__ __forceinline__ void operator()(const f32x4 (&acc)[2][2][4][2], const Unit& u, int wr, int wc, int fr, int fq) const {
        const int row0 = u.pm * BM + wr * 64 + fr, col0 = u.pn * BM + wc * 32 + 4 * fq;
#pragma unroll
        for (int ai = 0; ai < 2; ++ai)
#pragma unroll
            for (int m = 0; m < 4; ++m) { float* rowp = C + (size_t)(row0 + ai * HALF + m * 16) * ldc + col0;
#pragma unroll
                for (int bj = 0; bj < 2; ++bj)
#pragma unroll
                    for (int n = 0; n < 2; ++n) *(f32x4*)(rowp + bj * HALF + n * 16) = acc[ai][bj][m][n]; }
    }
};
struct EpiSplit {
    static constexpr bool PERM = true, AFTER_DRAIN = false, KEEP_ACC = false;
    bf16_t* O0; int ld0; bf16_t* O1; int ld1; int split; const float* bias1;
    __device__ __forceinline__ void operator()(const f32x4 (&acc)[2][2][4][2], const Unit& u, int wr, int wc, int fr, int fq) const {
        const int row0 = u.pm * BM + wr * 64 + fr;
        const bool second = u.pn >= split;
        bf16_t* base = second ? O1 : O0; const int ld = second ? ld1 : ld0;
        const int col0 = (second ? (u.pn - split) : u.pn) * BM + wc * 32 + 8 * fq;
        const bool sig = second && (bias1 != nullptr);
        f32x4 bv[2][2];
#pragma unroll
        for (int bj = 0; bj < 2; ++bj)
#pragma unroll
            for (int n = 0; n < 2; ++n) bv[bj][n] = sig ? *(const f32x4*)(bias1 + col0 + bj * HALF + 4 * n) : (f32x4){0.f, 0.f, 0.f, 0.f};
#pragma unroll
        for (int ai = 0; ai < 2; ++ai)
#pragma unroll
            for (int m = 0; m < 4; ++m) { bf16_t* rowp = base + (size_t)(row0 + ai * HALF + m * 16) * ld + col0;
#pragma unroll
                for (int bj = 0; bj < 2; ++bj) { f32x4 v0 = acc[ai][bj][m][0] + bv[bj][0], v1 = acc[ai][bj][m][1] + bv[bj][1];
                    if (sig) {
#pragma unroll
                        for (int j = 0; j < 4; ++j) { v0[j] = __builtin_amdgcn_rcpf(1.0f + __expf(-v0[j])); v1[j] = __builtin_amdgcn_rcpf(1.0f + __expf(-v1[j])); } }
                    u32x4 w; w.x = cvt_pk_bf16(v0[0], v0[1]); w.y = cvt_pk_bf16(v0[2], v0[3]); w.z = cvt_pk_bf16(v1[0], v1[1]); w.w = cvt_pk_bf16(v1[2], v1[3]);
                    *(u32x4*)(rowp + bj * HALF) = w; } }
    }
};
struct EpiMerge {
    static constexpr bool PERM = true, AFTER_DRAIN = false, KEEP_ACC = true;
    const bf16_t* GT; bf16_t* MG;
    __device__ __forceinline__ void operator()(f32x4 (&acc)[2][2][4][2], const Unit& u, int wr, int wc, int fr, int fq) const {
        const int row0 = u.pm * BM + wr * 64 + fr, col0 = u.pn * BM + wc * 32 + 8 * fq;
        const bool last = (u.g == 2);
#pragma unroll
        for (int ai = 0; ai < 2; ++ai) {
            u32x4 gw[4][2], gn[4][2];
#pragma unroll
            for (int m = 0; m < 4; ++m)
#pragma unroll
                for (int bj = 0; bj < 2; ++bj) { const size_t row = (size_t)(row0 + ai * HALF + m * 16); const int col = col0 + bj * HALF;
                    gw[m][bj] = *(const u32x4*)(GT + row * GC + u.g * 1024 + col);
                    gn[m][bj] = last ? (u32x4){0x3f803f80u, 0x3f803f80u, 0x3f803f80u, 0x3f803f80u} : *(const u32x4*)(GT + row * GC + (u.g + 1) * 1024 + col); }
#pragma unroll
            for (int m = 0; m < 4; ++m)
#pragma unroll
                for (int bj = 0; bj < 2; ++bj) { const size_t row = (size_t)(row0 + ai * HALF + m * 16); const int col = col0 + bj * HALF;
                    float gf[8], nf[8], v[8]; unpack8(gw[m][bj], gf); unpack8(gn[m][bj], nf);
#pragma unroll
                    for (int j = 0; j < 4; ++j) { v[j] = gf[j] * acc[ai][bj][m][0][j]; v[4 + j] = gf[4 + j] * acc[ai][bj][m][1][j]; }
                    if (last) { *(u32x4*)(MG + row * 1024 + col) = pack8(v); acc[ai][bj][m][0] = (f32x4){0.f, 0.f, 0.f, 0.f}; acc[ai][bj][m][1] = (f32x4){0.f, 0.f, 0.f, 0.f}; }
                    else {
#pragma unroll
                        for (int j = 0; j < 4; ++j) { acc[ai][bj][m][0][j] = v[j] * __builtin_amdgcn_rcpf(fmaxf(nf[j], 1e-30f)); acc[ai][bj][m][1][j] = v[4 + j] * __builtin_amdgcn_rcpf(fmaxf(nf[4 + j], 1e-30f)); } }
                }
        }
    }
};

__device__ __forceinline__ float dpp_row_shr1(float x) { return __int_as_float(__builtin_amdgcn_update_dpp(0, __float_as_int(x), 0x111, 0xf, 0xf, false)); }
__device__ __forceinline__ float dpp_row_shr2(float x) { return __int_as_float(__builtin_amdgcn_update_dpp(0, __float_as_int(x), 0x112, 0xf, 0xf, false)); }
__device__ __forceinline__ float dpp_row_ror1(float x) { return __int_as_float(__builtin_amdgcn_update_dpp(0, __float_as_int(x), 0x121, 0xf, 0xf, false)); }
__device__ __forceinline__ float dpp_row_ror2(float x) { return __int_as_float(__builtin_amdgcn_update_dpp(0, __float_as_int(x), 0x122, 0xf, 0xf, false)); }
__device__ __forceinline__ f32x2 gelu_tanh_mul2(f32x2 gt, f32x2 up) {
    const f32x2 g2 = gt * gt;
    const f32x2 t = gt * (g2 * 0.044715f + 1.0f);
    const f32x2 sx = t * (-2.0f * 0.7978845608028654f * 1.4426950408889634f);
    f32x2 e; e.x = __builtin_amdgcn_exp2f(sx.x); e.y = __builtin_amdgcn_exp2f(sx.y);
    const f32x2 d = e + 1.0f;
    f32x2 r; r.x = __builtin_amdgcn_rcpf(d.x); r.y = __builtin_amdgcn_rcpf(d.y);
    return gt * r * up;
}
__device__ __forceinline__ float gelu_tanh_mul(float gt, float up) {
    const float uu = 0.7978845608028654f * (gt + 0.044715f * gt * gt * gt);
    return gt * __builtin_amdgcn_rcpf(1.0f + __expf(-2.0f * uu)) * up;
}
struct EpiFFN {
    static constexpr bool PERM = true, AFTER_DRAIN = false, KEEP_ACC = false;
    bf16_t* ACT; float* HG; float* HU; const float* cw; const float* cb; LAS unsigned char* xlds;
    __device__ __forceinline__ void operator()(const f32x4 (&acc)[2][2][4][2], const Unit& u, int wr, int wc, int fr, int fq) const {
        const int chl = wc * 32 + 8 * fq, chg = u.pn * 128 + chl;
        LAS float* XG = (LAS float*)xlds;
        if (fr >= 14) {
#pragma unroll
            for (int ai = 0; ai < 2; ++ai) { LAS float* p = XG + ((2 * ai + wr) * 2 + (fr - 14)) * 128 + chl; *(LAS f32x4*)p = acc[ai][0][3][0]; *(LAS f32x4*)(p + 4) = acc[ai][0][3][1]; }
            if (wr == 1) { float* hp = HG + ((size_t)u.pm * 4 + 2 + (fr - 14)) * FF + chg; *(f32x4*)hp = acc[1][0][3][0]; *(f32x4*)(hp + 4) = acc[1][0][3][1]; }
        }
        if (fr < 2 && wr == 0) {
            float* hp = HG + ((size_t)u.pm * 4 + fr) * FF + chg; *(f32x4*)hp = acc[0][0][0][0]; *(f32x4*)(hp + 4) = acc[0][0][0][1];
            float* up = HU + ((size_t)u.pm * 2 + fr) * FF + chg; *(f32x4*)up = acc[0][1][0][0]; *(f32x4*)(up + 4) = acc[0][1][0][1];
        }
        asm volatile("s_waitcnt lgkmcnt(0)" ::: "memory"); __builtin_amdgcn_s_barrier(); asm volatile("" ::: "memory");
        float w0[8], w1[8], w2[8], bb[8];
        { const f32x4 a0 = *(const f32x4*)(cw + chg), a1 = *(const f32x4*)(cw + chg + 4), b0 = *(const f32x4*)(cw + FF + chg), b1 = *(const f32x4*)(cw + FF + chg + 4),
                      c0 = *(const f32x4*)(cw + 2 * FF + chg), c1 = *(const f32x4*)(cw + 2 * FF + chg + 4), d0 = *(const f32x4*)(cb + chg), d1 = *(const f32x4*)(cb + chg + 4);
#pragma unroll
          for (int j = 0; j < 4; ++j) { w0[j] = a0[j]; w0[4 + j] = a1[j]; w1[j] = b0[j]; w1[4 + j] = b1[j]; w2[j] = c0[j]; w2[4 + j] = c1[j]; bb[j] = d0[j]; bb[4 + j] = d1[j]; } }
#pragma unroll
        for (int ai = 0; ai < 2; ++ai)
#pragma unroll
            for (int m = 0; m < 4; ++m) {
                const int B = 2 * ai + wr;
                float g8[8], u8[8], q15[8], q14[8], o[8];
#pragma unroll
                for (int j = 0; j < 4; ++j) { g8[j] = acc[ai][0][m][0][j]; g8[4 + j] = acc[ai][0][m][1][j]; u8[j] = acc[ai][1][m][0][j]; u8[4 + j] = acc[ai][1][m][1][j]; }
                if (m == 0) {
                    if (B > 0) { const LAS float* p = XG + ((B - 1) * 2) * 128 + chl; const f32x4 r0a = *(const LAS f32x4*)p, r0b = *(const LAS f32x4*)(p + 4), r1a = *(const LAS f32x4*)(p + 128), r1b = *(const LAS f32x4*)(p + 132);
#pragma unroll
                        for (int j = 0; j < 4; ++j) { q14[j] = r0a[j]; q14[4 + j] = r0b[j]; q15[j] = r1a[j]; q15[4 + j] = r1b[j]; } }
                    else {
#pragma unroll
                        for (int j = 0; j < 8; ++j) { q14[j] = 0.f; q15[j] = 0.f; } }
                    float p1a[8], p2a[8];
#pragma unroll
                    for (int e = 0; e < 8; ++e) { const float s1 = dpp_row_shr1(g8[e]), s2 = dpp_row_shr2(g8[e]);
                        p1a[e] = (fr >= 1) ? s1 : q15[e]; p2a[e] = (fr >= 2) ? s2 : ((fr == 1) ? q15[e] : q14[e]); }
#pragma unroll
                    for (int e = 0; e < 8; e += 2) { const f32x2 gt = (f32x2){w0[e], w0[e + 1]} * (f32x2){p2a[e], p2a[e + 1]} + (f32x2){w1[e], w1[e + 1]} * (f32x2){p1a[e], p1a[e + 1]} + (f32x2){w2[e], w2[e + 1]} * (f32x2){g8[e], g8[e + 1]} + (f32x2){bb[e], bb[e + 1]};
                        const f32x2 r = gelu_tanh_mul2(gt, (f32x2){u8[e], u8[e + 1]}); o[e] = r.x; o[e + 1] = r.y; }
                } else {
                    float p1a[8], p2a[8];
#pragma unroll
                    for (int e = 0; e < 8; ++e) { const float pv = (e < 4) ? acc[ai][0][m - 1][0][e & 3] : acc[ai][0][m - 1][1][e & 3];
                        const float s1 = dpp_row_shr1(g8[e]), s2 = dpp_row_shr2(g8[e]), r1 = dpp_row_ror1(pv), r2 = dpp_row_ror2(pv);
                        p1a[e] = (fr >= 1) ? s1 : r1; p2a[e] = (fr >= 2) ? s2 : r2; }
#pragma unroll
                    for (int e = 0; e < 8; e += 2) { const f32x2 gt = (f32x2){w0[e], w0[e + 1]} * (f32x2){p2a[e], p2a[e + 1]} + (f32x2){w1[e], w1[e + 1]} * (f32x2){p1a[e], p1a[e + 1]} + (f32x2){w2[e], w2[e + 1]} * (f32x2){g8[e], g8[e + 1]} + (f32x2){bb[e], bb[e + 1]};
                        const f32x2 r = gelu_tanh_mul2(gt, (f32x2){u8[e], u8[e + 1]}); o[e] = r.x; o[e + 1] = r.y; }
                }
                const int rloc = 128 * ai + 64 * wr + 16 * m + fr;
                if (!(B == 0 && m == 0 && fr < 2)) *(u32x4*)(ACT + (size_t)(u.pm * BM + rloc) * FF + chg) = pack8(o);
            }
    }
};

struct EpiNormRes {
    static constexpr bool PERM = false, AFTER_DRAIN = true, KEEP_ACC = false;
    const float* xin; float* xout; bf16_t* H2; const float* g1; const float* g2; unsigned* xs1; unsigned* xs2; unsigned* cnt1; unsigned* cnt2;
    __device__ __forceinline__ void exchange(const f32x4 (&v)[2][2][4][2], const Unit& u, int wr, int wc, int fr, int fq, LAS unsigned char* lds, unsigned* xs, unsigned* cnt) const {
        LAS float* Pp = (LAS float*)lds;
        LAS float* S = (LAS float*)(lds + 4096);
        const int tid = get_tid();
#pragma unroll
        for (int ai = 0; ai < 2; ++ai)
#pragma unroll
            for (int m = 0; m < 4; ++m) { float sq = 0.f;
#pragma unroll
                for (int bj = 0; bj < 2; ++bj)
#pragma unroll
                    for (int n = 0; n < 2; ++n) { const f32x4 x = v[ai][bj][m][n]; sq += (x[0] * x[0] + x[1] * x[1]) + (x[2] * x[2] + x[3] * x[3]); }
                sq += __shfl_xor(sq, 16); sq += __shfl_xor(sq, 32);
                if (fq == 0) Pp[(ai * HALF + wr * 64 + m * 16 + fr) * 4 + wc] = sq; }
        asm volatile("s_waitcnt lgkmcnt(0)" ::: "memory"); __builtin_amdgcn_s_barrier(); asm volatile("" ::: "memory");
        if (tid < 256) { const f32x4 p = *(const LAS f32x4*)(Pp + tid * 4);
            __hip_atomic_store(xs + ((size_t)(u.pm * BM + tid)) * 4 + u.pn, __float_as_uint((p[0] + p[1]) + (p[2] + p[3])), __ATOMIC_RELAXED, __HIP_MEMORY_SCOPE_AGENT); }
        asm volatile("s_waitcnt vmcnt(0)" ::: "memory");
        __syncthreads();
        if (tid == 0) {
            __hip_atomic_fetch_add(cnt + u.pm * 4, 1u, __ATOMIC_RELAXED, __HIP_MEMORY_SCOPE_AGENT);
            unsigned sp = 0u;
            while (__hip_atomic_load(cnt + u.pm * 4, __ATOMIC_RELAXED, __HIP_MEMORY_SCOPE_AGENT) < 4u) { __builtin_amdgcn_s_sleep(1); if (++sp > (1u << 22)) break; }
            __builtin_amdgcn_fence(__ATOMIC_ACQUIRE, "agent");
            asm volatile("s_waitcnt vmcnt(0)" ::: "memory");
        }
        __syncthreads();
        if (tid < 256) { const unsigned* q = xs + ((size_t)(u.pm * BM + tid)) * 4; float t = 0.f;
#pragma unroll
            for (int k = 0; k < 4; ++k) t += __uint_as_float(__hip_atomic_load(q + k, __ATOMIC_RELAXED, __HIP_MEMORY_SCOPE_AGENT));
            S[tid] = rsqrtf(t * (1.0f / 1024.0f) + EPS); }
        asm volatile("s_waitcnt lgkmcnt(0)" ::: "memory"); __syncthreads();
    }
    __device__ __forceinline__ void fused(f32x4 (&acc)[2][2][4][2], const Unit& u, int wr, int wc, int fr, int fq, LAS unsigned char* lds) const {
        const LAS float* S = (const LAS float*)(lds + 4096);
        const int col0 = u.pn * BM + wc * 32 + 4 * fq;
        exchange(acc, u, wr, wc, fr, fq, lds, xs1, cnt1);
        {
            f32x4 gv[2][2];
#pragma unroll
            for (int bj = 0; bj < 2; ++bj)
#pragma unroll
                for (int n = 0; n < 2; ++n) gv[bj][n] = *(const f32x4*)(g1 + col0 + bj * HALF + n * 16);
#pragma unroll
            for (int ai = 0; ai < 2; ++ai) {
                f32x4 xv[4][2][2];
#pragma unroll
                for (int m = 0; m < 4; ++m)
#pragma unroll
                    for (int bj = 0; bj < 2; ++bj)
#pragma unroll
                        for (int n = 0; n < 2; ++n) xv[m][bj][n] = *(const f32x4*)(xin + (size_t)(u.pm * BM + ai * HALF + wr * 64 + m * 16 + fr) * DM + col0 + bj * HALF + n * 16);
#pragma unroll
                for (int m = 0; m < 4; ++m) { const int r = ai * HALF + wr * 64 + m * 16 + fr; const float r1 = S[r];
#pragma unroll
                    for (int bj = 0; bj < 2; ++bj)
#pragma unroll
                        for (int n = 0; n < 2; ++n) { acc[ai][bj][m][n] = xv[m][bj][n] + acc[ai][bj][m][n] * r1 * gv[bj][n];
                            *(f32x4*)(xout + (size_t)(u.pm * BM + r) * DM + col0 + bj * HALF + n * 16) = acc[ai][bj][m][n]; } }
            }
        }
        asm volatile("s_waitcnt lgkmcnt(0)" ::: "memory"); __syncthreads();
        exchange(acc, u, wr, wc, fr, fq, lds, xs2, cnt2);
        {
            f32x4 gv[2][2];
#pragma unroll
            for (int bj = 0; bj < 2; ++bj)
#pragma unroll
                for (int n = 0; n < 2; ++n) gv[bj][n] = *(const f32x4*)(g2 + col0 + bj * HALF + n * 16);
#pragma unroll
            for (int ai = 0; ai < 2; ++ai)
#pragma unroll
                for (int m = 0; m < 4; ++m) { const int r = ai * HALF + wr * 64 + m * 16 + fr; const float r2 = S[r];
#pragma unroll
                    for (int bj = 0; bj < 2; ++bj)
#pragma unroll
                        for (int n = 0; n < 2; ++n) { const f32x4 h = acc[ai][bj][m][n] * r2 * gv[bj][n]; u32x2 w; w.x = cvt_pk_bf16(h[0], h[1]); w.y = cvt_pk_bf16(h[2], h[3]);
                            *(u32x2*)(H2 + (size_t)(u.pm * BM + r) * DM + col0 + bj * HALF + n * 16) = w; } }
        }
        asm volatile("s_waitcnt lgkmcnt(0)" ::: "memory"); __syncthreads();
    }
    __device__ __forceinline__ void operator()(const f32x4 (&)[2][2][4][2], const Unit&, int, int, int, int) const {}
};
}

__device__ __forceinline__ void transpose_tile(const float* src, int ld, int k0, int n0s, bf16_t* dst, int dk, int n0d, LAS float* tile) {
    const int tid = get_tid();
    { const int r = tid >> 4, c4 = (tid & 15) * 4;
#pragma unroll
      for (int i = 0; i < 2; ++i) { const f32x4 v = *(const f32x4*)(src + (size_t)(k0 + r + 32 * i) * ld + n0s + c4);
          LAS float* t = tile + (r + 32 * i) * 65 + c4; t[0] = v[0]; t[1] = v[1]; t[2] = v[2]; t[3] = v[3]; } }
    __syncthreads();
    { const int n = tid >> 3, ks = (tid & 7) * 8; float e[8];
#pragma unroll
      for (int j = 0; j < 8; ++j) e[j] = tile[(ks + j) * 65 + n];
      *(u32x4*)(dst + (size_t)(n0d + n) * dk + k0 + ks) = pack8(e); }
    __syncthreads();
}

__device__ void phase_convert(const Params& P, int l, LAS unsigned char* lds) {
    LAS float* tile = (LAS float*)lds;
    unsigned char* ws = P.ws;
    bf16_t* W1 = (bf16_t*)(ws + WS_W1); bf16_t* WBR = (bf16_t*)(ws + WS_WBR); bf16_t* WMO = (bf16_t*)(ws + WS_WMO); bf16_t* WFF = (bf16_t*)(ws + WS_WFF); bf16_t* WD = (bf16_t*)(ws + WS_WD);
    const float* win = P.w_in + (size_t)l * 1024 * IN_COLS;
#define SEG(src, ld, ktiles, ntiles, n0s, dst, dk, n0d) if (r < (ktiles) * (ntiles)) { const int kt = r / (ntiles), ntl = r % (ntiles); transpose_tile(src, ld, kt * 64, (n0s) + ntl * 64, dst, dk, (n0d) + ntl * 64, tile); continue; } r -= (ktiles) * (ntiles);
    constexpr int total = 16 * 120 + 16 * 48 + 3 * 8 * 16 + 16 * 16 + 16 * 44 + 16 * 44 + 44 * 16;
    for (int it = blockIdx.x; it < total; it += gridDim.x) {
        int r = it;
        SEG(win, IN_COLS, 16, 8, 0, W1, 1024, ZQ)
        SEG(win, IN_COLS, 16, 8, 512, W1, 1024, ZV)
        SEG(win, IN_COLS, 16, 8, 1024, W1, 1024, ZG)
        SEG(win, IN_COLS, 16, 8, 1552, W1, 1024, ZSB)
        SEG(win, IN_COLS, 16, 8, 2064, W1, 1024, ZSC)
        SEG(win, IN_COLS, 16, 8, 2576, W1, 1024, ZSX)
        SEG(win, IN_COLS, 16, 72, 3088, W1, 1024, ZDQ)
        SEG(P.w_gate + (size_t)l * 1024 * 3072, 3072, 16, 48, 0, W1, 1024, 7680)
        SEG(P.w_branch + ((size_t)l * 3 + 0) * 512 * 1024, 1024, 8, 16, 0, WBR, 512, 0)
        SEG(P.w_branch + ((size_t)l * 3 + 1) * 512 * 1024, 1024, 8, 16, 0, WBR + (size_t)1024 * 512, 512, 0)
        SEG(P.w_branch + ((size_t)l * 3 + 2) * 512 * 1024, 1024, 8, 16, 0, WBR + (size_t)2 * 1024 * 512, 512, 0)
        SEG(P.w_mix_out + (size_t)l * 1024 * 1024, 1024, 16, 16, 0, WMO, 1024, 0)
        if (r < 16 * 44) { const int kt = r / 44, ntl = r % 44; transpose_tile(P.w_ff_gate + (size_t)l * 1024 * FF, FF, kt * 64, ntl * 64, WFF, 1024, 256 * (ntl >> 1) + 64 * (ntl & 1), tile); continue; } r -= 16 * 44;
        if (r < 16 * 44) { const int kt = r / 44, ntl = r % 44; transpose_tile(P.w_ff_up + (size_t)l * 1024 * FF, FF, kt * 64, ntl * 64, WFF, 1024, 256 * (ntl >> 1) + 128 + 64 * (ntl & 1), tile); continue; } r -= 16 * 44;
        SEG(P.w_ff_down + (size_t)l * FF * 1024, 1024, 44, 16, 0, WD, FF, 0)
    }
#undef SEG
    { const int t = get_tid();
      if (l == 0 && blockIdx.x == 0 && t < 64) ((float*)(ws + WS_RC))[t] = exp2f(-(float)t * (13.287712379549449f / 64.0f)); }
}

__device__ __forceinline__ float wave_sum(float v) {
#pragma unroll
    for (int o = 32; o >= 1; o >>= 1) v += __shfl_xor(v, o);
    return v;
}

__device__ void phase_norm_alow(const Params& P, int l, int half, LAS unsigned char* lds) {
    const int tid = get_tid(), lane = tid & 63, wave = tid >> 6;
    LAS float* WaT = (LAS float*)lds;
    const float* win = P.w_in + (size_t)l * 1024 * IN_COLS + 1536;
    for (int i = tid; i < 1024 * 4; i += NTHR) { const int k = i >> 2, c4 = (i & 3) * 4; const f32x4 v = *(const f32x4*)(win + (size_t)k * IN_COLS + c4);
        WaT[(c4 + 0) * 1024 + k] = v[0]; WaT[(c4 + 1) * 1024 + k] = v[1]; WaT[(c4 + 2) * 1024 + k] = v[2]; WaT[(c4 + 3) * 1024 + k] = v[3]; }
    __syncthreads();
    const float* xs = (l == 0 ? P.x : P.out) + (size_t)half * TH * DM;
    const float* gg = P.pre_mix_g + (size_t)l * DM;
    bf16_t* H = (bf16_t*)(P.ws + WS_H) + (size_t)half * TH * DM; float* AL = (float*)(P.ws + WS_ALOW);
    f32x4 gv[4];
#pragma unroll
    for (int i = 0; i < 4; ++i) gv[i] = *(const f32x4*)(gg + i * 256 + lane * 4);
    const int rstride = gridDim.x * 8;
    int row = blockIdx.x * 8 + wave;
    f32x4 nv[4];
    if (row < TH) {
#pragma unroll
        for (int i = 0; i < 4; ++i) nv[i] = *(const f32x4*)(xs + (size_t)row * DM + i * 256 + lane * 4);
    }
    for (; row < TH; row += rstride) {
        f32x4 v[4]; float ss = 0.f;
#pragma unroll
        for (int i = 0; i < 4; ++i) { v[i] = nv[i]; ss += v[i][0] * v[i][0] + v[i][1] * v[i][1] + v[i][2] * v[i][2] + v[i][3] * v[i][3]; }
        if (row + rstride < TH) {
#pragma unroll
            for (int i = 0; i < 4; ++i) nv[i] = *(const f32x4*)(xs + (size_t)(row + rstride) * DM + i * 256 + lane * 4);
        }
        ss = wave_sum(ss);
        const float r = rsqrtf(ss * (1.0f / DM) + EPS);
        float a[16];
#pragma unroll
        for (int c = 0; c < 16; ++c) a[c] = 0.f;
#pragma unroll
        for (int i = 0; i < 4; ++i) { f32x4 h = v[i] * r * gv[i];
            u32x2 w; w.x = cvt_pk_bf16(h[0], h[1]); w.y = cvt_pk_bf16(h[2], h[3]);
            *(u32x2*)(H + (size_t)row * DM + i * 256 + lane * 4) = w;
#pragma unroll
            for (int c = 0; c < 16; ++c) { const f32x4 wv = *(const LAS f32x4*)(WaT + c * 1024 + i * 256 + lane * 4); a[c] += h[0] * wv[0] + h[1] * wv[1] + h[2] * wv[2] + h[3] * wv[3]; } }
        float b8[8], b4[4], b2[2], b1;
        { const bool up = (lane & 32) != 0;
#pragma unroll
          for (int c = 0; c < 8; ++c) { const float keep = up ? a[c + 8] : a[c], send = up ? a[c] : a[c + 8]; b8[c] = keep + __shfl_xor(send, 32); } }
        { const bool up = (lane & 16) != 0;
#pragma unroll
          for (int c = 0; c < 4; ++c) { const float keep = up ? b8[c + 4] : b8[c], send = up ? b8[c] : b8[c + 4]; b4[c] = keep + __shfl_xor(send, 16); } }
        { const bool up = (lane & 8) != 0;
#pragma unroll
          for (int c = 0; c < 2; ++c) { const float keep = up ? b4[c + 2] : b4[c], send = up ? b4[c] : b4[c + 2]; b2[c] = keep + __shfl_xor(send, 8); } }
        { const bool up = (lane & 4) != 0; const float keep = up ? b2[1] : b2[0], send = up ? b2[0] : b2[1]; b1 = keep + __shfl_xor(send, 4); }
        b1 += __shfl_xor(b1, 2); b1 += __shfl_xor(b1, 1);
        if ((lane & 3) == 0) { const int co = ((lane >> 5) & 1) * 8 + ((lane >> 4) & 1) * 4 + ((lane >> 3) & 1) * 2 + ((lane >> 2) & 1); AL[(size_t)row * 16 + co] = b1; }
    }
}

__device__ void phase_resid(const float* xin, float* xout, const bf16_t* Y, const float* pg, const float* ng, bf16_t* H2, int nrows) {
    const int tid = get_tid(), lane = tid & 63, wave = tid >> 6;
    f32x4 pgv[4], ngv[4];
#pragma unroll
    for (int i = 0; i < 4; ++i) { pgv[i] = *(const f32x4*)(pg + i * 256 + lane * 4); ngv[i] = ng ? *(const f32x4*)(ng + i * 256 + lane * 4) : (f32x4){0.f, 0.f, 0.f, 0.f}; }
    const int stride = gridDim.x * 8;
    int row = blockIdx.x * 8 + wave;
    u32x2 ny[4]; f32x4 nx[4];
    if (row < nrows) {
#pragma unroll
        for (int i = 0; i < 4; ++i) { ny[i] = *(const u32x2*)(Y + (size_t)row * DM + i * 256 + lane * 4); nx[i] = *(const f32x4*)(xin + (size_t)row * DM + i * 256 + lane * 4); }
    }
    for (; row < nrows; row += stride) {
        f32x4 y[4], xv[4];
#pragma unroll
        for (int i = 0; i < 4; ++i) { y[i] = (f32x4){bflo(ny[i].x), bfhi(ny[i].x), bflo(ny[i].y), bfhi(ny[i].y)}; xv[i] = nx[i]; }
        const int rn = row + stride;
        if (rn < nrows) {
#pragma unroll
            for (int i = 0; i < 4; ++i) { ny[i] = *(const u32x2*)(Y + (size_t)rn * DM + i * 256 + lane * 4); nx[i] = *(const f32x4*)(xin + (size_t)rn * DM + i * 256 + lane * 4); }
        }
        float ss = 0.f;
#pragma unroll
        for (int i = 0; i < 4; ++i) ss += y[i][0] * y[i][0] + y[i][1] * y[i][1] + y[i][2] * y[i][2] + y[i][3] * y[i][3];
        ss = wave_sum(ss);
        const float r = rsqrtf(ss * (1.0f / DM) + EPS);
        float s2 = 0.f;
#pragma unroll
        for (int i = 0; i < 4; ++i) { xv[i] = xv[i] + y[i] * r * pgv[i]; *(f32x4*)(xout + (size_t)row * DM + i * 256 + lane * 4) = xv[i];
            s2 += xv[i][0] * xv[i][0] + xv[i][1] * xv[i][1] + xv[i][2] * xv[i][2] + xv[i][3] * xv[i][3]; }
        if (ng) {
            s2 = wave_sum(s2);
            const float r2 = rsqrtf(s2 * (1.0f / DM) + EPS);
#pragma unroll
            for (int i = 0; i < 4; ++i) { const f32x4 h = xv[i] * r2 * ngv[i]; u32x2 w; w.x = cvt_pk_bf16(h[0], h[1]); w.y = cvt_pk_bf16(h[2], h[3]);
                *(u32x2*)(H2 + (size_t)row * DM + i * 256 + lane * 4) = w; }
        }
    }
}

__device__ void phase_combine(const Params& P) {
    bf16_t* Z = (bf16_t*)(P.ws + WS_Z); const float* LSE = (const float*)(P.ws + WS_LSE);
    const int stride = gridDim.x * NTHR;
    for (int idx0 = blockIdx.x * NTHR + get_tid(); idx0 < TH * 64; idx0 += 2 * stride) {
        float lw[2][3]; u32x4 va[2], vb[2], vc[2]; bf16_t* pp[2]; bool ok[2];
#pragma unroll
        for (int k = 0; k < 2; ++k) { const int idx = idx0 + k * stride; ok[k] = idx < TH * 64; const int id2 = ok[k] ? idx : idx0;
            const int tok = id2 >> 6, c8 = id2 & 63, hh = c8 >> 4, d0 = (c8 & 15) * 8;
            lw[k][0] = LSE[tok * 12 + hh]; lw[k][1] = LSE[tok * 12 + 4 + hh]; lw[k][2] = LSE[tok * 12 + 8 + hh];
            pp[k] = Z + (size_t)tok * ZC + ZDQ + hh * 128 + d0;
            va[k] = *(const u32x4*)pp[k]; vb[k] = *(const u32x4*)(pp[k] + 512); vc[k] = *(const u32x4*)(pp[k] + 1024); }
#pragma unroll
        for (int k = 0; k < 2; ++k) {
            const float mx = fmaxf(lw[k][0], fmaxf(lw[k][1], lw[k][2]));
            float w0 = __expf(lw[k][0] - mx), w1 = __expf(lw[k][1] - mx), w2 = __expf(lw[k][2] - mx);
            const float inv = 1.0f / (w0 + w1 + w2); w0 *= inv; w1 *= inv; w2 *= inv;
            float a[8], b[8], c[8], o[8];
            unpack8(va[k], a); unpack8(vb[k], b); unpack8(vc[k], c);
#pragma unroll
            for (int j = 0; j < 8; ++j) o[j] = w0 * a[j] + w1 * b[j] + w2 * c[j];
            if (ok[k]) *(u32x4*)pp[k] = pack8(o);
        }
    }
}

__device__ void phase_ffn_fix(const Params& P, int l) {
    bf16_t* ACT = (bf16_t*)(P.ws + WS_U); const float* HG = (const float*)(P.ws + WS_HG); const float* HU = (const float*)(P.ws + WS_HU);
    const float* cw = P.ff_conv_w + (size_t)l * 3 * FF; const float* cb = P.ff_conv_b + (size_t)l * FF;
    for (int idx = blockIdx.x * NTHR + get_tid(); idx < 128 * (FF / 8); idx += gridDim.x * NTHR) {
        const int pm = idx / (FF / 8), c0 = (idx % (FF / 8)) * 8;
        float o0[8], o1[8];
#pragma unroll
        for (int hf = 0; hf < 2; ++hf) {
            const int c = c0 + 4 * hf;
            const f32x4 z = (f32x4){0.f, 0.f, 0.f, 0.f};
            const bool first = (pm & 7) == 0;
            const f32x4 gm2 = first ? z : *(const f32x4*)(HG + ((size_t)(pm - 1) * 4 + 2) * FF + c), gm1 = first ? z : *(const f32x4*)(HG + ((size_t)(pm - 1) * 4 + 3) * FF + c);
            const f32x4 g0 = *(const f32x4*)(HG + ((size_t)pm * 4 + 0) * FF + c), g1 = *(const f32x4*)(HG + ((size_t)pm * 4 + 1) * FF + c);
            const f32x4 u0 = *(const f32x4*)(HU + ((size_t)pm * 2 + 0) * FF + c), u1 = *(const f32x4*)(HU + ((size_t)pm * 2 + 1) * FF + c);
            const f32x4 w0 = *(const f32x4*)(cw + c), w1 = *(const f32x4*)(cw + FF + c), w2 = *(const f32x4*)(cw + 2 * FF + c), bb = *(const f32x4*)(cb + c);
#pragma unroll
            for (int j = 0; j < 4; ++j) { o0[4 * hf + j] = pg8::gelu_tanh_mul(w0[j] * gm2[j] + w1[j] * gm1[j] + w2[j] * g0[j] + bb[j], u0[j]);
                                          o1[4 * hf + j] = pg8::gelu_tanh_mul(w0[j] * gm1[j] + w1[j] * g0[j] + w2[j] * g1[j] + bb[j], u1[j]); }
        }
        *(u32x4*)(ACT + (size_t)(pm * 256 + 0) * FF + c0) = pack8(o0);
        *(u32x4*)(ACT + (size_t)(pm * 256 + 1) * FF + c0) = pack8(o1);
    }
}

__device__ __forceinline__ void sc_item(const Params& P, int l, int si) {
    bf16_t* Z = (bf16_t*)(P.ws + WS_Z);
    const int tid = get_tid(), cgi = tid & 63, run = tid >> 6, c0 = cgi * 8, t0 = si * 128 + run * 16;
    const float* cw = P.sc_conv_w + (size_t)l * 3 * 512;
    float w0[8], w1[8], w2[8];
#pragma unroll
    for (int j = 0; j < 8; ++j) { w0[j] = cw[c0 + j]; w1[j] = cw[512 + c0 + j]; w2[j] = cw[1024 + c0 + j]; }
    float p1[8], p2[8];
    if ((t0 & 2047) != 0) {
        float a[8], b[8];
        unpack8(*(const u32x4*)(Z + (size_t)(t0 - 1) * ZC + ZSC + c0), a); unpack8(*(const u32x4*)(Z + (size_t)(t0 - 1) * ZC + ZSX + c0), b);
#pragma unroll
        for (int j = 0; j < 8; ++j) p1[j] = a[j] * b[j];
        unpack8(*(const u32x4*)(Z + (size_t)(t0 - 2) * ZC + ZSC + c0), a); unpack8(*(const u32x4*)(Z + (size_t)(t0 - 2) * ZC + ZSX + c0), b);
#pragma unroll
        for (int j = 0; j < 8; ++j) p2[j] = a[j] * b[j];
    } else {
#pragma unroll
        for (int j = 0; j < 8; ++j) { p1[j] = 0.f; p2[j] = 0.f; } }
    for (int tt = 0; tt < 16; tt += 4) {
        u32x4 va[4], vb[4], vs[4];
#pragma unroll
        for (int k = 0; k < 4; ++k) { const bf16_t* zr = Z + (size_t)(t0 + tt + k) * ZC; va[k] = *(const u32x4*)(zr + ZSC + c0); vb[k] = *(const u32x4*)(zr + ZSX + c0); vs[k] = *(const u32x4*)(zr + ZSB + c0); }
#pragma unroll
        for (int k = 0; k < 4; ++k) {
            float a[8], b[8], sb[8], o[8];
            unpack8(va[k], a); unpack8(vb[k], b); unpack8(vs[k], sb);
#pragma unroll
            for (int j = 0; j < 8; ++j) { const float p0 = a[j] * b[j]; o[j] = sb[j] * (w0[j] * p2[j] + w1[j] * p1[j] + w2[j] * p0); p2[j] = p1[j]; p1[j] = p0; }
            *(u32x4*)(Z + (size_t)(t0 + tt + k) * ZC + ZSB + c0) = pack8(o);
        }
    }
}

__device__ __forceinline__ void attn_item(const Params& P, int half, int item, LAS unsigned char* lds, unsigned* ctr) {
    const int tid = get_tid(), lane = tid & 63, w = __builtin_amdgcn_readfirstlane(tid >> 6), g = lane >> 4, c = lane & 15;
    const int b = item / 192, rem = item % 192, gi = rem / 64, r2 = rem % 64;
    const int dil = (gi == 0) ? 1 : (gi == 1 ? 4 : 16), nb = 16 / dil;
    const int n = r2 % nb, t2 = r2 / nb, hh = t2 & 3, rr = t2 >> 2;
    bf16_t* Z = (bf16_t*)(P.ws + WS_Z);
    const float* RC = (const float*)(P.ws + WS_RC); const float* RS = (const float*)(P.ws + WS_RS);
    float* LSE = (float*)(P.ws + WS_LSE);
    const int colq = ZDQ + gi * 512 + hh * 128, colk = ZDK + gi * 512 + hh * 128, colv = ZDV + gi * 512 + hh * 128;
    const int rowb = b * 2048, gtb = half * TH;
    constexpr int KSTR = 272, VSTR = 528;
    LAS unsigned char* Ks = lds; LAS unsigned char* Vt = lds + 256 * KSTR;
    constexpr float QSCALE = 0.08838834764831845f * 1.4426950408889634f;

    const int km = tid >> 1, khf = tid & 1, klk = (n - 1) * 128 + km;
    const int vkb = tid & 31, vdb = tid >> 5, vlk0 = (n - 1) * 128 + vkb * 8;
    const int qi = 16 * w + c, qrow = rowb + (n * 128 + qi) * dil + rr;
    u32x4 kx1[4], kx2[4]; f32x4 kinv[8]; float kpos = 0.f;
    u32x4 rv[8];
    u32x4 qx1[2], qx2[2]; f32x4 qinv[4]; float qpos;
    if (klk >= 0) {
        const int krow = rowb + klk * dil + rr;
        const bf16_t* kp = Z + (size_t)krow * ZC + colk + khf * 32;
        kpos = (float)P.pos[gtb + krow];
#pragma unroll
        for (int cc = 0; cc < 4; ++cc) { kx1[cc] = *(const u32x4*)(kp + cc * 8); kx2[cc] = *(const u32x4*)(kp + 64 + cc * 8);
            kinv[2 * cc] = *(const f32x4*)(RC + khf * 32 + cc * 8); kinv[2 * cc + 1] = *(const f32x4*)(RC + khf * 32 + cc * 8 + 4); }
    } else {
#pragma unroll
        for (int cc = 0; cc < 4; ++cc) { kx1[cc] = (u32x4){0u, 0u, 0u, 0u}; kx2[cc] = (u32x4){0u, 0u, 0u, 0u};
            kinv[2 * cc] = (f32x4){0.f, 0.f, 0.f, 0.f}; kinv[2 * cc + 1] = (f32x4){0.f, 0.f, 0.f, 0.f}; }
    }
    if (vlk0 >= 0) {
#pragma unroll
        for (int kk = 0; kk < 8; ++kk) { const int row = rowb + (vlk0 + kk) * dil + rr; rv[kk] = *(const u32x4*)(Z + (size_t)row * ZC + colv + vdb * 8); }
    } else {
#pragma unroll
        for (int kk = 0; kk < 8; ++kk) rv[kk] = (u32x4){0u, 0u, 0u, 0u};
    }
    {
        const bf16_t* qp = Z + (size_t)qrow * ZC + colq + 8 * g;
        qpos = (float)P.pos[gtb + qrow];
#pragma unroll
        for (int kh = 0; kh < 2; ++kh) { qx1[kh] = *(const u32x4*)(qp + kh * 32); qx2[kh] = *(const u32x4*)(qp + 64 + kh * 32);
            qinv[2 * kh] = *(const f32x4*)(RC + kh * 32 + 8 * g); qinv[2 * kh + 1] = *(const f32x4*)(RC + kh * 32 + 8 * g + 4); }
    }
    {
        LAS unsigned char* kd = Ks + km * KSTR;
#pragma unroll
        for (int cc = 0; cc < 4; ++cc) {
            float x1[8], x2[8], o1[8], o2[8];
            unpack8(kx1[cc], x1); unpack8(kx2[cc], x2);
            f32x4 c0, c1, s0, s1;
#pragma unroll
            for (int j = 0; j < 4; ++j) { const float r0 = __builtin_amdgcn_fractf(kpos * kinv[2 * cc][j] * 0.15915494309189535f), r1 = __builtin_amdgcn_fractf(kpos * kinv[2 * cc + 1][j] * 0.15915494309189535f);
                c0[j] = __builtin_amdgcn_cosf(r0); s0[j] = __builtin_amdgcn_sinf(r0); c1[j] = __builtin_amdgcn_cosf(r1); s1[j] = __builtin_amdgcn_sinf(r1); }
#pragma unroll
            for (int j = 0; j < 4; ++j) { o1[j] = x1[j] * c0[j] - x2[j] * s0[j]; o2[j] = x2[j] * c0[j] + x1[j] * s0[j];
                o1[4 + j] = x1[4 + j] * c1[j] - x2[4 + j] * s1[j]; o2[4 + j] = x2[4 + j] * c1[j] + x1[4 + j] * s1[j]; }
            *(LAS u32x4*)(kd + (khf * 32 + cc * 8) * 2) = pack8(o1); *(LAS u32x4*)(kd + (64 + khf * 32 + cc * 8) * 2) = pack8(o2);
        }
    }
    {
#pragma unroll
        for (int dd = 0; dd < 8; ++dd) {
            const int wi = dd >> 1; u32x4 o;
            if (dd & 1) { o.x = __builtin_amdgcn_perm(rv[1][wi], rv[0][wi], 0x07060302u); o.y = __builtin_amdgcn_perm(rv[3][wi], rv[2][wi], 0x07060302u); o.z = __builtin_amdgcn_perm(rv[5][wi], rv[4][wi], 0x07060302u); o.w = __builtin_amdgcn_perm(rv[7][wi], rv[6][wi], 0x07060302u); }
            else { o.x = __builtin_amdgcn_perm(rv[1][wi], rv[0][wi], 0x05040100u); o.y = __builtin_amdgcn_perm(rv[3][wi], rv[2][wi], 0x05040100u); o.z = __builtin_amdgcn_perm(rv[5][wi], rv[4][wi], 0x05040100u); o.w = __builtin_amdgcn_perm(rv[7][wi], rv[6][wi], 0x05040100u); }
            *(LAS u32x4*)(Vt + (vdb * 8 + dd) * VSTR + vkb * 16) = o;
        }
    }
    bf16x8 Qf[4];
    {
#pragma unroll
        for (int kh = 0; kh < 2; ++kh) {
            float x1[8], x2[8], o1[8], o2[8];
            unpack8(qx1[kh], x1); unpack8(qx2[kh], x2);
            f32x4 c0, c1, s0, s1;
#pragma unroll
            for (int j = 0; j < 4; ++j) { const float r0 = __builtin_amdgcn_fractf(qpos * qinv[2 * kh][j] * 0.15915494309189535f), r1 = __builtin_amdgcn_fractf(qpos * qinv[2 * kh + 1][j] * 0.15915494309189535f);
                c0[j] = __builtin_amdgcn_cosf(r0); s0[j] = __builtin_amdgcn_sinf(r0); c1[j] = __builtin_amdgcn_cosf(r1); s1[j] = __builtin_amdgcn_sinf(r1); }
#pragma unroll
            for (int j = 0; j < 4; ++j) { o1[j] = (x1[j] * c0[j] - x2[j] * s0[j]) * QSCALE; o2[j] = (x2[j] * c0[j] + x1[j] * s0[j]) * QSCALE;
                o1[4 + j] = (x1[4 + j] * c1[j] - x2[4 + j] * s1[j]) * QSCALE; o2[4 + j] = (x2[4 + j] * c1[j] + x1[4 + j] * s1[j]) * QSCALE; }
            Qf[kh] = as_bf16x8(pack8(o1)); Qf[kh + 2] = as_bf16x8(pack8(o2));
        }
    }
    __syncthreads();
    unsigned nxt_id = 0u;
    if (tid == 0) nxt_id = atomicAdd(ctr, 1u);
    const int m0 = (16 * w < 96) ? 16 * w : 96;
    f32x4 S[10];
#pragma unroll
    for (int jt = 0; jt < 10; ++jt) {
        S[jt] = (f32x4){0.f, 0.f, 0.f, 0.f};
        const LAS unsigned char* kr = Ks + (m0 + jt * 16 + c) * KSTR + 16 * g;
#pragma unroll
        for (int ks = 0; ks < 4; ++ks) { const bf16x8 a = *(const LAS bf16x8*)(kr + ks * 64); S[jt] = __builtin_amdgcn_mfma_f32_16x16x32_bf16(a, Qf[ks], S[jt], 0, 0, 0); }
    }
    float mx = -INFINITY;
#pragma unroll
    for (int jt = 0; jt < 10; ++jt)
#pragma unroll
        for (int jj = 0; jj < 4; ++jj) { const int m = m0 + jt * 16 + 4 * g + jj, dist = qi + 128 - m; const bool ok = (dist >= 0) && (dist <= 128) && ((n - 1) * 128 + m >= 0);
            const float s = ok ? S[jt][jj] : -INFINITY; S[jt][jj] = s; mx = fmaxf(mx, s); }
    mx = fmaxf(mx, __shfl_xor(mx, 16)); mx = fmaxf(mx, __shfl_xor(mx, 32));
    float den = 0.f;
#pragma unroll
    for (int jt = 0; jt < 10; ++jt)
#pragma unroll
        for (int jj = 0; jj < 4; ++jj) { const float p = __builtin_amdgcn_exp2f(S[jt][jj] - mx); S[jt][jj] = p; den += p; }
    den += __shfl_xor(den, 16); den += __shfl_xor(den, 32);
    bf16x8 Pf[5];
#pragma unroll
    for (int k5 = 0; k5 < 5; ++k5) { u32x4 pw; pw.x = cvt_pk_bf16(S[2 * k5][0], S[2 * k5][1]); pw.y = cvt_pk_bf16(S[2 * k5][2], S[2 * k5][3]); pw.z = cvt_pk_bf16(S[2 * k5 + 1][0], S[2 * k5 + 1][1]); pw.w = cvt_pk_bf16(S[2 * k5 + 1][2], S[2 * k5 + 1][3]); Pf[k5] = as_bf16x8(pw); }
    const float inv = 1.0f / den;
    bf16_t* op = Z + (size_t)qrow * ZC + colq + 4 * g;
#pragma unroll
    for (int dt = 0; dt < 8; ++dt) {
        f32x4 O = (f32x4){0.f, 0.f, 0.f, 0.f};
        const LAS unsigned char* vr = Vt + (dt * 16 + c) * VSTR + (m0 + 4 * g) * 2;
#pragma unroll
        for (int k5 = 0; k5 < 5; ++k5) { const u32x2 lo = *(const LAS u32x2*)(vr + k5 * 64), hi = *(const LAS u32x2*)(vr + k5 * 64 + 32);
            const bf16x8 a = as_bf16x8((u32x4){lo.x, lo.y, hi.x, hi.y}); O = __builtin_amdgcn_mfma_f32_16x16x32_bf16(a, Pf[k5], O, 0, 0, 0); }
        u32x2 ow; ow.x = cvt_pk_bf16(O[0] * inv, O[1] * inv); ow.y = cvt_pk_bf16(O[2] * inv, O[3] * inv);
        *(u32x2*)(op + dt * 16) = ow;
    }
    if (g == 0) LSE[(size_t)qrow * 12 + gi * 4 + hh] = (mx + __builtin_amdgcn_logf(den)) * 0.6931471805599453f;
    if (tid == 0) *(LAS unsigned*)(lds + LDS_SLOT) = nxt_id;
    __syncthreads();
}

__device__ __forceinline__ float logsig16(float x) { return (fminf(x, 0.f) - __logf(1.0f + __expf(-fabsf(x)))) * (1.0f / 16.0f); }

#define LBAR() do { asm volatile("s_waitcnt lgkmcnt(0)" ::: "memory"); __builtin_amdgcn_s_barrier(); asm volatile("" ::: "memory"); } while (0)
__device__ void gla_item(const Params& P, int l, int b, int h, int seg, LAS unsigned char* lds) {
    const int tid = get_tid(), lane = tid & 63, w = __builtin_amdgcn_readfirstlane(tid >> 6), g = lane >> 4, c = lane & 15;
    bf16_t* Z = (bf16_t*)(P.ws + WS_Z); const float* AL = (const float*)(P.ws + WS_ALOW);
    LAS float* WUP = (LAS float*)(lds + 0);
    LAS float* BUP = (LAS float*)(lds + 4096);
    LAS float* ARAW = (LAS float*)(lds + 4352);
    LAS float* LC = (LAS float*)(lds + 8448);
    LAS float* SEG = (LAS float*)(lds + 24832);
    LAS float* DEC = (LAS float*)(lds + 26880);
    LAS unsigned char* QP = lds + 29184;
    LAS unsigned char* KP = lds + 38400;
    LAS unsigned char* KPP = lds + 47616;
    LAS unsigned char* AIN = lds + 56832;
    LAS unsigned char* VS = lds + 66048;
    LAS unsigned char* OT = lds + 83456;
    constexpr int QS = 144, VSS = 272;
    for (int i = tid; i < 1024; i += NTHR) { const int r = i >> 6, d = i & 63; WUP[i] = P.w_alpha_up[((size_t)l * 16 + r) * 256 + h * 64 + d]; }
    if (tid < 64) BUP[tid] = P.b_alpha[(size_t)l * 256 + h * 64 + tid];
    f32x4 Sacc[4];
#pragma unroll
    for (int dt = 0; dt < 4; ++dt) Sacc[dt] = (f32x4){0.f, 0.f, 0.f, 0.f};
    const int rowb = b * 2048 + seg * 256;
    const int t_ = tid >> 3, d8 = (tid & 7) * 8;
    u32x4 nq, nk, nv0, nv1; f32x4 na = (f32x4){0.f, 0.f, 0.f, 0.f};
    {
        const size_t r0 = (size_t)(rowb + t_) * ZC;
        nq = *(const u32x4*)(Z + r0 + ZQ + h * 64 + d8); nk = *(const u32x4*)(Z + r0 + ZK + h * 64 + d8);
        nv0 = *(const u32x4*)(Z + (size_t)(rowb + (tid >> 4)) * ZC + ZV + h * 128 + (tid & 15) * 8);
        nv1 = *(const u32x4*)(Z + (size_t)(rowb + 32 + (tid >> 4)) * ZC + ZV + h * 128 + (tid & 15) * 8);
        if (tid < 256) na = *(const f32x4*)(AL + (size_t)(rowb + (tid >> 2)) * 16 + (tid & 3) * 4);
    }
    float Lseg[8];
#pragma unroll
    for (int j = 0; j < 8; ++j) Lseg[j] = 0.f;
    float* DSEG = (float*)(P.ws + WS_DSEG);
    for (int n = 0; n < 4; ++n) {
        if ((n & 3) == 0) {
#pragma unroll
            for (int dt = 0; dt < 4; ++dt) Sacc[dt] = (f32x4){0.f, 0.f, 0.f, 0.f};
#pragma unroll
            for (int j = 0; j < 8; ++j) Lseg[j] = 0.f;
        }
        const int row0 = rowb + n * 64;
        const u32x4 cq = nq, ck = nk;
        *(LAS u32x4*)(VS + (tid >> 4) * VSS + (tid & 15) * 16) = nv0;
        *(LAS u32x4*)(VS + (32 + (tid >> 4)) * VSS + (tid & 15) * 16) = nv1;
        if (tid < 256) *(LAS f32x4*)(ARAW + (tid >> 2) * 16 + (tid & 3) * 4) = na;
        if (n + 1 < 4) {
            const int rn = row0 + 64; const size_t r0 = (size_t)(rn + t_) * ZC;
            nq = *(const u32x4*)(Z + r0 + ZQ + h * 64 + d8); nk = *(const u32x4*)(Z + r0 + ZK + h * 64 + d8);
            nv0 = *(const u32x4*)(Z + (size_t)(rn + (tid >> 4)) * ZC + ZV + h * 128 + (tid & 15) * 8);
            nv1 = *(const u32x4*)(Z + (size_t)(rn + 32 + (tid >> 4)) * ZC + ZV + h * 128 + (tid & 15) * 8);
            if (tid < 256) na = *(const f32x4*)(AL + (size_t)(rn + (tid >> 2)) * 16 + (tid & 3) * 4);
        }
        LBAR();
        {
            float x[8];
#pragma unroll
            for (int j = 0; j < 8; ++j) x[j] = BUP[d8 + j];
#pragma unroll
            for (int r = 0; r < 16; ++r) { const float a = ARAW[t_ * 16 + r]; const f32x4 w0 = *(const LAS f32x4*)(WUP + r * 64 + d8), w1 = *(const LAS f32x4*)(WUP + r * 64 + d8 + 4);
#pragma unroll
                for (int j = 0; j < 4; ++j) { x[j] += a * w0[j]; x[4 + j] += a * w1[j]; } }
            f32x4 o0, o1;
#pragma unroll
            for (int j = 0; j < 4; ++j) { o0[j] = logsig16(x[j]); o1[j] = logsig16(x[4 + j]); }
            *(LAS f32x4*)(LC + t_ * 64 + d8) = o0; *(LAS f32x4*)(LC + t_ * 64 + d8 + 4) = o1;
        }
        LBAR();
        {
            const int d = tid & 63, sg = tid >> 6; float cum[8]; float run = 0.f;
#pragma unroll
            for (int i = 0; i < 8; ++i) { run += LC[(sg * 8 + i) * 64 + d]; cum[i] = run; }
            SEG[sg * 64 + d] = run;
            LBAR();
            float off = 0.f;
#pragma unroll
            for (int s = 0; s < 7; ++s) off += (s < sg) ? SEG[s * 64 + d] : 0.f;
#pragma unroll
            for (int i = 0; i < 8; ++i) LC[(sg * 8 + i) * 64 + d] = cum[i] + off;
        }
        LBAR();
        {
            const f32x4 L0 = *(const LAS f32x4*)(LC + t_ * 64 + d8), L1 = *(const LAS f32x4*)(LC + t_ * 64 + d8 + 4);
            const f32x4 E0 = *(const LAS f32x4*)(LC + 63 * 64 + d8), E1 = *(const LAS f32x4*)(LC + 63 * 64 + d8 + 4);
            float qf[8], kf[8], qo[8], ko[8], k2[8], q2[8];
            unpack8(cq, qf); unpack8(ck, kf);
#pragma unroll
            for (int j = 0; j < 8; ++j) { const float L = (j < 4) ? L0[j & 3] : L1[j & 3], Le = (j < 4) ? E0[j & 3] : E1[j & 3];
                qo[j] = qf[j] * __expf(L) * 0.125f; ko[j] = kf[j] * __expf(-L); k2[j] = kf[j] * __expf(Le - L); q2[j] = qf[j] * __expf(L + Lseg[j]) * 0.125f; Lseg[j] += Le; }
            *(LAS u32x4*)(QP + t_ * QS + d8 * 2) = pack8(qo); *(LAS u32x4*)(KP + t_ * QS + d8 * 2) = pack8(ko); *(LAS u32x4*)(KPP + t_ * QS + d8 * 2) = pack8(k2);
            *(u32x4*)(Z + (size_t)(row0 + t_) * ZC + ZQ + h * 64 + d8) = pack8(q2);
            if (t_ == 0) {
#pragma unroll
                for (int j = 0; j < 8; ++j) DEC[d8 + j] = __expf((j < 4) ? E0[j & 3] : E1[j & 3]); }
        }
        LBAR();
#pragma unroll
        for (int q = 0; q < 2; ++q) {
            const int idx = 2 * w + q, it = idx >> 2, jt = idx & 3;
            f32x4 A = (f32x4){0.f, 0.f, 0.f, 0.f};
            if (jt <= it) {
#pragma unroll
                for (int ks = 0; ks < 2; ++ks) { const bf16x8 a = *(const LAS bf16x8*)(QP + (it * 16 + c) * QS + (ks * 32 + 8 * g) * 2), bb = *(const LAS bf16x8*)(KP + (jt * 16 + c) * QS + (ks * 32 + 8 * g) * 2);
                    A = __builtin_amdgcn_mfma_f32_16x16x32_bf16(a, bb, A, 0, 0, 0); }
            }
#pragma unroll
            for (int jj = 0; jj < 4; ++jj) { const int i = it * 16 + 4 * g + jj, j = jt * 16 + c; const float v = (j <= i) ? A[jj] : 0.f;
                *(LAS unsigned short*)(AIN + i * QS + j * 2) = f2bf(v); }
        }
        LBAR();
        bf16x8 Vb[2];
#pragma unroll
        for (int ks = 0; ks < 2; ++ks) { unsigned short e[8];
#pragma unroll
            for (int j = 0; j < 8; ++j) e[j] = *(const LAS unsigned short*)(VS + (ks * 32 + 8 * g + j) * VSS + (16 * w + c) * 2);
            u32x4 pw; pw.x = e[0] | ((unsigned)e[1] << 16); pw.y = e[2] | ((unsigned)e[3] << 16); pw.z = e[4] | ((unsigned)e[5] << 16); pw.w = e[6] | ((unsigned)e[7] << 16); Vb[ks] = as_bf16x8(pw); }
        bf16x8 Sb[2];
#pragma unroll
        for (int k2 = 0; k2 < 2; ++k2) { u32x4 pw; pw.x = cvt_pk_bf16(Sacc[2 * k2][0], Sacc[2 * k2][1]); pw.y = cvt_pk_bf16(Sacc[2 * k2][2], Sacc[2 * k2][3]);
            pw.z = cvt_pk_bf16(Sacc[2 * k2 + 1][0], Sacc[2 * k2 + 1][1]); pw.w = cvt_pk_bf16(Sacc[2 * k2 + 1][2], Sacc[2 * k2 + 1][3]); Sb[k2] = as_bf16x8(pw); }
        f32x4 Oacc[4];
#pragma unroll
        for (int it = 0; it < 4; ++it) {
            Oacc[it] = (f32x4){0.f, 0.f, 0.f, 0.f};
#pragma unroll
            for (int ks = 0; ks < 2; ++ks) { const bf16x8 a = *(const LAS bf16x8*)(AIN + (it * 16 + c) * QS + (ks * 32 + 8 * g) * 2); Oacc[it] = __builtin_amdgcn_mfma_f32_16x16x32_bf16(a, Vb[ks], Oacc[it], 0, 0, 0); }
#pragma unroll
            for (int k2 = 0; k2 < 2; ++k2) { const u32x2 lo = *(const LAS u32x2*)(QP + (it * 16 + c) * QS + (32 * k2 + 4 * g) * 2), hi = *(const LAS u32x2*)(QP + (it * 16 + c) * QS + (32 * k2 + 16 + 4 * g) * 2);
                const bf16x8 a = as_bf16x8((u32x4){lo.x, lo.y, hi.x, hi.y}); Oacc[it] = __builtin_amdgcn_mfma_f32_16x16x32_bf16(a, Sb[k2], Oacc[it], 0, 0, 0); }
        }
#pragma unroll
        for (int dt = 0; dt < 4; ++dt) {
            const f32x4 dc = *(const LAS f32x4*)(DEC + dt * 16 + 4 * g);
            Sacc[dt] = Sacc[dt] * dc;
#pragma unroll
            for (int ks = 0; ks < 2; ++ks) { unsigned short e[8];
#pragma unroll
                for (int j = 0; j < 8; ++j) e[j] = *(const LAS unsigned short*)(KPP + (ks * 32 + 8 * g + j) * QS + (dt * 16 + c) * 2);
                u32x4 pw; pw.x = e[0] | ((unsigned)e[1] << 16); pw.y = e[2] | ((unsigned)e[3] << 16); pw.z = e[4] | ((unsigned)e[5] << 16); pw.w = e[6] | ((unsigned)e[7] << 16);
                Sacc[dt] = __builtin_amdgcn_mfma_f32_16x16x32_bf16(as_bf16x8(pw), Vb[ks], Sacc[dt], 0, 0, 0); }
        }
#pragma unroll
        for (int it = 0; it < 4; ++it)
#pragma unroll
            for (int jj = 0; jj < 4; ++jj) *(LAS unsigned short*)(OT + (it * 16 + 4 * g + jj) * VSS + (16 * w + c) * 2) = f2bf(Oacc[it][jj]);
        LBAR();
        {
            const u32x4 o0 = *(const LAS u32x4*)(OT + (tid >> 4) * VSS + (tid & 15) * 16), o1 = *(const LAS u32x4*)(OT + (32 + (tid >> 4)) * VSS + (tid & 15) * 16);
            *(u32x4*)(Z + (size_t)(row0 + (tid >> 4)) * ZC + ZV + h * 128 + (tid & 15) * 8) = o0;
            *(u32x4*)(Z + (size_t)(row0 + 32 + (tid >> 4)) * ZC + ZV + h * 128 + (tid & 15) * 8) = o1;
        }
        if ((n & 3) == 3) {
            const int rs0 = rowb;
#pragma unroll
            for (int dt = 0; dt < 4; ++dt)
#pragma unroll
                for (int jj = 0; jj < 4; ++jj) { const int d = dt * 16 + 4 * g + jj, dv = 16 * w + c; *((float*)(Z + (size_t)(rs0 + d * 4 + (dv >> 5)) * ZC + ZK + h * 64) + (dv & 31)) = Sacc[dt][jj]; }            if (t_ == 0) {
#pragma unroll
                for (int j = 0; j < 8; ++j) DSEG[(size_t)((b * 4 + h) * 8 + seg) * 64 + d8 + j] = __expf(Lseg[j]); }
        }
    }
    __syncthreads();
}


__device__ void gla_C(const Params& P, int l, int item, LAS unsigned char* lds) {
    const int tid = get_tid(), lane = tid & 63, w = __builtin_amdgcn_readfirstlane(tid >> 6), g = lane >> 4, c = lane & 15;
    const int seg = item & 7, bh = item >> 3, b = bh >> 2, h = bh & 3;
    bf16_t* Z = (bf16_t*)(P.ws + WS_Z);
    LAS float* SSQ = (LAS float*)lds;
    LAS unsigned char* OT = lds + 8192;
    const float ng = P.gla_norm_g[(size_t)l * 128 + 16 * w + c];
    const float* DSEG = (const float*)(P.ws + WS_DSEG);
    float Sin[2][8];
#pragma unroll
    for (int ks = 0; ks < 2; ++ks)
#pragma unroll
        for (int e = 0; e < 8; ++e) Sin[ks][e] = 0.f;
    for (int sq = 0; sq < seg; ++sq) {
        const int rs0 = b * 2048 + sq * 256; const size_t it2 = (size_t)bh * 8 + sq;
#pragma unroll
        for (int ks = 0; ks < 2; ++ks)
#pragma unroll
            for (int e = 0; e < 8; ++e) { const int d = ks * 32 + 8 * g + e, dv = 16 * w + c;
                Sin[ks][e] = DSEG[it2 * 64 + d] * Sin[ks][e] + *((const float*)(Z + (size_t)(rs0 + d * 4 + (dv >> 5)) * ZC + ZK + h * 64) + (dv & 31)); }
    }
    bf16x8 Sb[2];
#pragma unroll
    for (int ks = 0; ks < 2; ++ks) Sb[ks] = as_bf16x8(pack8(Sin[ks]));
    const int row0 = b * 2048 + seg * 256;
    unsigned short gtr[16][4], olr[16][4];
#pragma unroll
    for (int rt = 0; rt < 16; ++rt)
#pragma unroll
        for (int jj = 0; jj < 4; ++jj) { const bf16_t* zr = Z + (size_t)(row0 + rt * 16 + 4 * g + jj) * ZC + h * 128 + 16 * w + c; gtr[rt][jj] = zr[ZG]; olr[rt][jj] = zr[ZV]; }
    f32x4 O[16];
#pragma unroll
    for (int rt = 0; rt < 16; ++rt) {
#pragma unroll
        for (int jj = 0; jj < 4; ++jj) O[rt][jj] = bf2f(olr[rt][jj]);
        if (seg > 0) {
#pragma unroll
            for (int ks = 0; ks < 2; ++ks) { const bf16x8 a = as_bf16x8(*(const u32x4*)(Z + (size_t)(row0 + rt * 16 + c) * ZC + ZQ + h * 64 + ks * 32 + 8 * g)); O[rt] = __builtin_amdgcn_mfma_f32_16x16x32_bf16(a, Sb[ks], O[rt], 0, 0, 0); }
        }
    }
    {
#pragma unroll
        for (int rt = 0; rt < 16; ++rt) {
            float sv[4];
#pragma unroll
            for (int jj = 0; jj < 4; ++jj) sv[jj] = O[rt][jj] * O[rt][jj];
#pragma unroll
            for (int m = 1; m <= 8; m <<= 1)
#pragma unroll
                for (int jj = 0; jj < 4; ++jj) sv[jj] += __shfl_xor(sv[jj], m);
            if (c == 0) {
#pragma unroll
                for (int jj = 0; jj < 4; ++jj) SSQ[w * 256 + rt * 16 + 4 * g + jj] = sv[jj]; }
        }
    }
    __syncthreads();
#pragma unroll
    for (int rt = 0; rt < 16; ++rt)
#pragma unroll
        for (int jj = 0; jj < 4; ++jj) { const int t = rt * 16 + 4 * g + jj; float tot = 0.f;
#pragma unroll
            for (int ww = 0; ww < 8; ++ww) tot += SSQ[ww * 256 + t];
            const float rs = rsqrtf(tot * (1.0f / 128.0f) + EPS);
            const float gt = bf2f(gtr[rt][jj]);
            *(LAS unsigned short*)(OT + t * 272 + (16 * w + c) * 2) = f2bf(O[rt][jj] * rs * ng * (gt * __builtin_amdgcn_rcpf(1.0f + __expf(-gt)))); }
    __syncthreads();
#pragma unroll
    for (int i = 0; i < 8; ++i) { const int p = tid + i * NTHR, r = p >> 4, sg = p & 15;
        *(u32x4*)(Z + (size_t)(row0 + r) * ZC + ZG + h * 128 + sg * 8) = *(const LAS u32x4*)(OT + r * 272 + sg * 16); }
    __syncthreads();
}

__device__ __forceinline__ int next_item(unsigned* ctr, LAS unsigned char* lds) {
    __syncthreads();
    if (threadIdx.x == 0) *(LAS unsigned*)(lds + LDS_SLOT) = atomicAdd(ctr, 1u);
    __syncthreads();
    return (int)*(LAS unsigned*)(lds + LDS_SLOT);
}

__device__ void phase_branches(const Params& P, int l, int half, LAS unsigned char* lds) {
    unsigned* ctr = (unsigned*)(P.ws + WS_CTL) + 64 * (l * 2 + half);
    for (int it = blockIdx.x; it < 256; it += gridDim.x) gla_item(P, l, it >> 5, (it >> 3) & 3, it & 7, lds);
    int it = next_item(ctr, lds);
    while (it < 1536 + 128) {
        if (it < 1536) { attn_item(P, half, it, lds, ctr); it = (int)*(LAS unsigned*)(lds + LDS_SLOT); }
        else { sc_item(P, l, it - 1536); it = next_item(ctr, lds); }
    }
}


#define XB_TMO      128
#define XB_XCNT(j)  (256  + 64 * (j))
#define XB_XSUB(j)  (1280 + 64 * (j))
#define XB_XGEN(j)  (2304 + 64 * (j))
#define XB_TOP      3328
#define XB_TOPGEN   3392
#define XCD_BAR_WORDS 3456
#define XB_SPIN_CAP (1u << 20)
__device__ __forceinline__ unsigned xb_ld(unsigned* p)              { return __hip_atomic_load(p, __ATOMIC_RELAXED, __HIP_MEMORY_SCOPE_AGENT); }
__device__ __forceinline__ unsigned xb_add(unsigned* p, unsigned v) { return __hip_atomic_fetch_add(p, v, __ATOMIC_RELAXED, __HIP_MEMORY_SCOPE_AGENT); }
__device__ __forceinline__ unsigned xb_xcc_id() { return (unsigned)__builtin_amdgcn_s_getreg((3 << 11) | 20) & 0xFu; }
#define XB_SPIN(cond, bar) do { unsigned _sp = 0; while (cond) { __builtin_amdgcn_s_sleep(1); \
    if ((++_sp & 255u) == 0u) { if (xb_ld(&(bar)[XB_TMO])) break; if (_sp > XB_SPIN_CAP) { atomicAdd(&(bar)[XB_TMO], 1u); break; } } } } while (0)
struct XcdBarrier { unsigned* bar; unsigned x; volatile LAS unsigned* st; };
__device__ __forceinline__ XcdBarrier xcd_barrier_post(unsigned* bar, volatile LAS unsigned* st) {
    XcdBarrier b; b.bar = bar; b.x = xb_xcc_id(); b.st = st;
    if (threadIdx.x == 0) (void)xb_add(&bar[XB_XCNT(b.x)], 1u);
    return b;
}
__device__ __forceinline__ void xcd_barrier_complete(unsigned* bar, unsigned x, unsigned& nloc, unsigned& nx) {
    const unsigned G = gridDim.x * gridDim.y * gridDim.z;
    unsigned sum, cnt, mine, sp = 0u;
    for (;;) {
        sum = 0u; cnt = 0u; mine = 0u;
#pragma unroll
        for (unsigned j = 0; j < 16; ++j) { const unsigned c = xb_ld(&bar[XB_XCNT(j)]); sum += c; cnt += (c > 0u) ? 1u : 0u; mine = (j == x) ? c : mine; }
        if (sum == G) break;
        __builtin_amdgcn_s_sleep(1);
        if ((++sp & 255u) == 0u) { if (xb_ld(&bar[XB_TMO])) break; if (sp > XB_SPIN_CAP) { atomicAdd(&bar[XB_TMO], 1u); break; } }
    }
    nloc = mine > 0u ? mine : 1u; nx = cnt > 0u ? cnt : 1u;
}
__device__ __forceinline__ void xcd_barrier(const XcdBarrier& b) {
    asm volatile("s_waitcnt vmcnt(0)" ::: "memory");
    __syncthreads();
    if (threadIdx.x == 0) {
        unsigned* bar = b.bar;
        __builtin_amdgcn_s_waitcnt(0);
        unsigned nloc = b.st[0], nx = b.st[1];
        if (nloc == 0u) { xcd_barrier_complete(bar, b.x, nloc, nx); b.st[0] = nloc; b.st[1] = nx; }
        const unsigned old = xb_add(&bar[XB_XSUB(b.x)], 1u);
        const unsigned gen = old / nloc;
        if (old + 1u == (gen + 1u) * nloc) {
            __builtin_amdgcn_fence(__ATOMIC_RELEASE, "agent");
            asm volatile("s_waitcnt vmcnt(0)" ::: "memory");
            const unsigned og = xb_add(&bar[XB_TOP], 1u);
            const unsigned tg = og / nx;
            if (og + 1u == (tg + 1u) * nx) xb_add(&bar[XB_TOPGEN], 1u);
            else XB_SPIN(xb_ld(&bar[XB_TOPGEN]) == tg, bar);
            __builtin_amdgcn_fence(__ATOMIC_ACQUIRE, "agent");
            xb_add(&bar[XB_XGEN(b.x)], 1u);
            asm volatile("s_waitcnt vmcnt(0)" ::: "memory");
        } else {
            XB_SPIN(xb_ld(&bar[XB_XGEN(b.x)]) == gen, bar);
            __builtin_amdgcn_fence(__ATOMIC_ACQUIRE, "agent");
            asm volatile("s_waitcnt vmcnt(0)" ::: "memory");
        }
    }
    __syncthreads();
}

__global__ void __launch_bounds__(NTHR, 2) fwd_kernel(Params P) {
    extern __shared__ __attribute__((aligned(16))) unsigned char smem[];
    LAS unsigned char* lds = (LAS unsigned char*)smem;
    cg::grid_group grid = cg::this_grid();
    if (threadIdx.x < 4) ((LAS unsigned*)(lds + LDS_BYTES - 32))[threadIdx.x] = 0u;
    __syncthreads();
    const XcdBarrier xb = xcd_barrier_post((unsigned*)(P.ws + WS_BAR), (volatile LAS unsigned*)(lds + LDS_BYTES - 32));
    unsigned char* ws = P.ws;
    const int lo = P.ph_lo, hi = P.ph_hi;
    const bool fuse = (gridDim.x == 256);
    for (int ph = lo; ph < hi; ++ph) {
        const int l = ph / 19, q = ph % 19;
        const int half = (q >= 8 && q <= 14) ? 1 : 0;
        const int k = (q == 0) ? 0 : (q <= 14 ? 1 + (q - 1) % 7 : q - 7);
        switch (k) {
        case 0: if (l == 0) { phase_convert(P, l, lds); phase_norm_alow(P, 0, 0, lds); } break;
        case 1: break;
        case 2: { pg8::Gemm g{(const bf16_t*)(ws + WS_H) + (size_t)half * TH * DM, (const bf16_t*)(ws + WS_W1), 1024, 1024, 1024, 0, 0}; pg8::Order S; S.init(TH, 10752, gridDim.x, blockIdx.x, 1);
                  pg8::EpiSplit E{(bf16_t*)(ws + WS_Z), ZC, (bf16_t*)(ws + WS_GT), GC, 30, P.b_gate + (size_t)l * GC}; pg8::gemm_phase(lds, g, S, E); } break;
        case 3: phase_branches(P, l, half, lds); break;
        case 4: for (int it = blockIdx.x; it < 256; it += gridDim.x) gla_C(P, l, it, lds); phase_combine(P); break;
        case 5: { pg8::Gemm g{(const bf16_t*)(ws + WS_Z) + ZG, (const bf16_t*)(ws + WS_WBR), ZC, 512, 512, (size_t)1024, (size_t)1024 * 512};
                  pg8::Order S; S.init(TH, 1024, gridDim.x, blockIdx.x, 3);
                  pg8::EpiMerge E{(const bf16_t*)(ws + WS_GT), (bf16_t*)(ws + WS_MG)}; pg8::gemm_phase(lds, g, S, E); } break;
        case 6: if (fuse) {
                      const int inst = l * 2 + half;
                      pg8::Gemm g{(const bf16_t*)(ws + WS_MG), (const bf16_t*)(ws + WS_WMO), 1024, 1024, 1024, 0, 0}; pg8::Order S; S.init(TH, 1024, gridDim.x, blockIdx.x, 1);
                      pg8::EpiNormRes E{(l == 0 ? P.x : P.out) + (size_t)half * TH * DM, P.out + (size_t)half * TH * DM, (bf16_t*)(ws + WS_H) + (size_t)half * TH * DM,
                                        P.post_mix_g + (size_t)l * DM, P.pre_ffn_g + (size_t)l * DM,
                                        (unsigned*)(ws + WS_XS) + (size_t)(inst * 2) * TH * 4, (unsigned*)(ws + WS_XS) + (size_t)(inst * 2 + 1) * TH * 4,
                                        (unsigned*)(ws + WS_CTL) + 4608 + (inst * 2) * 256, (unsigned*)(ws + WS_CTL) + 4608 + (inst * 2 + 1) * 256};
                      pg8::gemm_phase(lds, g, S, E);
                      if (half == 0) phase_norm_alow(P, l, 1, lds);
                  } else { pg8::Gemm g{(const bf16_t*)(ws + WS_MG), (const bf16_t*)(ws + WS_WMO), 1024, 1024, 1024, 0, 0}; pg8::Order S; S.init(TH, 1024, gridDim.x, blockIdx.x, 1);
                      pg8::EpiSplit E{(bf16_t*)(ws + WS_Y), 1024, (bf16_t*)(ws + WS_Y), 1024, 1 << 20, nullptr}; pg8::gemm_phase(lds, g, S, E); } break;
        case 7: if (!fuse) { phase_resid((l == 0 ? P.x : P.out) + (size_t)half * TH * DM, P.out + (size_t)half * TH * DM, (const bf16_t*)(ws + WS_Y), P.post_mix_g + (size_t)l * DM, P.pre_ffn_g + (size_t)l * DM,
                            (bf16_t*)(ws + WS_H) + (size_t)half * TH * DM, TH);
                if (half == 0) phase_norm_alow(P, l, 1, lds); }
                break;
        case 8: { pg8::Gemm g{(const bf16_t*)(ws + WS_H), (const bf16_t*)(ws + WS_WFF), 1024, 1024, 1024, 0, 0}; pg8::Order S; S.init(T_ALL, 5632, gridDim.x, blockIdx.x, 1);
                  pg8::EpiFFN E{(bf16_t*)(ws + WS_U), (float*)(ws + WS_HG), (float*)(ws + WS_HU), P.ff_conv_w + (size_t)l * 3 * FF, P.ff_conv_b + (size_t)l * FF, lds + pg8::STAGE_BYTES};
                  pg8::gemm_phase(lds, g, S, E); } break;
        case 9: phase_ffn_fix(P, l); break;
        case 10: { pg8::Gemm g{(const bf16_t*)(ws + WS_U), (const bf16_t*)(ws + WS_WD), FF, FF, FF, 0, 0}; pg8::Order S; S.init(T_ALL, 1024, gridDim.x, blockIdx.x, 1);
                   pg8::EpiSplit E{(bf16_t*)(ws + WS_Y2), 1024, (bf16_t*)(ws + WS_Y2), 1024, 1 << 20, nullptr}; pg8::gemm_phase(lds, g, S, E); } break;
        default: phase_resid(P.out, P.out, (const bf16_t*)(ws + WS_Y2), P.post_ffn_g + (size_t)l * DM, nullptr, nullptr, T_ALL);
                 if (l == 0) { phase_convert(P, 1, lds); phase_norm_alow(P, 1, 0, lds); }
                 break;
        }
        const bool empty = (k == 0 && l == 1) || (k == 1) || (k == 7 && fuse);
        if (ph + 1 < hi && !empty) { if (hi < lo) grid.sync(); else xcd_barrier(xb); }
    }
}

constexpr int N_PHASES = 2 * (1 + 2 * 7 + 4);

#ifndef MULTI_LAUNCH
#define MULTI_LAUNCH 0
#endif

extern "C" void kernel_launch(void* const* d_in, const int* in_sizes, int n_in, void* d_out, int out_size, void* d_ws, size_t ws_size, hipStream_t stream) {
    static int grid = 0;
    if (grid == 0) {
        if (n_in != 20 || ws_size < WS_END) { fprintf(stderr, "kernel_launch: unexpected n_in %d / ws_size %zu (need %zu)\n", n_in, ws_size, (size_t)WS_END); grid = -1; return; }
        int dev = 0, cus = 0, per_cu = 0;
        hipGetDevice(&dev); hipDeviceGetAttribute(&cus, hipDeviceAttributeMultiprocessorCount, dev);
        if (hipFuncSetAttribute((const void*)fwd_kernel, hipFuncAttributeMaxDynamicSharedMemorySize, LDS_BYTES) != hipSuccess) { fprintf(stderr, "kernel_launch: hipFuncSetAttribute failed\n"); grid = -1; return; }
        if (hipOccupancyMaxActiveBlocksPerMultiprocessor(&per_cu, (const void*)fwd_kernel, NTHR, LDS_BYTES) != hipSuccess || per_cu < 1) per_cu = 1;
        (void)hipGetLastError();
        grid = cus * per_cu;
        if (grid > 256) grid = 256;
    }
    if (grid < 0) return;
    hipMemsetAsync((char*)d_ws + WS_CTL, 0, 32768, stream);
    Params p{};
    p.x = (const float*)d_in[0]; p.pos = (const int*)d_in[1]; p.w_in = (const float*)d_in[2]; p.w_alpha_up = (const float*)d_in[3]; p.b_alpha = (const float*)d_in[4];
    p.gla_norm_g = (const float*)d_in[5]; p.sc_conv_w = (const float*)d_in[6]; p.w_gate = (const float*)d_in[7]; p.b_gate = (const float*)d_in[8]; p.w_branch = (const float*)d_in[9];
    p.w_mix_out = (const float*)d_in[10]; p.pre_mix_g = (const float*)d_in[11]; p.post_mix_g = (const float*)d_in[12]; p.pre_ffn_g = (const float*)d_in[13]; p.post_ffn_g = (const float*)d_in[14];
    p.w_ff_gate = (const float*)d_in[15]; p.w_ff_up = (const float*)d_in[16]; p.ff_conv_w = (const float*)d_in[17]; p.ff_conv_b = (const float*)d_in[18]; p.w_ff_down = (const float*)d_in[19];
    p.out = (float*)d_out; p.ws = (unsigned char*)d_ws;
#if MULTI_LAUNCH
    for (int ph = 0; ph < N_PHASES; ++ph) { p.ph_lo = ph; p.ph_hi = ph + 1; hipLaunchKernelGGL(fwd_kernel, dim3(grid), dim3(NTHR), LDS_BYTES, stream, p); }
#else
    p.ph_lo = 0; p.ph_hi = N_PHASES;
    void* args[] = {&p};
    hipError_t e = hipLaunchCooperativeKernel((const void*)fwd_kernel, dim3(grid), dim3(NTHR), args, LDS_BYTES, stream);
    if (e != hipSuccess) fprintf(stderr, "cooperative launch failed: %s (grid %d)\n", hipGetErrorString(e), grid);
#endif
}
```

```cpp
#include <hip/hip_runtime.h>
#include <hip/hip_cooperative_groups.h>
#include <cstdint>
#include <cstdio>
namespace cg = cooperative_groups;

#define LAS __attribute__((address_space(3)))
typedef unsigned short bf16_t;
typedef short bf16x8 __attribute__((ext_vector_type(8)));
typedef float f32x4 __attribute__((ext_vector_type(4)));
typedef float f32x2 __attribute__((ext_vector_type(2)));
typedef unsigned u32x4 __attribute__((ext_vector_type(4)));
typedef unsigned u32x2 __attribute__((ext_vector_type(2)));

constexpr int T_ALL = 32768, TH = 16384, DM = 1024, ZC = 7680, GC = 3072, FF = 2816;
constexpr int ZQ = 0, ZK = 256, ZV = 512, ZG = 1024, ZSC = 1536, ZSB = 2048, ZSX = 2560, ZDQ = 3072, ZDK = 4608, ZDV = 6144;
constexpr int IN_COLS = 7696;
constexpr float EPS = 1e-6f;
constexpr int NTHR = 512;
constexpr int LDS_BYTES = 147456;
constexpr int LDS_SLOT = LDS_BYTES - 16;

constexpr size_t WS_CTL = 0;
constexpr size_t WS_BAR = 4096;
constexpr size_t WS_W1 = 32768;
constexpr size_t WS_WBR = WS_W1 + (size_t)10752 * 1024 * 2;
constexpr size_t WS_WMO = WS_WBR + (size_t)3 * 1024 * 512 * 2;
constexpr size_t WS_WFF = WS_WMO + (size_t)1024 * 1024 * 2;
constexpr size_t WS_WD = WS_WFF + (size_t)5632 * 1024 * 2;
constexpr size_t WS_RC = WS_WD + (size_t)1024 * 2816 * 2;
constexpr size_t WS_XS = WS_RC + (size_t)1024 * 1024;
constexpr size_t WS_RS = WS_RC + (size_t)T_ALL * 64 * 4;
constexpr size_t WS_H = WS_RS + (size_t)T_ALL * 64 * 4;
constexpr size_t WS_ALOW = WS_H + (size_t)T_ALL * 1024 * 2;
constexpr size_t WS_LSE = WS_ALOW + (size_t)TH * 16 * 4;
constexpr size_t WS_DSEG = WS_LSE + (size_t)TH * 12 * 4;
constexpr size_t WS_BIG = WS_DSEG + (size_t)256 * 64 * 4;
constexpr size_t WS_Z = WS_BIG;
constexpr size_t WS_GT = WS_Z + (size_t)TH * ZC * 2;
constexpr size_t WS_MG = WS_GT + (size_t)TH * GC * 2;
constexpr size_t WS_END = WS_MG + (size_t)TH * 1024 * 2;
constexpr size_t WS_Y = WS_BIG;
constexpr size_t WS_G = WS_BIG;
constexpr size_t WS_U = WS_BIG + (size_t)T_ALL * FF * 2;
constexpr size_t WS_Y2 = WS_BIG;
constexpr size_t WS_HG = WS_BIG + (size_t)T_ALL * 1024 * 4;
constexpr size_t WS_HU = WS_HG + (size_t)128 * 4 * FF * 4;
static_assert(WS_HU + (size_t)128 * 2 * FF * 4 <= WS_U, "halo fits between Y2 and the activation buffer");
static_assert(WS_U + (size_t)T_ALL * FF * 2 <= WS_END, "ffn overlay");

struct Params {
    const float* x; const int* pos; const float* w_in; const float* w_alpha_up; const float* b_alpha; const float* gla_norm_g; const float* sc_conv_w;
    const float* w_gate; const float* b_gate; const float* w_branch; const float* w_mix_out; const float* pre_mix_g; const float* post_mix_g;
    const float* pre_ffn_g; const float* post_ffn_g; const float* w_ff_gate; const float* w_ff_up; const float* ff_conv_w; const float* ff_conv_b; const float* w_ff_down;
    float* out; unsigned char* ws; int ph_lo, ph_hi;
};

__device__ __forceinline__ int get_tid() { int t = threadIdx.x; asm volatile("" : "+v"(t)); return t; }
__device__ __forceinline__ unsigned cvt_pk_bf16(float lo, float hi) { unsigned r; asm volatile("v_cvt_pk_bf16_f32 %0, %1, %2" : "=v"(r) : "v"(lo), "v"(hi)); return r; }
__device__ __forceinline__ float bflo(unsigned w) { return __uint_as_float(w << 16); }
__device__ __forceinline__ float bfhi(unsigned w) { return __uint_as_float(w & 0xffff0000u); }
__device__ __forceinline__ float bf2f(unsigned short b) { return __uint_as_float(((unsigned)b) << 16); }
__device__ __forceinline__ unsigned short f2bf(float f) { return (unsigned short)(cvt_pk_bf16(f, 0.f) & 0xffffu); }
__device__ __forceinline__ void unpack8(const u32x4 w, float (&f)[8]) { f[0] = bflo(w.x); f[1] = bfhi(w.x); f[2] = bflo(w.y); f[3] = bfhi(w.y); f[4] = bflo(w.z); f[5] = bfhi(w.z); f[6] = bflo(w.w); f[7] = bfhi(w.w); }
__device__ __forceinline__ u32x4 pack8(const float (&f)[8]) { u32x4 w; w.x = cvt_pk_bf16(f[0], f[1]); w.y = cvt_pk_bf16(f[2], f[3]); w.z = cvt_pk_bf16(f[4], f[5]); w.w = cvt_pk_bf16(f[6], f[7]); return w; }
__device__ __forceinline__ bf16x8 as_bf16x8(const u32x4 w) { union { u32x4 u; bf16x8 b; } c; c.u = w; return c.b; }

namespace pg8 {
constexpr int BM = 256, BK = 64, HALF = 128, HTB = HALF * BK * 2, STAGE_BYTES = 8 * HTB, NXCD = 8, WGM = 8;
__device__ __forceinline__ int lds_byte(int r, int c) { const int st = (r >> 4) * 2 + (c >> 5), rr = r & 15, cc = c & 31, ob = rr * 64 + cc * 2; return st * 1024 + (ob ^ (((ob >> 9) & 1) << 5)); }
__device__ __forceinline__ void stage_rc(int b, int& R, int& C) { const int st = b / 1024, sb = b % 1024, swz = sb ^ (((sb >> 9) & 1) << 5); R = (st >> 1) * 16 + swz / 64; C = (st & 1) * 32 + (swz % 64) / 2; }
__device__ __forceinline__ int perm32(int rho) { const int n = rho >> 4, i = rho & 15; return 8 * (i >> 2) + 4 * n + (i & 3); }

struct Unit { int pm, pn, g; };
struct Gemm { const bf16_t* A; const bf16_t* Bt; int lda, ldb, K; size_t gA, gB; };

struct Order {
    int nM, nN, nwg, G, c, ng;
    __device__ void init(int M, int N, int G_, int c_, int ng_) { nM = M / BM; nN = N / BM; nwg = nM * nN; G = G_; c = c_; ng = ng_; }
    __device__ bool next(int i, Unit& u) const {
        const int ti = i / ng; u.g = i - ti * ng;
        const long L = (long)ti * G + c; if (L >= nwg) return false;
        int wgid = (int)L; { const int q = nwg / NXCD, r = nwg % NXCD, xcd = wgid % NXCD, off = wgid / NXCD; wgid = (xcd < r ? xcd * (q + 1) : r * (q + 1) + (xcd - r) * q) + off; }
        const int nig = WGM * nN, gid = wgid / nig, fm = gid * WGM, gsz = (nM - fm) < WGM ? (nM - fm) : WGM;
        u.pm = fm + ((wgid % nig) % gsz); u.pn = (wgid % nig) / gsz; return true;
    }
};

template <class Epi>
__device__ __forceinline__ void gemm_phase(LAS unsigned char* lds, const Gemm g, const Order& S, const Epi& E) {
    const int tid = get_tid(), wid = __builtin_amdgcn_readfirstlane(tid >> 6), lane = tid & 63, wr = wid >> 2, wc = wid & 3, fr = lane & 15, fq = lane >> 4;
    const int K = g.K, nt = K / BK;
    unsigned voffA[2], voffB[2];
#pragma unroll
    for (int i = 0; i < 2; ++i) { int R, C; stage_rc(tid * 16 + i * 8192, R, C); const int Rb = Epi::PERM ? ((R & ~31) + perm32(R & 31)) : R;
        voffA[i] = (unsigned)(R * g.lda + C) * 2u; voffB[i] = (unsigned)(Rb * g.ldb + C) * 2u; }
    const size_t kstep = (size_t)(BK * 2);
    const size_t hstepA = (size_t)HALF * g.lda * 2, hstepB = (size_t)HALF * g.ldb * 2;
    const size_t tstepA = 2 * hstepA, tstepB = 2 * hstepB;
    const unsigned ldsw = (unsigned)wid * 1024u;
    const int aoff = lds_byte(wr * 64 + fr, fq * 8), boff = lds_byte(wc * 32 + fr, fq * 8);
#define PG8_SA(b, h) (((b) * 2 + (h)) * HTB)
#define PG8_SB(b, h) ((4 + (b) * 2 + (h)) * HTB)
#define PG8_STAGE(bufoff, gbase, voff) do { _Pragma("unroll") for (int _i = 0; _i < 2; ++_i) \
        __builtin_amdgcn_global_load_lds((const unsigned*)((const char*)(gbase) + (voff)[_i]), (LAS unsigned*)(lds + (bufoff) + ldsw + _i * 8192), 16, 0, 0); } while (0)
#define PG8_LDA(dst, b, h) do { _Pragma("unroll") for (int m = 0; m < 4; ++m) _Pragma("unroll") for (int k = 0; k < 2; ++k) dst[m][k] = *(const LAS bf16x8*)(lds + PG8_SA(b, h) + aoff + m * 2048 + k * 1024); } while (0)
#define PG8_LDB(dst, b, h) do { _Pragma("unroll") for (int n = 0; n < 2; ++n) _Pragma("unroll") for (int k = 0; k < 2; ++k) dst[n][k] = *(const LAS bf16x8*)(lds + PG8_SB(b, h) + boff + n * 2048 + k * 1024); } while (0)
#define PG8_MMA(ai, bj, At, Bt) do { __builtin_amdgcn_s_setprio(1); _Pragma("unroll") for (int m = 0; m < 4; ++m) _Pragma("unroll") for (int n = 0; n < 2; ++n) _Pragma("unroll") for (int k = 0; k < 2; ++k) \
        acc[ai][bj][m][n] = __builtin_amdgcn_mfma_f32_16x16x32_bf16(Bt[n][k], At[m][k], acc[ai][bj][m][n], 0, 0, 0); __builtin_amdgcn_s_setprio(0); } while (0)
#define PG8_WAIT_V(n) asm volatile("s_waitcnt vmcnt(" #n ")" ::: "memory")
#define PG8_WAIT_L(n) asm volatile("s_waitcnt lgkmcnt(" #n ")" ::: "memory")
#define PG8_BAR __builtin_amdgcn_s_barrier()
#define PG8_SCHED __builtin_amdgcn_sched_barrier(0)
    Unit cur, nxt; int ui = 0;
    if (!S.next(0, cur)) return;
    f32x4 acc[2][2][4][2];
#pragma unroll
    for (int a = 0; a < 2; ++a)
#pragma unroll
        for (int b = 0; b < 2; ++b)
#pragma unroll
            for (int m = 0; m < 4; ++m)
#pragma unroll
                for (int n = 0; n < 2; ++n) acc[a][b][m][n] = (f32x4){0.f, 0.f, 0.f, 0.f};
    bf16x8 At[4][2], B0[2][2], B1[2][2];
    const char* cA = (const char*)(g.A + (size_t)cur.g * g.gA) + (size_t)cur.pm * tstepA; const char* cB = (const char*)(g.Bt + (size_t)cur.g * g.gB) + (size_t)cur.pn * tstepB;
    PG8_STAGE(PG8_SB(0, 0), cB, voffB); PG8_STAGE(PG8_SB(0, 1), cB + hstepB, voffB); PG8_STAGE(PG8_SA(0, 0), cA, voffA); PG8_STAGE(PG8_SA(0, 1), cA + hstepA, voffA);
    if (wr == 1) PG8_BAR;
    PG8_WAIT_V(2); PG8_BAR;
    PG8_STAGE(PG8_SB(1, 0), cB + kstep, voffB); PG8_STAGE(PG8_SA(1, 0), cA + kstep, voffA); PG8_STAGE(PG8_SB(1, 1), cB + hstepB + kstep, voffB);
    PG8_WAIT_V(6); PG8_BAR;
    for (;;) {
        const bool has_next = S.next(ui + 1, nxt);
        const char* nA = has_next ? (const char*)(g.A + (size_t)nxt.g * g.gA) + (size_t)nxt.pm * tstepA : cA; const char* nB = has_next ? (const char*)(g.Bt + (size_t)nxt.g * g.gB) + (size_t)nxt.pn * tstepB : cB;
        for (int t = 0; t < nt; t += 2) {
            const bool last = (t == nt - 2);
            const char* a1 = cA + (size_t)(t + 1) * kstep;
            const char* a2 = last ? nA : cA + (size_t)(t + 2) * kstep; const char* b2 = last ? nB : cB + (size_t)(t + 2) * kstep;
            const char* a3 = a2 + kstep; const char* b3 = b2 + kstep;
            PG8_LDB(B0, 0, 0); PG8_LDB(B1, 0, 1); PG8_SCHED; PG8_LDA(At, 0, 0); PG8_STAGE(PG8_SA(1, 1), a1 + hstepA, voffA);
            PG8_WAIT_V(8); PG8_WAIT_L(0); PG8_BAR; PG8_MMA(0, 0, At, B0); PG8_MMA(0, 1, At, B1); PG8_BAR; PG8_SCHED;
            PG8_LDA(At, 0, 1); PG8_STAGE(PG8_SB(0, 0), b2, voffB); PG8_STAGE(PG8_SB(0, 1), b2 + hstepB, voffB); PG8_STAGE(PG8_SA(0, 0), a2, voffA);
            PG8_WAIT_V(8); PG8_WAIT_L(0); PG8_BAR; PG8_MMA(1, 0, At, B0); PG8_MMA(1, 1, At, B1); PG8_BAR; PG8_SCHED;
            PG8_LDB(B0, 1, 0); PG8_LDB(B1, 1, 1); PG8_SCHED; PG8_LDA(At, 1, 0); PG8_STAGE(PG8_SA(0, 1), a2 + hstepA, voffA);
            PG8_WAIT_V(8); PG8_WAIT_L(0); PG8_BAR; PG8_MMA(0, 0, At, B0); PG8_MMA(0, 1, At, B1); PG8_BAR; PG8_SCHED;
            PG8_LDA(At, 1, 1); PG8_STAGE(PG8_SB(1, 0), b3, voffB); PG8_STAGE(PG8_SB(1, 1), b3 + hstepB, voffB); PG8_STAGE(PG8_SA(1, 0), a3, voffA);
            PG8_WAIT_V(8); PG8_WAIT_L(0); PG8_BAR; PG8_MMA(1, 0, At, B0); PG8_MMA(1, 1, At, B1); PG8_BAR; PG8_SCHED;
        }
        if (wr == 0) PG8_BAR;
        if constexpr (!Epi::AFTER_DRAIN) E(acc, cur, wr, wc, fr, fq);
        if (!has_next) break;
        if constexpr (!Epi::KEEP_ACC) {
#pragma unroll
        for (int a = 0; a < 2; ++a)
#pragma unroll
            for (int b = 0; b < 2; ++b)
#pragma unroll
                for (int m = 0; m < 4; ++m)
#pragma unroll
                    for (int n = 0; n < 2; ++n) acc[a][b][m][n] = (f32x4){0.f, 0.f, 0.f, 0.f};
        }
        cur = nxt; cA = nA; cB = nB; ++ui;
        if (wr == 1) PG8_BAR;
    }
    PG8_WAIT_V(0);
    PG8_BAR;
    if constexpr (Epi::AFTER_DRAIN) E.fused(acc, cur, wr, wc, fr, fq, lds);
#undef PG8_SA
#undef PG8_SB
#undef PG8_STAGE
#undef PG8_LDA
#undef PG8_LDB
#undef PG8_MMA
#undef PG8_WAIT_V
#undef PG8_WAIT_L
#undef PG8_BAR
#undef PG8_SCHED
}

struct EpiF32 {
    static constexpr bool PERM = false, AFTER_DRAIN = false, KEEP_ACC = false;
    float* C; int ldc;
    __device__ __forceinline__ void operator()(const f32x4 (&acc)[2][2][4][2], const Unit& u, int wr, int wc, int fr, int fq) const {
        const int row0 = u.pm * BM + wr * 64 + fr, col0 = u.pn * BM + wc * 32 + 4 * fq;
#pragma unroll
        for (int ai = 0; ai < 2; ++ai)
#pragma unroll
            for (int m = 0; m < 4; ++m) { float* rowp = C + (size_t)(row0 + ai * HALF + m * 16) * ldc + col0;
#pragma unroll
                for (int bj = 0; bj < 2; ++bj)
#pragma unroll
                    for (int n = 0; n < 2; ++n) *(f32x4*)(rowp + bj * HALF + n * 16) = acc[ai][bj][m][n]; }
    }
};
struct EpiSplit {
    static constexpr bool PERM = true, AFTER_DRAIN = false, KEEP_ACC = false;
    bf16_t* O0; int ld0; bf16_t* O1; int ld1; int split; const float* bias1;
    __device__ __forceinline__ void operator()(const f32x4 (&acc)[2][2][4][2], const Unit& u, int wr, int wc, int fr, int fq) const {
        const int row0 = u.pm * BM + wr * 64 + fr;
        const bool second = u.pn >= split;
        bf16_t* base = second ? O1 : O0; const int ld = second ? ld1 : ld0;
        const int col0 = (second ? (u.pn - split) : u.pn) * BM + wc * 32 + 8 * fq;
        const bool sig = second && (bias1 != nullptr);
        f32x4 bv[2][2];
#pragma unroll
        for (int bj = 0; bj < 2; ++bj)
#pragma unroll
            for (int n = 0; n < 2; ++n) bv[bj][n] = sig ? *(const f32x4*)(bias1 + col0 + bj * HALF + 4 * n) : (f32x4){0.f, 0.f, 0.f, 0.f};
#pragma unroll
        for (int ai = 0; ai < 2; ++ai)
#pragma unroll
            for (int m = 0; m < 4; ++m) { bf16_t* rowp = base + (size_t)(row0 + ai * HALF + m * 16) * ld + col0;
#pragma unroll
                for (int bj = 0; bj < 2; ++bj) { f32x4 v0 = acc[ai][bj][m][0] + bv[bj][0], v1 = acc[ai][bj][m][1] + bv[bj][1];
                    if (sig) {
#pragma unroll
                        for (int j = 0; j < 4; ++j) { v0[j] = __builtin_amdgcn_rcpf(1.0f + __expf(-v0[j])); v1[j] = __builtin_amdgcn_rcpf(1.0f + __expf(-v1[j])); } }
                    u32x4 w; w.x = cvt_pk_bf16(v0[0], v0[1]); w.y = cvt_pk_bf16(v0[2], v0[3]); w.z = cvt_pk_bf16(v1[0], v1[1]); w.w = cvt_pk_bf16(v1[2], v1[3]);
                    *(u32x4*)(rowp + bj * HALF) = w; } }
    }
};
struct EpiMerge {
    static constexpr bool PERM = true, AFTER_DRAIN = false, KEEP_ACC = true;
    const bf16_t* GT; bf16_t* MG;
    __device__ __forceinline__ void operator()(f32x4 (&acc)[2][2][4][2], const Unit& u, int wr, int wc, int fr, int fq) const {
        const int row0 = u.pm * BM + wr * 64 + fr, col0 = u.pn * BM + wc * 32 + 8 * fq;
        const bool last = (u.g == 2);
#pragma unroll
        for (int ai = 0; ai < 2; ++ai) {
            u32x4 gw[4][2], gn[4][2];
#pragma unroll
            for (int m = 0; m < 4; ++m)
#pragma unroll
                for (int bj = 0; bj < 2; ++bj) { const size_t row = (size_t)(row0 + ai * HALF + m * 16); const int col = col0 + bj * HALF;
                    gw[m][bj] = *(const u32x4*)(GT + row * GC + u.g * 1024 + col);
                    gn[m][bj] = last ? (u32x4){0x3f803f80u, 0x3f803f80u, 0x3f803f80u, 0x3f803f80u} : *(const u32x4*)(GT + row * GC + (u.g + 1) * 1024 + col); }
#pragma unroll
            for (int m = 0; m < 4; ++m)
#pragma unroll
                for (int bj = 0; bj < 2; ++bj) { const size_t row = (size_t)(row0 + ai * HALF + m * 16); const int col = col0 + bj * HALF;
                    float gf[8], nf[8], v[8]; unpack8(gw[m][bj], gf); unpack8(gn[m][bj], nf);
#pragma unroll
                    for (int j = 0; j < 4; ++j) { v[j] = gf[j] * acc[ai][bj][m][0][j]; v[4 + j] = gf[4 + j] * acc[ai][bj][m][1][j]; }
                    if (last) { *(u32x4*)(MG + row * 1024 + col) = pack8(v); acc[ai][bj][m][0] = (f32x4){0.f, 0.f, 0.f, 0.f}; acc[ai][bj][m][1] = (f32x4){0.f, 0.f, 0.f, 0.f}; }
                    else {
#pragma unroll
                        for (int j = 0; j < 4; ++j) { acc[ai][bj][m][0][j] = v[j] * __builtin_amdgcn_rcpf(fmaxf(nf[j], 1e-30f)); acc[ai][bj][m][1][j] = v[4 + j] * __builtin_amdgcn_rcpf(fmaxf(nf[4 + j], 1e-30f)); } }
                }
        }
    }
};

__device__ __forceinline__ float dpp_row_shr1(float x) { return __int_as_float(__builtin_amdgcn_update_dpp(0, __float_as_int(x), 0x111, 0xf, 0xf, false)); }
__device__ __forceinline__ float dpp_row_shr2(float x) { return __int_as_float(__builtin_amdgcn_update_dpp(0, __float_as_int(x), 0x112, 0xf, 0xf, false)); }
__device__ __forceinline__ float dpp_row_ror1(float x) { return __int_as_float(__builtin_amdgcn_update_dpp(0, __float_as_int(x), 0x121, 0xf, 0xf, false)); }
__device__ __forceinline__ float dpp_row_ror2(float x) { return __int_as_float(__builtin_amdgcn_update_dpp(0, __float_as_int(x), 0x122, 0xf, 0xf, false)); }
__device__ __forceinline__ f32x2 gelu_tanh_mul2(f32x2 gt, f32x2 up) {
    const f32x2 g2 = gt * gt;
    const f32x2 t = gt * (g2 * 0.044715f + 1.0f);
    const f32x2 sx = t * (-2.0f * 0.7978845608028654f * 1.4426950408889634f);
    f32x2 e; e.x = __builtin_amdgcn_exp2f(sx.x); e.y = __builtin_amdgcn_exp2f(sx.y);
    const f32x2 d = e + 1.0f;
    f32x2 r; r.x = __builtin_amdgcn_rcpf(d.x); r.y = __builtin_amdgcn_rcpf(d.y);
    return gt * r * up;
}
__device__ __forceinline__ float gelu_tanh_mul(float gt, float up) {
    const float uu = 0.7978845608028654f * (gt + 0.044715f * gt * gt * gt);
    return gt * __builtin_amdgcn_rcpf(1.0f + __expf(-2.0f * uu)) * up;
}
struct EpiFFN {
    static constexpr bool PERM = true, AFTER_DRAIN = false, KEEP_ACC = false;
    bf16_t* ACT; float* HG; float* HU; const float* cw; const float* cb; LAS unsigned char* xlds;
    __device__ __forceinline__ void operator()(const f32x4 (&acc)[2][2][4][2], const Unit& u, int wr, int wc, int fr, int fq) const {
        const int chl = wc * 32 + 8 * fq, chg = u.pn * 128 + chl;
        LAS float* XG = (LAS float*)xlds;
        if (fr >= 14) {
#pragma unroll
            for (int ai = 0; ai < 2; ++ai) { LAS float* p = XG + ((2 * ai + wr) * 2 + (fr - 14)) * 128 + chl; *(LAS f32x4*)p = acc[ai][0][3][0]; *(LAS f32x4*)(p + 4) = acc[ai][0][3][1]; }
            if (wr == 1) { float* hp = HG + ((size_t)u.pm * 4 + 2 + (fr - 14)) * FF + chg; *(f32x4*)hp = acc[1][0][3][0]; *(f32x4*)(hp + 4) = acc[1][0][3][1]; }
        }
        if (fr < 2 && wr == 0) {
            float* hp = HG + ((size_t)u.pm * 4 + fr) * FF + chg; *(f32x4*)hp = acc[0][0][0][0]; *(f32x4*)(hp + 4) = acc[0][0][0][1];
            float* up = HU + ((size_t)u.pm * 2 + fr) * FF + chg; *(f32x4*)up = acc[0][1][0][0]; *(f32x4*)(up + 4) = acc[0][1][0][1];
        }
        asm volatile("s_waitcnt lgkmcnt(0)" ::: "memory"); __builtin_amdgcn_s_barrier(); asm volatile("" ::: "memory");
        float w0[8], w1[8], w2[8], bb[8];
        { const f32x4 a0 = *(const f32x4*)(cw + chg), a1 = *(const f32x4*)(cw + chg + 4), b0 = *(const f32x4*)(cw + FF + chg), b1 = *(const f32x4*)(cw + FF + chg + 4),
                      c0 = *(const f32x4*)(cw + 2 * FF + chg), c1 = *(const f32x4*)(cw + 2 * FF + chg + 4), d0 = *(const f32x4*)(cb + chg), d1 = *(const f32x4*)(cb + chg + 4);
#pragma unroll
          for (int j = 0; j < 4; ++j) { w0[j] = a0[j]; w0[4 + j] = a1[j]; w1[j] = b0[j]; w1[4 + j] = b1[j]; w2[j] = c0[j]; w2[4 + j] = c1[j]; bb[j] = d0[j]; bb[4 + j] = d1[j]; } }
#pragma unroll
        for (int ai = 0; ai < 2; ++ai)
#pragma unroll
            for (int m = 0; m < 4; ++m) {
                const int B = 2 * ai + wr;
                float g8[8], u8[8], q15[8], q14[8], o[8];
#pragma unroll
                for (int j = 0; j < 4; ++j) { g8[j] = acc[ai][0][m][0][j]; g8[4 + j] = acc[ai][0][m][1][j]; u8[j] = acc[ai][1][m][0][j]; u8[4 + j] = acc[ai][1][m][1][j]; }
                if (m == 0) {
                    if (B > 0) { const LAS float* p = XG + ((B - 1) * 2) * 128 + chl; const f32x4 r0a = *(const LAS f32x4*)p, r0b = *(const LAS f32x4*)(p + 4), r1a = *(const LAS f32x4*)(p + 128), r1b = *(const LAS f32x4*)(p + 132);
#pragma unroll
                        for (int j = 0; j < 4; ++j) { q14[j] = r0a[j]; q14[4 + j] = r0b[j]; q15[j] = r1a[j]; q15[4 + j] = r1b[j]; } }
                    else {
#pragma unroll
                        for (int j = 0; j < 8; ++j) { q14[j] = 0.f; q15[j] = 0.f; } }
                    float p1a[8], p2a[8];
#pragma unroll
                    for (int e = 0; e < 8; ++e) { const float s1 = dpp_row_shr1(g8[e]), s2 = dpp_row_shr2(g8[e]);
                        p1a[e] = (fr >= 1) ? s1 : q15[e]; p2a[e] = (fr >= 2) ? s2 : ((fr == 1) ? q15[e] : q14[e]); }
#pragma unroll
                    for (int e = 0; e < 8; e += 2) { const f32x2 gt = (f32x2){w0[e], w0[e + 1]} * (f32x2){p2a[e], p2a[e + 1]} + (f32x2){w1[e], w1[e + 1]} * (f32x2){p1a[e], p1a[e + 1]} + (f32x2){w2[e], w2[e + 1]} * (f32x2){g8[e], g8[e + 1]} + (f32x2){bb[e], bb[e + 1]};
                        const f32x2 r = gelu_tanh_mul2(gt, (f32x2){u8[e], u8[e + 1]}); o[e] = r.x; o[e + 1] = r.y; }
                } else {
                    float p1a[8], p2a[8];
#pragma unroll
                    for (int e = 0; e < 8; ++e) { const float pv = (e < 4) ? acc[ai][0][m - 1][0][e & 3] : acc[ai][0][m - 1][1][e & 3];
                        const float s1 = dpp_row_shr1(g8[e]), s2 = dpp_row_shr2(g8[e]), r1 = dpp_row_ror1(pv), r2 = dpp_row_ror2(pv);
                        p1a[e] = (fr >= 1) ? s1 : r1; p2a[e] = (fr >= 2) ? s2 : r2; }
#pragma unroll
                    for (int e = 0; e < 8; e += 2) { const f32x2 gt = (f32x2){w0[e], w0[e + 1]} * (f32x2){p2a[e], p2a[e + 1]} + (f32x2){w1[e], w1[e + 1]} * (f32x2){p1a[e], p1a[e + 1]} + (f32x2){w2[e], w2[e + 1]} * (f32x2){g8[e], g8[e + 1]} + (f32x2){bb[e], bb[e + 1]};
                        const f32x2 r = gelu_tanh_mul2(gt, (f32x2){u8[e], u8[e + 1]}); o[e] = r.x; o[e + 1] = r.y; }
                }
                const int rloc = 128 * ai + 64 * wr + 16 * m + fr;
                if (!(B == 0 && m == 0 && fr < 2)) *(u32x4*)(ACT + (size_t)(u.pm * BM + rloc) * FF + chg) = pack8(o);
            }
    }
};

struct EpiNormRes {
    static constexpr bool PERM = false, AFTER_DRAIN = true, KEEP_ACC = false;
    const float* xin; float* xout; bf16_t* H2; const float* g1; const float* g2; unsigned* xs1; unsigned* xs2; unsigned* cnt1; unsigned* cnt2;
    __device__ __forceinline__ void exchange(const f32x4 (&v)[2][2][4][2], const Unit& u, int wr, int wc, int fr, int fq, LAS unsigned char* lds, unsigned* xs, unsigned* cnt) const {
        LAS float* Pp = (LAS float*)lds;
        LAS float* S = (LAS float*)(lds + 4096);
        const int tid = get_tid();
#pragma unroll
        for (int ai = 0; ai < 2; ++ai)
#pragma unroll
            for (int m = 0; m < 4; ++m) { float sq = 0.f;
#pragma unroll
                for (int bj = 0; bj < 2; ++bj)
#pragma unroll
                    for (int n = 0; n < 2; ++n) { const f32x4 x = v[ai][bj][m][n]; sq += (x[0] * x[0] + x[1] * x[1]) + (x[2] * x[2] + x[3] * x[3]); }
                sq += __shfl_xor(sq, 16); sq += __shfl_xor(sq, 32);
                if (fq == 0) Pp[(ai * HALF + wr * 64 + m * 16 + fr) * 4 + wc] = sq; }
        asm volatile("s_waitcnt lgkmcnt(0)" ::: "memory"); __builtin_amdgcn_s_barrier(); asm volatile("" ::: "memory");
        if (tid < 256) { const f32x4 p = *(const LAS f32x4*)(Pp + tid * 4);
            __hip_atomic_store(xs + ((size_t)(u.pm * BM + tid)) * 4 + u.pn, __float_as_uint((p[0] + p[1]) + (p[2] + p[3])), __ATOMIC_RELAXED, __HIP_MEMORY_SCOPE_AGENT); }
        asm volatile("s_waitcnt vmcnt(0)" ::: "memory");
        __syncthreads();
        if (tid == 0) {
            __hip_atomic_fetch_add(cnt + u.pm * 4, 1u, __ATOMIC_RELAXED, __HIP_MEMORY_SCOPE_AGENT);
            unsigned sp = 0u;
            while (__hip_atomic_load(cnt + u.pm * 4, __ATOMIC_RELAXED, __HIP_MEMORY_SCOPE_AGENT) < 4u) { __builtin_amdgcn_s_sleep(1); if (++sp > (1u << 22)) break; }
            __builtin_amdgcn_fence(__ATOMIC_ACQUIRE, "agent");
            asm volatile("s_waitcnt vmcnt(0)" ::: "memory");
        }
        __syncthreads();
        if (tid < 256) { const unsigned* q = xs + ((size_t)(u.pm * BM + tid)) * 4; float t = 0.f;
#pragma unroll
            for (int k = 0; k < 4; ++k) t += __uint_as_float(__hip_atomic_load(q + k, __ATOMIC_RELAXED, __HIP_MEMORY_SCOPE_AGENT));
            S[tid] = rsqrtf(t * (1.0f / 1024.0f) + EPS); }
        asm volatile("s_waitcnt lgkmcnt(0)" ::: "memory"); __syncthreads();
    }
    __device__ __forceinline__ void fused(f32x4 (&acc)[2][2][4][2], const Unit& u, int wr, int wc, int fr, int fq, LAS unsigned char* lds) const {
        const LAS float* S = (const LAS float*)(lds + 4096);
        const int col0 = u.pn * BM + wc * 32 + 4 * fq;
        exchange(acc, u, wr, wc, fr, fq, lds, xs1, cnt1);
        {
            f32x4 gv[2][2];
#pragma unroll
            for (int bj = 0; bj < 2; ++bj)
#pragma unroll
                for (int n = 0; n < 2; ++n) gv[bj][n] = *(const f32x4*)(g1 + col0 + bj * HALF + n * 16);
#pragma unroll
            for (int ai = 0; ai < 2; ++ai) {
                f32x4 xv[4][2][2];
#pragma unroll
                for (int m = 0; m < 4; ++m)
#pragma unroll
                    for (int bj = 0; bj < 2; ++bj)
#pragma unroll
                        for (int n = 0; n < 2; ++n) xv[m][bj][n] = *(const f32x4*)(xin + (size_t)(u.pm * BM + ai * HALF + wr * 64 + m * 16 + fr) * DM + col0 + bj * HALF + n * 16);
#pragma unroll
                for (int m = 0; m < 4; ++m) { const int r = ai * HALF + wr * 64 + m * 16 + fr; const float r1 = S[r];
#pragma unroll
                    for (int bj = 0; bj < 2; ++bj)
#pragma unroll
                        for (int n = 0; n < 2; ++n) { acc[ai][bj][m][n] = xv[m][bj][n] + acc[ai][bj][m][n] * r1 * gv[bj][n];
                            *(f32x4*)(xout + (size_t)(u.pm * BM + r) * DM + col0 + bj * HALF + n * 16) = acc[ai][bj][m][n]; } }
            }
        }
        asm volatile("s_waitcnt lgkmcnt(0)" ::: "memory"); __syncthreads();
        exchange(acc, u, wr, wc, fr, fq, lds, xs2, cnt2);
        {
            f32x4 gv[2][2];
#pragma unroll
            for (int bj = 0; bj < 2; ++bj)
#pragma unroll
                for (int n = 0; n < 2; ++n) gv[bj][n] = *(const f32x4*)(g2 + col0 + bj * HALF + n * 16);
#pragma unroll
            for (int ai = 0; ai < 2; ++ai)
#pragma unroll
                for (int m = 0; m < 4; ++m) { const int r = ai * HALF + wr * 64 + m * 16 + fr; const float r2 = S[r];
#pragma unroll
                    for (int bj = 0; bj < 2; ++bj)
#pragma unroll
                        for (int n = 0; n < 2; ++n) { const f32x4 h = acc[ai][bj][m][n] * r2 * gv[bj][n]; u32x2 w; w.x = cvt_pk_bf16(h[0], h[1]); w.y = cvt_pk_bf16(h[2], h[3]);
                            *(u32x2*)(H2 + (size_t)(u.pm * BM + r) * DM + col0 + bj * HALF + n * 16) = w; } }
        }
        asm volatile("s_waitcnt lgkmcnt(0)" ::: "memory"); __syncthreads();
    }
    __device__ __forceinline__ void operator()(const f32x4 (&)[2][2][4][2], const Unit&, int, int, int, int) const {}
};
}

__device__ __forceinline__ void transpose_tile(const float* src, int ld, int k0, int n0s, bf16_t* dst, int dk, int n0d, LAS float* tile) {
    const int tid = get_tid();
    { const int r = tid >> 4, c4 = (tid & 15) * 4;
#pragma unroll
      for (int i = 0; i < 2; ++i) { const f32x4 v = *(const f32x4*)(src + (size_t)(k0 + r + 32 * i) * ld + n0s + c4);
          LAS float* t = tile + (r + 32 * i) * 65 + c4; t[0] = v[0]; t[1] = v[1]; t[2] = v[2]; t[3] = v[3]; } }
    __syncthreads();
    { const int n = tid >> 3, ks = (tid & 7) * 8; float e[8];
#pragma unroll
      for (int j = 0; j < 8; ++j) e[j] = tile[(ks + j) * 65 + n];
      *(u32x4*)(dst + (size_t)(n0d + n) * dk + k0 + ks) = pack8(e); }
    __syncthreads();
}

__device__ void phase_convert(const Params& P, int l, LAS unsigned char* lds) {
    LAS float* tile = (LAS float*)lds;
    unsigned char* ws = P.ws;
    bf16_t* W1 = (bf16_t*)(ws + WS_W1); bf16_t* WBR = (bf16_t*)(ws + WS_WBR); bf16_t* WMO = (bf16_t*)(ws + WS_WMO); bf16_t* WFF = (bf16_t*)(ws + WS_WFF); bf16_t* WD = (bf16_t*)(ws + WS_WD);
    const float* win = P.w_in + (size_t)l * 1024 * IN_COLS;
#define SEG(src, ld, ktiles, ntiles, n0s, dst, dk, n0d) if (r < (ktiles) * (ntiles)) { const int kt = r / (ntiles), ntl = r % (ntiles); transpose_tile(src, ld, kt * 64, (n0s) + ntl * 64, dst, dk, (n0d) + ntl * 64, tile); continue; } r -= (ktiles) * (ntiles);
    constexpr int total = 16 * 120 + 16 * 48 + 3 * 8 * 16 + 16 * 16 + 16 * 44 + 16 * 44 + 44 * 16;
    for (int it = blockIdx.x; it < total; it += gridDim.x) {
        int r = it;
        SEG(win, IN_COLS, 16, 8, 0, W1, 1024, ZQ)
        SEG(win, IN_COLS, 16, 8, 512, W1, 1024, ZV)
        SEG(win, IN_COLS, 16, 8, 1024, W1, 1024, ZG)
        SEG(win, IN_COLS, 16, 8, 1552, W1, 1024, ZSB)
        SEG(win, IN_COLS, 16, 8, 2064, W1, 1024, ZSC)
        SEG(win, IN_COLS, 16, 8, 2576, W1, 1024, ZSX)
        SEG(win, IN_COLS, 16, 72, 3088, W1, 1024, ZDQ)
        SEG(P.w_gate + (size_t)l * 1024 * 3072, 3072, 16, 48, 0, W1, 1024, 7680)
        SEG(P.w_branch + ((size_t)l * 3 + 0) * 512 * 1024, 1024, 8, 16, 0, WBR, 512, 0)
        SEG(P.w_branch + ((size_t)l * 3 + 1) * 512 * 1024, 1024, 8, 16, 0, WBR + (size_t)1024 * 512, 512, 0)
        SEG(P.w_branch + ((size_t)l * 3 + 2) * 512 * 1024, 1024, 8, 16, 0, WBR + (size_t)2 * 1024 * 512, 512, 0)
        SEG(P.w_mix_out + (size_t)l * 1024 * 1024, 1024, 16, 16, 0, WMO, 1024, 0)
        if (r < 16 * 44) { const int kt = r / 44, ntl = r % 44; transpose_tile(P.w_ff_gate + (size_t)l * 1024 * FF, FF, kt * 64, ntl * 64, WFF, 1024, 256 * (ntl >> 1) + 64 * (ntl & 1), tile); continue; } r -= 16 * 44;
        if (r < 16 * 44) { const int kt = r / 44, ntl = r % 44; transpose_tile(P.w_ff_up + (size_t)l * 1024 * FF, FF, kt * 64, ntl * 64, WFF, 1024, 256 * (ntl >> 1) + 128 + 64 * (ntl & 1), tile); continue; } r -= 16 * 44;
        SEG(P.w_ff_down + (size_t)l * FF * 1024, 1024, 44, 16, 0, WD, FF, 0)
    }
#undef SEG
    { const int t = get_tid();
      if (l == 0 && blockIdx.x == 0 && t < 64) ((float*)(ws + WS_RC))[t] = exp2f(-(float)t * (13.287712379549449f / 64.0f)); }
}

__device__ __forceinline__ float wave_sum(float v) {
#pragma unroll
    for (int o = 32; o >= 1; o >>= 1) v += __shfl_xor(v, o);
    return v;
}

__device__ void phase_norm_alow(const Params& P, int l, int half, LAS unsigned char* lds) {
    const int tid = get_tid(), lane = tid & 63, wave = tid >> 6;
    LAS float* WaT = (LAS float*)lds;
    const float* win = P.w_in + (size_t)l * 1024 * IN_COLS + 1536;
    for (int i = tid; i < 1024 * 4; i += NTHR) { const int k = i >> 2, c4 = (i & 3) * 4; const f32x4 v = *(const f32x4*)(win + (size_t)k * IN_COLS + c4);
        WaT[(c4 + 0) * 1024 + k] = v[0]; WaT[(c4 + 1) * 1024 + k] = v[1]; WaT[(c4 + 2) * 1024 + k] = v[2]; WaT[(c4 + 3) * 1024 + k] = v[3]; }
    __syncthreads();
    const float* xs = (l == 0 ? P.x : P.out) + (size_t)half * TH * DM;
    const float* gg = P.pre_mix_g + (size_t)l * DM;
    bf16_t* H = (bf16_t*)(P.ws + WS_H) + (size_t)half * TH * DM; float* AL = (float*)(P.ws + WS_ALOW);
    f32x4 gv[4];
#pragma unroll
    for (int i = 0; i < 4; ++i) gv[i] = *(const f32x4*)(gg + i * 256 + lane * 4);
    const int rstride = gridDim.x * 8;
    int row = blockIdx.x * 8 + wave;
    f32x4 nv[4];
    if (row < TH) {
#pragma unroll
        for (int i = 0; i < 4; ++i) nv[i] = *(const f32x4*)(xs + (size_t)row * DM + i * 256 + lane * 4);
    }
    for (; row < TH; row += rstride) {
        f32x4 v[4]; float ss = 0.f;
#pragma unroll
        for (int i = 0; i < 4; ++i) { v[i] = nv[i]; ss += v[i][0] * v[i][0] + v[i][1] * v[i][1] + v[i][2] * v[i][2] + v[i][3] * v[i][3]; }
        if (row + rstride < TH) {
#pragma unroll
            for (int i = 0; i < 4; ++i) nv[i] = *(const f32x4*)(xs + (size_t)(row + rstride) * DM + i * 256 + lane * 4);
        }
        ss = wave_sum(ss);
        const float r = rsqrtf(ss * (1.0f / DM) + EPS);
        float a[16];
#pragma unroll
        for (int c = 0; c < 16; ++c) a[c] = 0.f;
#pragma unroll
        for (int i = 0; i < 4; ++i) { f32x4 h = v[i] * r * gv[i];
            u32x2 w; w.x = cvt_pk_bf16(h[0], h[1]); w.y = cvt_pk_bf16(h[2], h[3]);
            *(u32x2*)(H + (size_t)row * DM + i * 256 + lane * 4) = w;
#pragma unroll
            for (int c = 0; c < 16; ++c) { const f32x4 wv = *(const LAS f32x4*)(WaT + c * 1024 + i * 256 + lane * 4); a[c] += h[0] * wv[0] + h[1] * wv[1] + h[2] * wv[2] + h[3] * wv[3]; } }
        float b8[8], b4[4], b2[2], b1;
        { const bool up = (lane & 32) != 0;
#pragma unroll
          for (int c = 0; c < 8; ++c) { const float keep = up ? a[c + 8] : a[c], send = up ? a[c] : a[c + 8]; b8[c] = keep + __shfl_xor(send, 32); } }
        { const bool up = (lane & 16) != 0;
#pragma unroll
          for (int c = 0; c < 4; ++c) { const float keep = up ? b8[c + 4] : b8[c], send = up ? b8[c] : b8[c + 4]; b4[c] = keep + __shfl_xor(send, 16); } }
        { const bool up = (lane & 8) != 0;
#pragma unroll
          for (int c = 0; c < 2; ++c) { const float keep = up ? b4[c + 2] : b4[c], send = up ? b4[c] : b4[c + 2]; b2[c] = keep + __shfl_xor(send, 8); } }
        { const bool up = (lane & 4) != 0; const float keep = up ? b2[1] : b2[0], send = up ? b2[0] : b2[1]; b1 = keep + __shfl_xor(send, 4); }
        b1 += __shfl_xor(b1, 2); b1 += __shfl_xor(b1, 1);
        if ((lane & 3) == 0) { const int co = ((lane >> 5) & 1) * 8 + ((lane >> 4) & 1) * 4 + ((lane >> 3) & 1) * 2 + ((lane >> 2) & 1); AL[(size_t)row * 16 + co] = b1; }
    }
}

__device__ void phase_resid(const float* xin, float* xout, const bf16_t* Y, const float* pg, const float* ng, bf16_t* H2, int nrows) {
    const int tid = get_tid(), lane = tid & 63, wave = tid >> 6;
    f32x4 pgv[4], ngv[4];
#pragma unroll
    for (int i = 0; i < 4; ++i) { pgv[i] = *(const f32x4*)(pg + i * 256 + lane * 4); ngv[i] = ng ? *(const f32x4*)(ng + i * 256 + lane * 4) : (f32x4){0.f, 0.f, 0.f, 0.f}; }
    const int stride = gridDim.x * 8;
    int row = blockIdx.x * 8 + wave;
    u32x2 ny[4]; f32x4 nx[4];
    if (row < nrows) {
#pragma unroll
        for (int i = 0; i < 4; ++i) { ny[i] = *(const u32x2*)(Y + (size_t)row * DM + i * 256 + lane * 4); nx[i] = *(const f32x4*)(xin + (size_t)row * DM + i * 256 + lane * 4); }
    }
    for (; row < nrows; row += stride) {
        f32x4 y[4], xv[4];
#pragma unroll
        for (int i = 0; i < 4; ++i) { y[i] = (f32x4){bflo(ny[i].x), bfhi(ny[i].x), bflo(ny[i].y), bfhi(ny[i].y)}; xv[i] = nx[i]; }
        const int rn = row + stride;
        if (rn < nrows) {
#pragma unroll
            for (int i = 0; i < 4; ++i) { ny[i] = *(const u32x2*)(Y + (size_t)rn * DM + i * 256 + lane * 4); nx[i] = *(const f32x4*)(xin + (size_t)rn * DM + i * 256 + lane * 4); }
        }
        float ss = 0.f;
#pragma unroll
        for (int i = 0; i < 4; ++i) ss += y[i][0] * y[i][0] + y[i][1] * y[i][1] + y[i][2] * y[i][2] + y[i][3] * y[i][3];
        ss = wave_sum(ss);
        const float r = rsqrtf(ss * (1.0f / DM) + EPS);
        float s2 = 0.f;
#pragma unroll
        for (int i = 0; i < 4; ++i) { xv[i] = xv[i] + y[i] * r * pgv[i]; *(f32x4*)(xout + (size_t)row * DM + i * 256 + lane * 4) = xv[i];
            s2 += xv[i][0] * xv[i][0] + xv[i][1] * xv[i][1] + xv[i][2] * xv[i][2] + xv[i][3] * xv[i][3]; }
        if (ng) {
            s2 = wave_sum(s2);
            const float r2 = rsqrtf(s2 * (1.0f / DM) + EPS);
#pragma unroll
            for (int i = 0; i < 4; ++i) { const f32x4 h = xv[i] * r2 * ngv[i]; u32x2 w; w.x = cvt_pk_bf16(h[0], h[1]); w.y = cvt_pk_bf16(h[2], h[3]);
                *(u32x2*)(H2 + (size_t)row * DM + i * 256 + lane * 4) = w; }
        }
    }
}

__device__ void phase_combine(const Params& P) {
    bf16_t* Z = (bf16_t*)(P.ws + WS_Z); const float* LSE = (const float*)(P.ws + WS_LSE);
    const int stride = gridDim.x * NTHR;
    for (int idx0 = blockIdx.x * NTHR + get_tid(); idx0 < TH * 64; idx0 += 2 * stride) {
        float lw[2][3]; u32x4 va[2], vb[2], vc[2]; bf16_t* pp[2]; bool ok[2];
#pragma unroll
        for (int k = 0; k < 2; ++k) { const int idx = idx0 + k * stride; ok[k] = idx < TH * 64; const int id2 = ok[k] ? idx : idx0;
            const int tok = id2 >> 6, c8 = id2 & 63, hh = c8 >> 4, d0 = (c8 & 15) * 8;
            lw[k][0] = LSE[tok * 12 + hh]; lw[k][1] = LSE[tok * 12 + 4 + hh]; lw[k][2] = LSE[tok * 12 + 8 + hh];
            pp[k] = Z + (size_t)tok * ZC + ZDQ + hh * 128 + d0;
            va[k] = *(const u32x4*)pp[k]; vb[k] = *(const u32x4*)(pp[k] + 512); vc[k] = *(const u32x4*)(pp[k] + 1024); }
#pragma unroll
        for (int k = 0; k < 2; ++k) {
            const float mx = fmaxf(lw[k][0], fmaxf(lw[k][1], lw[k][2]));
            float w0 = __expf(lw[k][0] - mx), w1 = __expf(lw[k][1] - mx), w2 = __expf(lw[k][2] - mx);
            const float inv = 1.0f / (w0 + w1 + w2); w0 *= inv; w1 *= inv; w2 *= inv;
            float a[8], b[8], c[8], o[8];
            unpack8(va[k], a); unpack8(vb[k], b); unpack8(vc[k], c);
#pragma unroll
            for (int j = 0; j < 8; ++j) o[j] = w0 * a[j] + w1 * b[j] + w2 * c[j];
            if (ok[k]) *(u32x4*)pp[k] = pack8(o);
        }
    }
}

__device__ void phase_ffn_fix(const Params& P, int l) {
    bf16_t* ACT = (bf16_t*)(P.ws + WS_U); const float* HG = (const float*)(P.ws + WS_HG); const float* HU = (const float*)(P.ws + WS_HU);
    const float* cw = P.ff_conv_w + (size_t)l * 3 * FF; const float* cb = P.ff_conv_b + (size_t)l * FF;
    for (int idx = blockIdx.x * NTHR + get_tid(); idx < 128 * (FF / 8); idx += gridDim.x * NTHR) {
        const int pm = idx / (FF / 8), c0 = (idx % (FF / 8)) * 8;
        float o0[8], o1[8];
#pragma unroll
        for (int hf = 0; hf < 2; ++hf) {
            const int c = c0 + 4 * hf;
            const f32x4 z = (f32x4){0.f, 0.f, 0.f, 0.f};
            const bool first = (pm & 7) == 0;
            const f32x4 gm2 = first ? z : *(const f32x4*)(HG + ((size_t)(pm - 1) * 4 + 2) * FF + c), gm1 = first ? z : *(const f32x4*)(HG + ((size_t)(pm - 1) * 4 + 3) * FF + c);
            const f32x4 g0 = *(const f32x4*)(HG + ((size_t)pm * 4 + 0) * FF + c), g1 = *(const f32x4*)(HG + ((size_t)pm * 4 + 1) * FF + c);
            const f32x4 u0 = *(const f32x4*)(HU + ((size_t)pm * 2 + 0) * FF + c), u1 = *(const f32x4*)(HU + ((size_t)pm * 2 + 1) * FF + c);
            const f32x4 w0 = *(const f32x4*)(cw + c), w1 = *(const f32x4*)(cw + FF + c), w2 = *(const f32x4*)(cw + 2 * FF + c), bb = *(const f32x4*)(cb + c);
#pragma unroll
            for (int j = 0; j < 4; ++j) { o0[4 * hf + j] = pg8::gelu_tanh_mul(w0[j] * gm2[j] + w1[j] * gm1[j] + w2[j] * g0[j] + bb[j], u0[j]);
                                          o1[4 * hf + j] = pg8::gelu_tanh_mul(w0[j] * gm1[j] + w1[j] * g0[j] + w2[j] * g1[j] + bb[j], u1[j]); }
        }
        *(u32x4*)(ACT + (size_t)(pm * 256 + 0) * FF + c0) = pack8(o0);
        *(u32x4*)(ACT + (size_t)(pm * 256 + 1) * FF + c0) = pack8(o1);
    }
}

__device__ __forceinline__ void sc_item(const Params& P, int l, int si) {
    bf16_t* Z = (bf16_t*)(P.ws + WS_Z);
    const int tid = get_tid(), cgi = tid & 63, run = tid >> 6, c0 = cgi * 8, t0 = si * 128 + run * 16;
    const float* cw = P.sc_conv_w + (size_t)l * 3 * 512;
    float w0[8], w1[8], w2[8];
#pragma unroll
    for (int j = 0; j < 8; ++j) { w0[j] = cw[c0 + j]; w1[j] = cw[512 + c0 + j]; w2[j] = cw[1024 + c0 + j]; }
    float p1[8], p2[8];
    if ((t0 & 2047) != 0) {
        float a[8], b[8];
        unpack8(*(const u32x4*)(Z + (size_t)(t0 - 1) * ZC + ZSC + c0), a); unpack8(*(const u32x4*)(Z + (size_t)(t0 - 1) * ZC + ZSX + c0), b);
#pragma unroll
        for (int j = 0; j < 8; ++j) p1[j] = a[j] * b[j];
        unpack8(*(const u32x4*)(Z + (size_t)(t0 - 2) * ZC + ZSC + c0), a); unpack8(*(const u32x4*)(Z + (size_t)(t0 - 2) * ZC + ZSX + c0), b);
#pragma unroll
        for (int j = 0; j < 8; ++j) p2[j] = a[j] * b[j];
    } else {
#pragma unroll
        for (int j = 0; j < 8; ++j) { p1[j] = 0.f; p2[j] = 0.f; } }
    for (int tt = 0; tt < 16; tt += 4) {
        u32x4 va[4], vb[4], vs[4];
#pragma unroll
        for (int k = 0; k < 4; ++k) { const bf16_t* zr = Z + (size_t)(t0 + tt + k) * ZC; va[k] = *(const u32x4*)(zr + ZSC + c0); vb[k] = *(const u32x4*)(zr + ZSX + c0); vs[k] = *(const u32x4*)(zr + ZSB + c0); }
#pragma unroll
        for (int k = 0; k < 4; ++k) {
            float a[8], b[8], sb[8], o[8];
            unpack8(va[k], a); unpack8(vb[k], b); unpack8(vs[k], sb);
#pragma unroll
            for (int j = 0; j < 8; ++j) { const float p0 = a[j] * b[j]; o[j] = sb[j] * (w0[j] * p2[j] + w1[j] * p1[j] + w2[j] * p0); p2[j] = p1[j]; p1[j] = p0; }
            *(u32x4*)(Z + (size_t)(t0 + tt + k) * ZC + ZSB + c0) = pack8(o);
        }
    }
}

__device__ __forceinline__ void attn_item(const Params& P, int half, int item, LAS unsigned char* lds, unsigned* ctr) {
    const int tid = get_tid(), lane = tid & 63, w = __builtin_amdgcn_readfirstlane(tid >> 6), g = lane >> 4, c = lane & 15;
    const int b = item / 192, rem = item % 192, gi = rem / 64, r2 = rem % 64;
    const int dil = (gi == 0) ? 1 : (gi == 1 ? 4 : 16), nb = 16 / dil;
    const int n = r2 % nb, t2 = r2 / nb, hh = t2 & 3, rr = t2 >> 2;
    bf16_t* Z = (bf16_t*)(P.ws + WS_Z);
    const float* RC = (const float*)(P.ws + WS_RC); const float* RS = (const float*)(P.ws + WS_RS);
    float* LSE = (float*)(P.ws + WS_LSE);
    const int colq = ZDQ + gi * 512 + hh * 128, colk = ZDK + gi * 512 + hh * 128, colv = ZDV + gi * 512 + hh * 128;
    const int rowb = b * 2048, gtb = half * TH;
    constexpr int KSTR = 272, VSTR = 528;
    LAS unsigned char* Ks = lds; LAS unsigned char* Vt = lds + 256 * KSTR;
    constexpr float QSCALE = 0.08838834764831845f * 1.4426950408889634f;

    const int km = tid >> 1, khf = tid & 1, klk = (n - 1) * 128 + km;
    const int vkb = tid & 31, vdb = tid >> 5, vlk0 = (n - 1) * 128 + vkb * 8;
    const int qi = 16 * w + c, qrow = rowb + (n * 128 + qi) * dil + rr;
    u32x4 kx1[4], kx2[4]; f32x4 kinv[8]; float kpos = 0.f;
    u32x4 rv[8];
    u32x4 qx1[2], qx2[2]; f32x4 qinv[4]; float qpos;
    if (klk >= 0) {
        const int krow = rowb + klk * dil + rr;
        const bf16_t* kp = Z + (size_t)krow * ZC + colk + khf * 32;
        kpos = (float)P.pos[gtb + krow];
#pragma unroll
        for (int cc = 0; cc < 4; ++cc) { kx1[cc] = *(const u32x4*)(kp + cc * 8); kx2[cc] = *(const u32x4*)(kp + 64 + cc * 8);
            kinv[2 * cc] = *(const f32x4*)(RC + khf * 32 + cc * 8); kinv[2 * cc + 1] = *(const f32x4*)(RC + khf * 32 + cc * 8 + 4); }
    } else {
#pragma unroll
        for (int cc = 0; cc < 4; ++cc) { kx1[cc] = (u32x4){0u, 0u, 0u, 0u}; kx2[cc] = (u32x4){0u, 0u, 0u, 0u};
            kinv[2 * cc] = (f32x4){0.f, 0.f, 0.f, 0.f}; kinv[2 * cc + 1] = (f32x4){0.f, 0.f, 0.f, 0.f}; }
    }
    if (vlk0 >= 0) {
#pragma unroll
        for (int kk = 0; kk < 8; ++kk) { const int row = rowb + (vlk0 + kk) * dil + rr; rv[kk] = *(const u32x4*)(Z + (size_t)row * ZC + colv + vdb * 8); }
    } else {
#pragma unroll
        for (int kk = 0; kk < 8; ++kk) rv[kk] = (u32x4){0u, 0u, 0u, 0u};
    }
    {
        const bf16_t* qp = Z + (size_t)qrow * ZC + colq + 8 * g;
        qpos = (float)P.pos[gtb + qrow];
#pragma unroll
        for (int kh = 0; kh < 2; ++kh) { qx1[kh] = *(const u32x4*)(qp + kh * 32); qx2[kh] = *(const u32x4*)(qp + 64 + kh * 32);
            qinv[2 * kh] = *(const f32x4*)(RC + kh * 32 + 8 * g); qinv[2 * kh + 1] = *(const f32x4*)(RC + kh * 32 + 8 * g + 4); }
    }
    {
        LAS unsigned char* kd = Ks + km * KSTR;
#pragma unroll
        for (int cc = 0; cc < 4; ++cc) {
            float x1[8], x2[8], o1[8], o2[8];
            unpack8(kx1[cc], x1); unpack8(kx2[cc], x2);
            f32x4 c0, c1, s0, s1;
#pragma unroll
            for (int j = 0; j < 4; ++j) { const float r0 = __builtin_amdgcn_fractf(kpos * kinv[2 * cc][j] * 0.15915494309189535f), r1 = __builtin_amdgcn_fractf(kpos * kinv[2 * cc + 1][j] * 0.15915494309189535f);
                c0[j] = __builtin_amdgcn_cosf(r0); s0[j] = __builtin_amdgcn_sinf(r0); c1[j] = __builtin_amdgcn_cosf(r1); s1[j] = __builtin_amdgcn_sinf(r1); }
#pragma unroll
            for (int j = 0; j < 4; j += 2) {
                { const f32x2 X1 = (f32x2){x1[j], x1[j + 1]}, X2 = (f32x2){x2[j], x2[j + 1]}, C = (f32x2){c0[j], c0[j + 1]}, Sn = (f32x2){s0[j], s0[j + 1]};
                  const f32x2 A = X1 * C - X2 * Sn, B = X2 * C + X1 * Sn; o1[j] = A.x; o1[j + 1] = A.y; o2[j] = B.x; o2[j + 1] = B.y; }
                { const f32x2 X1 = (f32x2){x1[4 + j], x1[5 + j]}, X2 = (f32x2){x2[4 + j], x2[5 + j]}, C = (f32x2){c1[j], c1[j + 1]}, Sn = (f32x2){s1[j], s1[j + 1]};
                  const f32x2 A = X1 * C - X2 * Sn, B = X2 * C + X1 * Sn; o1[4 + j] = A.x; o1[5 + j] = A.y; o2[4 + j] = B.x; o2[5 + j] = B.y; } }
            *(LAS u32x4*)(kd + (khf * 32 + cc * 8) * 2) = pack8(o1); *(LAS u32x4*)(kd + (64 + khf * 32 + cc * 8) * 2) = pack8(o2);
        }
    }
    {
#pragma unroll
        for (int dd = 0; dd < 8; ++dd) {
            const int wi = dd >> 1; u32x4 o;
            if (dd & 1) { o.x = __builtin_amdgcn_perm(rv[1][wi], rv[0][wi], 0x07060302u); o.y = __builtin_amdgcn_perm(rv[3][wi], rv[2][wi], 0x07060302u); o.z = __builtin_amdgcn_perm(rv[5][wi], rv[4][wi], 0x07060302u); o.w = __builtin_amdgcn_perm(rv[7][wi], rv[6][wi], 0x07060302u); }
            else { o.x = __builtin_amdgcn_perm(rv[1][wi], rv[0][wi], 0x05040100u); o.y = __builtin_amdgcn_perm(rv[3][wi], rv[2][wi], 0x05040100u); o.z = __builtin_amdgcn_perm(rv[5][wi], rv[4][wi], 0x05040100u); o.w = __builtin_amdgcn_perm(rv[7][wi], rv[6][wi], 0x05040100u); }
            *(LAS u32x4*)(Vt + (vdb * 8 + dd) * VSTR + vkb * 16) = o;
        }
    }
    bf16x8 Qf[4];
    {
#pragma unroll
        for (int kh = 0; kh < 2; ++kh) {
            float x1[8], x2[8], o1[8], o2[8];
            unpack8(qx1[kh], x1); unpack8(qx2[kh], x2);
            f32x4 c0, c1, s0, s1;
#pragma unroll
            for (int j = 0; j < 4; ++j) { const float r0 = __builtin_amdgcn_fractf(qpos * qinv[2 * kh][j] * 0.15915494309189535f), r1 = __builtin_amdgcn_fractf(qpos * qinv[2 * kh + 1][j] * 0.15915494309189535f);
                c0[j] = __builtin_amdgcn_cosf(r0); s0[j] = __builtin_amdgcn_sinf(r0); c1[j] = __builtin_amdgcn_cosf(r1); s1[j] = __builtin_amdgcn_sinf(r1); }
#pragma unroll
            for (int j = 0; j < 4; ++j) { o1[j] = (x1[j] * c0[j] - x2[j] * s0[j]) * QSCALE; o2[j] = (x2[j] * c0[j] + x1[j] * s0[j]) * QSCALE;
                o1[4 + j] = (x1[4 + j] * c1[j] - x2[4 + j] * s1[j]) * QSCALE; o2[4 + j] = (x2[4 + j] * c1[j] + x1[4 + j] * s1[j]) * QSCALE; }
            Qf[kh] = as_bf16x8(pack8(o1)); Qf[kh + 2] = as_bf16x8(pack8(o2));
        }
    }
    __syncthreads();
    unsigned nxt_id = 0u;
    if (tid == 0) nxt_id = atomicAdd(ctr, 1u);
    const int m0 = (16 * w < 96) ? 16 * w : 96;
    f32x4 S[10];
#pragma unroll
    for (int jt = 0; jt < 10; ++jt) {
        S[jt] = (f32x4){0.f, 0.f, 0.f, 0.f};
        const LAS unsigned char* kr = Ks + (m0 + jt * 16 + c) * KSTR + 16 * g;
#pragma unroll
        for (int ks = 0; ks < 4; ++ks) { const bf16x8 a = *(const LAS bf16x8*)(kr + ks * 64); S[jt] = __builtin_amdgcn_mfma_f32_16x16x32_bf16(a, Qf[ks], S[jt], 0, 0, 0); }
    }
    float mx = -INFINITY;
    const int dbase = qi + 128 - m0 - 4 * g;
    const unsigned dlim = (unsigned)((n == 0) ? (qi < 128 ? qi : 128) : 128);
#pragma unroll
    for (int jt = 0; jt < 10; ++jt)
#pragma unroll
        for (int jj = 0; jj < 4; ++jj) { const bool ok = (unsigned)(dbase - (jt * 16 + jj)) <= dlim;
            const float s = ok ? S[jt][jj] : -INFINITY; S[jt][jj] = s; mx = fmaxf(mx, s); }
    mx = fmaxf(mx, __shfl_xor(mx, 16)); mx = fmaxf(mx, __shfl_xor(mx, 32));
    float den = 0.f;
#pragma unroll
    for (int jt = 0; jt < 10; ++jt)
#pragma unroll
        for (int jj = 0; jj < 4; ++jj) { const float p = __builtin_amdgcn_exp2f(S[jt][jj] - mx); S[jt][jj] = p; den += p; }
    den += __shfl_xor(den, 16); den += __shfl_xor(den, 32);
    bf16x8 Pf[5];
#pragma unroll
    for (int k5 = 0; k5 < 5; ++k5) { u32x4 pw; pw.x = cvt_pk_bf16(S[2 * k5][0], S[2 * k5][1]); pw.y = cvt_pk_bf16(S[2 * k5][2], S[2 * k5][3]); pw.z = cvt_pk_bf16(S[2 * k5 + 1][0], S[2 * k5 + 1][1]); pw.w = cvt_pk_bf16(S[2 * k5 + 1][2], S[2 * k5 + 1][3]); Pf[k5] = as_bf16x8(pw); }
    const float inv = 1.0f / den;
    bf16_t* op = Z + (size_t)qrow * ZC + colq + 4 * g;
#pragma unroll
    for (int dt = 0; dt < 8; ++dt) {
        f32x4 O = (f32x4){0.f, 0.f, 0.f, 0.f};
        const LAS unsigned char* vr = Vt + (dt * 16 + c) * VSTR + (m0 + 4 * g) * 2;
#pragma unroll
        for (int k5 = 0; k5 < 5; ++k5) { const u32x2 lo = *(const LAS u32x2*)(vr + k5 * 64), hi = *(const LAS u32x2*)(vr + k5 * 64 + 32);
            const bf16x8 a = as_bf16x8((u32x4){lo.x, lo.y, hi.x, hi.y}); O = __builtin_amdgcn_mfma_f32_16x16x32_bf16(a, Pf[k5], O, 0, 0, 0); }
        u32x2 ow; ow.x = cvt_pk_bf16(O[0] * inv, O[1] * inv); ow.y = cvt_pk_bf16(O[2] * inv, O[3] * inv);
        *(u32x2*)(op + dt * 16) = ow;
    }
    if (g == 0) LSE[(size_t)qrow * 12 + gi * 4 + hh] = (mx + __builtin_amdgcn_logf(den)) * 0.6931471805599453f;
    if (tid == 0) *(LAS unsigned*)(lds + LDS_SLOT) = nxt_id;
    __syncthreads();
}

__device__ __forceinline__ float logsig16(float x) { return (fminf(x, 0.f) - __logf(1.0f + __expf(-fabsf(x)))) * (1.0f / 16.0f); }

#define LBAR() do { asm volatile("s_waitcnt lgkmcnt(0)" ::: "memory"); __builtin_amdgcn_s_barrier(); asm volatile("" ::: "memory"); } while (0)
__device__ void gla_item(const Params& P, int l, int b, int h, int seg, LAS unsigned char* lds) {
    const int tid = get_tid(), lane = tid & 63, w = __builtin_amdgcn_readfirstlane(tid >> 6), g = lane >> 4, c = lane & 15;
    bf16_t* Z = (bf16_t*)(P.ws + WS_Z); const float* AL = (const float*)(P.ws + WS_ALOW);
    LAS float* WUP = (LAS float*)(lds + 0);
    LAS float* BUP = (LAS float*)(lds + 4096);
    LAS float* ARAW = (LAS float*)(lds + 4352);
    LAS float* LC = (LAS float*)(lds + 8448);
    LAS float* SEG = (LAS float*)(lds + 24832);
    LAS float* DEC = (LAS float*)(lds + 26880);
    LAS unsigned char* QP = lds + 29184;
    LAS unsigned char* KP = lds + 38400;
    LAS unsigned char* KPP = lds + 47616;
    LAS unsigned char* AIN = lds + 56832;
    LAS unsigned char* VS = lds + 66048;
    LAS unsigned char* OT = lds + 83456;
    constexpr int QS = 144, VSS = 272;
    for (int i = tid; i < 1024; i += NTHR) { const int r = i >> 6, d = i & 63; WUP[i] = P.w_alpha_up[((size_t)l * 16 + r) * 256 + h * 64 + d]; }
    if (tid < 64) BUP[tid] = P.b_alpha[(size_t)l * 256 + h * 64 + tid];
    f32x4 Sacc[4];
#pragma unroll
    for (int dt = 0; dt < 4; ++dt) Sacc[dt] = (f32x4){0.f, 0.f, 0.f, 0.f};
    const int rowb = b * 2048 + seg * 256;
    const int t_ = tid >> 3, d8 = (tid & 7) * 8;
    u32x4 nq, nk, nv0, nv1; f32x4 na = (f32x4){0.f, 0.f, 0.f, 0.f};
    {
        const size_t r0 = (size_t)(rowb + t_) * ZC;
        nq = *(const u32x4*)(Z + r0 + ZQ + h * 64 + d8); nk = *(const u32x4*)(Z + r0 + ZK + h * 64 + d8);
        nv0 = *(const u32x4*)(Z + (size_t)(rowb + (tid >> 4)) * ZC + ZV + h * 128 + (tid & 15) * 8);
        nv1 = *(const u32x4*)(Z + (size_t)(rowb + 32 + (tid >> 4)) * ZC + ZV + h * 128 + (tid & 15) * 8);
        if (tid < 256) na = *(const f32x4*)(AL + (size_t)(rowb + (tid >> 2)) * 16 + (tid & 3) * 4);
    }
    float Lseg[8];
#pragma unroll
    for (int j = 0; j < 8; ++j) Lseg[j] = 0.f;
    float* DSEG = (float*)(P.ws + WS_DSEG);
    for (int n = 0; n < 4; ++n) {
        if ((n & 3) == 0) {
#pragma unroll
            for (int dt = 0; dt < 4; ++dt) Sacc[dt] = (f32x4){0.f, 0.f, 0.f, 0.f};
#pragma unroll
            for (int j = 0; j < 8; ++j) Lseg[j] = 0.f;
        }
        const int row0 = rowb + n * 64;
        const u32x4 cq = nq, ck = nk;
        *(LAS u32x4*)(VS + (tid >> 4) * VSS + (tid & 15) * 16) = nv0;
        *(LAS u32x4*)(VS + (32 + (tid >> 4)) * VSS + (tid & 15) * 16) = nv1;
        if (tid < 256) *(LAS f32x4*)(ARAW + (tid >> 2) * 16 + (tid & 3) * 4) = na;
        if (n + 1 < 4) {
            const int rn = row0 + 64; const size_t r0 = (size_t)(rn + t_) * ZC;
            nq = *(const u32x4*)(Z + r0 + ZQ + h * 64 + d8); nk = *(const u32x4*)(Z + r0 + ZK + h * 64 + d8);
            nv0 = *(const u32x4*)(Z + (size_t)(rn + (tid >> 4)) * ZC + ZV + h * 128 + (tid & 15) * 8);
            nv1 = *(const u32x4*)(Z + (size_t)(rn + 32 + (tid >> 4)) * ZC + ZV + h * 128 + (tid & 15) * 8);
            if (tid < 256) na = *(const f32x4*)(AL + (size_t)(rn + (tid >> 2)) * 16 + (tid & 3) * 4);
        }
        LBAR();
        {
            float x[8];
#pragma unroll
            for (int j = 0; j < 8; ++j) x[j] = BUP[d8 + j];
#pragma unroll
            for (int r = 0; r < 16; ++r) { const float a = ARAW[t_ * 16 + r]; const f32x4 w0 = *(const LAS f32x4*)(WUP + r * 64 + d8), w1 = *(const LAS f32x4*)(WUP + r * 64 + d8 + 4);
#pragma unroll
                for (int j = 0; j < 4; ++j) { x[j] += a * w0[j]; x[4 + j] += a * w1[j]; } }
            f32x4 o0, o1;
#pragma unroll
            for (int j = 0; j < 4; ++j) { o0[j] = logsig16(x[j]); o1[j] = logsig16(x[4 + j]); }
            *(LAS f32x4*)(LC + t_ * 64 + d8) = o0; *(LAS f32x4*)(LC + t_ * 64 + d8 + 4) = o1;
        }
        LBAR();
        {
            const int d = tid & 63, sg = tid >> 6; float cum[8]; float run = 0.f;
#pragma unroll
            for (int i = 0; i < 8; ++i) { run += LC[(sg * 8 + i) * 64 + d]; cum[i] = run; }
            SEG[sg * 64 + d] = run;
            LBAR();
            float off = 0.f;
#pragma unroll
            for (int s = 0; s < 7; ++s) off += (s < sg) ? SEG[s * 64 + d] : 0.f;
#pragma unroll
            for (int i = 0; i < 8; ++i) LC[(sg * 8 + i) * 64 + d] = cum[i] + off;
        }
        LBAR();
        {
            const f32x4 L0 = *(const LAS f32x4*)(LC + t_ * 64 + d8), L1 = *(const LAS f32x4*)(LC + t_ * 64 + d8 + 4);
            const f32x4 E0 = *(const LAS f32x4*)(LC + 63 * 64 + d8), E1 = *(const LAS f32x4*)(LC + 63 * 64 + d8 + 4);
            float qf[8], kf[8], qo[8], ko[8], k2[8], q2[8];
            unpack8(cq, qf); unpack8(ck, kf);
#pragma unroll
            for (int j = 0; j < 8; ++j) { const float L = (j < 4) ? L0[j & 3] : L1[j & 3], Le = (j < 4) ? E0[j & 3] : E1[j & 3];
                qo[j] = qf[j] * __expf(L) * 0.125f; ko[j] = kf[j] * __expf(-L); k2[j] = kf[j] * __expf(Le - L); q2[j] = qf[j] * __expf(L + Lseg[j]) * 0.125f; Lseg[j] += Le; }
            *(LAS u32x4*)(QP + t_ * QS + d8 * 2) = pack8(qo); *(LAS u32x4*)(KP + t_ * QS + d8 * 2) = pack8(ko); *(LAS u32x4*)(KPP + t_ * QS + d8 * 2) = pack8(k2);
            *(u32x4*)(Z + (size_t)(row0 + t_) * ZC + ZQ + h * 64 + d8) = pack8(q2);
            if (t_ == 0) {
#pragma unroll
                for (int j = 0; j < 8; ++j) DEC[d8 + j] = __expf((j < 4) ? E0[j & 3] : E1[j & 3]); }
        }
        LBAR();
#pragma unroll
        for (int q = 0; q < 2; ++q) {
            const int idx = 2 * w + q, it = idx >> 2, jt = idx & 3;
            f32x4 A = (f32x4){0.f, 0.f, 0.f, 0.f};
            if (jt <= it) {
#pragma unroll
                for (int ks = 0; ks < 2; ++ks) { const bf16x8 a = *(const LAS bf16x8*)(QP + (it * 16 + c) * QS + (ks * 32 + 8 * g) * 2), bb = *(const LAS bf16x8*)(KP + (jt * 16 + c) * QS + (ks * 32 + 8 * g) * 2);
                    A = __builtin_amdgcn_mfma_f32_16x16x32_bf16(a, bb, A, 0, 0, 0); }
            }
#pragma unroll
            for (int jj = 0; jj < 4; ++jj) { const int i = it * 16 + 4 * g + jj, j = jt * 16 + c; const float v = (j <= i) ? A[jj] : 0.f;
                *(LAS unsigned short*)(AIN + i * QS + j * 2) = f2bf(v); }
        }
        LBAR();
        bf16x8 Vb[2];
#pragma unroll
        for (int ks = 0; ks < 2; ++ks) { unsigned short e[8];
#pragma unroll
            for (int j = 0; j < 8; ++j) e[j] = *(const LAS unsigned short*)(VS + (ks * 32 + 8 * g + j) * VSS + (16 * w + c) * 2);
            u32x4 pw; pw.x = e[0] | ((unsigned)e[1] << 16); pw.y = e[2] | ((unsigned)e[3] << 16); pw.z = e[4] | ((unsigned)e[5] << 16); pw.w = e[6] | ((unsigned)e[7] << 16); Vb[ks] = as_bf16x8(pw); }
        bf16x8 Sb[2];
#pragma unroll
        for (int k2 = 0; k2 < 2; ++k2) { u32x4 pw; pw.x = cvt_pk_bf16(Sacc[2 * k2][0], Sacc[2 * k2][1]); pw.y = cvt_pk_bf16(Sacc[2 * k2][2], Sacc[2 * k2][3]);
            pw.z = cvt_pk_bf16(Sacc[2 * k2 + 1][0], Sacc[2 * k2 + 1][1]); pw.w = cvt_pk_bf16(Sacc[2 * k2 + 1][2], Sacc[2 * k2 + 1][3]); Sb[k2] = as_bf16x8(pw); }
        f32x4 Oacc[4];
#pragma unroll
        for (int it = 0; it < 4; ++it) {
            Oacc[it] = (f32x4){0.f, 0.f, 0.f, 0.f};
#pragma unroll
            for (int ks = 0; ks < 2; ++ks) { const bf16x8 a = *(const LAS bf16x8*)(AIN + (it * 16 + c) * QS + (ks * 32 + 8 * g) * 2); Oacc[it] = __builtin_amdgcn_mfma_f32_16x16x32_bf16(a, Vb[ks], Oacc[it], 0, 0, 0); }
#pragma unroll
            for (int k2 = 0; k2 < 2; ++k2) { const u32x2 lo = *(const LAS u32x2*)(QP + (it * 16 + c) * QS + (32 * k2 + 4 * g) * 2), hi = *(const LAS u32x2*)(QP + (it * 16 + c) * QS + (32 * k2 + 16 + 4 * g) * 2);
                const bf16x8 a = as_bf16x8((u32x4){lo.x, lo.y, hi.x, hi.y}); Oacc[it] = __builtin_amdgcn_mfma_f32_16x16x32_bf16(a, Sb[k2], Oacc[it], 0, 0, 0); }
        }
#pragma unroll
        for (int dt = 0; dt < 4; ++dt) {
            const f32x4 dc = *(const LAS f32x4*)(DEC + dt * 16 + 4 * g);
            Sacc[dt] = Sacc[dt] * dc;
#pragma unroll
            for (int ks = 0; ks < 2; ++ks) { unsigned short e[8];
#pragma unroll
                for (int j = 0; j < 8; ++j) e[j] = *(const LAS unsigned short*)(KPP + (ks * 32 + 8 * g + j) * QS + (dt * 16 + c) * 2);
                u32x4 pw; pw.x = e[0] | ((unsigned)e[1] << 16); pw.y = e[2] | ((unsigned)e[3] << 16); pw.z = e[4] | ((unsigned)e[5] << 16); pw.w = e[6] | ((unsigned)e[7] << 16);
                Sacc[dt] = __builtin_amdgcn_mfma_f32_16x16x32_bf16(as_bf16x8(pw), Vb[ks], Sacc[dt], 0, 0, 0); }
        }
#pragma unroll
        for (int it = 0; it < 4; ++it)
#pragma unroll
            for (int jj = 0; jj < 4; ++jj) *(LAS unsigned short*)(OT + (it * 16 + 4 * g + jj) * VSS + (16 * w + c) * 2) = f2bf(Oacc[it][jj]);
        LBAR();
        {
            const u32x4 o0 = *(const LAS u32x4*)(OT + (tid >> 4) * VSS + (tid & 15) * 16), o1 = *(const LAS u32x4*)(OT + (32 + (tid >> 4)) * VSS + (tid & 15) * 16);
            *(u32x4*)(Z + (size_t)(row0 + (tid >> 4)) * ZC + ZV + h * 128 + (tid & 15) * 8) = o0;
            *(u32x4*)(Z + (size_t)(row0 + 32 + (tid >> 4)) * ZC + ZV + h * 128 + (tid & 15) * 8) = o1;
        }
        if ((n & 3) == 3) {
            const int rs0 = rowb;
#pragma unroll
            for (int dt = 0; dt < 4; ++dt)
#pragma unroll
                for (int jj = 0; jj < 4; ++jj) { const int d = dt * 16 + 4 * g + jj, dv = 16 * w + c; *((float*)(Z + (size_t)(rs0 + d * 4 + (dv >> 5)) * ZC + ZK + h * 64) + (dv & 31)) = Sacc[dt][jj]; }            if (t_ == 0) {
#pragma unroll
                for (int j = 0; j < 8; ++j) DSEG[(size_t)((b * 4 + h) * 8 + seg) * 64 + d8 + j] = __expf(Lseg[j]); }
        }
    }
    __syncthreads();
}


__device__ void gla_C(const Params& P, int l, int item, LAS unsigned char* lds) {
    const int tid = get_tid(), lane = tid & 63, w = __builtin_amdgcn_readfirstlane(tid >> 6), g = lane >> 4, c = lane & 15;
    const int seg = item & 7, bh = item >> 3, b = bh >> 2, h = bh & 3;
    bf16_t* Z = (bf16_t*)(P.ws + WS_Z);
    LAS float* SSQ = (LAS float*)lds;
    LAS unsigned char* OT = lds + 8192;
    const float ng = P.gla_norm_g[(size_t)l * 128 + 16 * w + c];
    const float* DSEG = (const float*)(P.ws + WS_DSEG);
    float Sin[2][8];
#pragma unroll
    for (int ks = 0; ks < 2; ++ks)
#pragma unroll
        for (int e = 0; e < 8; ++e) Sin[ks][e] = 0.f;
    for (int sq = 0; sq < seg; ++sq) {
        const int rs0 = b * 2048 + sq * 256; const size_t it2 = (size_t)bh * 8 + sq;
#pragma unroll
        for (int ks = 0; ks < 2; ++ks)
#pragma unroll
            for (int e = 0; e < 8; ++e) { const int d = ks * 32 + 8 * g + e, dv = 16 * w + c;
                Sin[ks][e] = DSEG[it2 * 64 + d] * Sin[ks][e] + *((const float*)(Z + (size_t)(rs0 + d * 4 + (dv >> 5)) * ZC + ZK + h * 64) + (dv & 31)); }
    }
    bf16x8 Sb[2];
#pragma unroll
    for (int ks = 0; ks < 2; ++ks) Sb[ks] = as_bf16x8(pack8(Sin[ks]));
    const int row0 = b * 2048 + seg * 256;
    unsigned short gtr[16][4], olr[16][4];
#pragma unroll
    for (int rt = 0; rt < 16; ++rt)
#pragma unroll
        for (int jj = 0; jj < 4; ++jj) { const bf16_t* zr = Z + (size_t)(row0 + rt * 16 + 4 * g + jj) * ZC + h * 128 + 16 * w + c; gtr[rt][jj] = zr[ZG]; olr[rt][jj] = zr[ZV]; }
    f32x4 O[16];
#pragma unroll
    for (int rt = 0; rt < 16; ++rt) {
#pragma unroll
        for (int jj = 0; jj < 4; ++jj) O[rt][jj] = bf2f(olr[rt][jj]);
        if (seg > 0) {
#pragma unroll
            for (int ks = 0; ks < 2; ++ks) { const bf16x8 a = as_bf16x8(*(const u32x4*)(Z + (size_t)(row0 + rt * 16 + c) * ZC + ZQ + h * 64 + ks * 32 + 8 * g)); O[rt] = __builtin_amdgcn_mfma_f32_16x16x32_bf16(a, Sb[ks], O[rt], 0, 0, 0); }
        }
    }
    {
#pragma unroll
        for (int rt = 0; rt < 16; ++rt) {
            float sv[4];
#pragma unroll
            for (int jj = 0; jj < 4; ++jj) sv[jj] = O[rt][jj] * O[rt][jj];
#pragma unroll
            for (int m = 1; m <= 8; m <<= 1)
#pragma unroll
                for (int jj = 0; jj < 4; ++jj) sv[jj] += __shfl_xor(sv[jj], m);
            if (c == 0) {
#pragma unroll
                for (int jj = 0; jj < 4; ++jj) SSQ[w * 256 + rt * 16 + 4 * g + jj] = sv[jj]; }
        }
    }
    __syncthreads();
#pragma unroll
    for (int rt = 0; rt < 16; ++rt)
#pragma unroll
        for (int jj = 0; jj < 4; ++jj) { const int t = rt * 16 + 4 * g + jj; float tot = 0.f;
#pragma unroll
            for (int ww = 0; ww < 8; ++ww) tot += SSQ[ww * 256 + t];
            const float rs = rsqrtf(tot * (1.0f / 128.0f) + EPS);
            const float gt = bf2f(gtr[rt][jj]);
            *(LAS unsigned short*)(OT + t * 272 + (16 * w + c) * 2) = f2bf(O[rt][jj] * rs * ng * (gt * __builtin_amdgcn_rcpf(1.0f + __expf(-gt)))); }
    __syncthreads();
#pragma unroll
    for (int i = 0; i < 8; ++i) { const int p = tid + i * NTHR, r = p >> 4, sg = p & 15;
        *(u32x4*)(Z + (size_t)(row0 + r) * ZC + ZG + h * 128 + sg * 8) = *(const LAS u32x4*)(OT + r * 272 + sg * 16); }
    __syncthreads();
}

__device__ __forceinline__ int next_item(unsigned* ctr, LAS unsigned char* lds) {
    __syncthreads();
    if (threadIdx.x == 0) *(LAS unsigned*)(lds + LDS_SLOT) = atomicAdd(ctr, 1u);
    __syncthreads();
    return (int)*(LAS unsigned*)(lds + LDS_SLOT);
}

__device__ void phase_branches(const Params& P, int l, int half, LAS unsigned char* lds) {
    unsigned* ctr = (unsigned*)(P.ws + WS_CTL) + 64 * (l * 2 + half);
    for (int it = blockIdx.x; it < 256; it += gridDim.x) gla_item(P, l, it >> 5, (it >> 3) & 3, it & 7, lds);
    int it = next_item(ctr, lds);
    while (it < 1536 + 128) {
        if (it < 1536) { attn_item(P, half, it, lds, ctr); it = (int)*(LAS unsigned*)(lds + LDS_SLOT); }
        else { sc_item(P, l, it - 1536); it = next_item(ctr, lds); }
    }
}


#define XB_TMO      128
#define XB_XCNT(j)  (256  + 64 * (j))
#define XB_XSUB(j)  (1280 + 64 * (j))
#define XB_XGEN(j)  (2304 + 64 * (j))
#define XB_TOP      3328
#define XB_TOPGEN   3392
#define XCD_BAR_WORDS 3456
#define XB_SPIN_CAP (1u << 20)
__device__ __forceinline__ unsigned xb_ld(unsigned* p)              { return __hip_atomic_load(p, __ATOMIC_RELAXED, __HIP_MEMORY_SCOPE_AGENT); }
__device__ __forceinline__ unsigned xb_add(unsigned* p, unsigned v) { return __hip_atomic_fetch_add(p, v, __ATOMIC_RELAXED, __HIP_MEMORY_SCOPE_AGENT); }
__device__ __forceinline__ unsigned xb_xcc_id() { return (unsigned)__builtin_amdgcn_s_getreg((3 << 11) | 20) & 0xFu; }
#define XB_SPIN(cond, bar) do { unsigned _sp = 0; while (cond) { __builtin_amdgcn_s_sleep(1); \
    if ((++_sp & 255u) == 0u) { if (xb_ld(&(bar)[XB_TMO])) break; if (_sp > XB_SPIN_CAP) { atomicAdd(&(bar)[XB_TMO], 1u); break; } } } } while (0)
struct XcdBarrier { unsigned* bar; unsigned x; volatile LAS unsigned* st; };
__device__ __forceinline__ XcdBarrier xcd_barrier_post(unsigned* bar, volatile LAS unsigned* st) {
    XcdBarrier b; b.bar = bar; b.x = xb_xcc_id(); b.st = st;
    if (threadIdx.x == 0) (void)xb_add(&bar[XB_XCNT(b.x)], 1u);
    return b;
}
__device__ __forceinline__ void xcd_barrier_complete(unsigned* bar, unsigned x, unsigned& nloc, unsigned& nx) {
    const unsigned G = gridDim.x * gridDim.y * gridDim.z;
    unsigned sum, cnt, mine, sp = 0u;
    for (;;) {
        sum = 0u; cnt = 0u; mine = 0u;
#pragma unroll
        for (unsigned j = 0; j < 16; ++j) { const unsigned c = xb_ld(&bar[XB_XCNT(j)]); sum += c; cnt += (c > 0u) ? 1u : 0u; mine = (j == x) ? c : mine; }
        if (sum == G) break;
        __builtin_amdgcn_s_sleep(1);
        if ((++sp & 255u) == 0u) { if (xb_ld(&bar[XB_TMO])) break; if (sp > XB_SPIN_CAP) { atomicAdd(&bar[XB_TMO], 1u); break; } }
    }
    nloc = mine > 0u ? mine : 1u; nx = cnt > 0u ? cnt : 1u;
}
__device__ __forceinline__ void xcd_barrier(const XcdBarrier& b) {
    asm volatile("s_waitcnt vmcnt(0)" ::: "memory");
    __syncthreads();
    if (threadIdx.x == 0) {
        unsigned* bar = b.bar;
        __builtin_amdgcn_s_waitcnt(0);
        unsigned nloc = b.st[0], nx = b.st[1];
        if (nloc == 0u) { xcd_barrier_complete(bar, b.x, nloc, nx); b.st[0] = nloc; b.st[1] = nx; }
        const unsigned old = xb_add(&bar[XB_XSUB(b.x)], 1u);
        const unsigned gen = old / nloc;
        if (old + 1u == (gen + 1u) * nloc) {
            __builtin_amdgcn_fence(__ATOMIC_RELEASE, "agent");
            asm volatile("s_waitcnt vmcnt(0)" ::: "memory");
            const unsigned og = xb_add(&bar[XB_TOP], 1u);
            const unsigned tg = og / nx;
            if (og + 1u == (tg + 1u) * nx) xb_add(&bar[XB_TOPGEN], 1u);
            else XB_SPIN(xb_ld(&bar[XB_TOPGEN]) == tg, bar);
            __builtin_amdgcn_fence(__ATOMIC_ACQUIRE, "agent");
            xb_add(&bar[XB_XGEN(b.x)], 1u);
            asm volatile("s_waitcnt vmcnt(0)" ::: "memory");
        } else {
            XB_SPIN(xb_ld(&bar[XB_XGEN(b.x)]) == gen, bar);
            __builtin_amdgcn_fence(__ATOMIC_ACQUIRE, "agent");
            asm volatile("s_waitcnt vmcnt(0)" ::: "memory");
        }
    }
    __syncthreads();
}

__global__ void __launch_bounds__(NTHR, 2) fwd_kernel(Params P) {
    extern __shared__ __attribute__((aligned(16))) unsigned char smem[];
    LAS unsigned char* lds = (LAS unsigned char*)smem;
    cg::grid_group grid = cg::this_grid();
    if (threadIdx.x < 4) ((LAS unsigned*)(lds + LDS_BYTES - 32))[threadIdx.x] = 0u;
    __syncthreads();
    const XcdBarrier xb = xcd_barrier_post((unsigned*)(P.ws + WS_BAR), (volatile LAS unsigned*)(lds + LDS_BYTES - 32));
    unsigned char* ws = P.ws;
    const int lo = P.ph_lo, hi = P.ph_hi;
    const bool fuse = (gridDim.x == 256);
    for (int ph = lo; ph < hi; ++ph) {
        const int l = ph / 19, q = ph % 19;
        const int half = (q >= 8 && q <= 14) ? 1 : 0;
        const int k = (q == 0) ? 0 : (q <= 14 ? 1 + (q - 1) % 7 : q - 7);
        switch (k) {
        case 0: if (l == 0) { phase_convert(P, l, lds); phase_norm_alow(P, 0, 0, lds); } break;
        case 1: break;
        case 2: { pg8::Gemm g{(const bf16_t*)(ws + WS_H) + (size_t)half * TH * DM, (const bf16_t*)(ws + WS_W1), 1024, 1024, 1024, 0, 0}; pg8::Order S; S.init(TH, 10752, gridDim.x, blockIdx.x, 1);
                  pg8::EpiSplit E{(bf16_t*)(ws + WS_Z), ZC, (bf16_t*)(ws + WS_GT), GC, 30, P.b_gate + (size_t)l * GC}; pg8::gemm_phase(lds, g, S, E); } break;
        case 3: phase_branches(P, l, half, lds); break;
        case 4: for (int it = blockIdx.x; it < 256; it += gridDim.x) gla_C(P, l, it, lds); phase_combine(P); break;
        case 5: { pg8::Gemm g{(const bf16_t*)(ws + WS_Z) + ZG, (const bf16_t*)(ws + WS_WBR), ZC, 512, 512, (size_t)1024, (size_t)1024 * 512};
                  pg8::Order S; S.init(TH, 1024, gridDim.x, blockIdx.x, 3);
                  pg8::EpiMerge E{(const bf16_t*)(ws + WS_GT), (bf16_t*)(ws + WS_MG)}; pg8::gemm_phase(lds, g, S, E); } break;
        case 6: if (fuse) {
                      const int inst = l * 2 + half;
                      pg8::Gemm g{(const bf16_t*)(ws + WS_MG), (const bf16_t*)(ws + WS_WMO), 1024, 1024, 1024, 0, 0}; pg8::Order S; S.init(TH, 1024, gridDim.x, blockIdx.x, 1);
                      pg8::EpiNormRes E{(l == 0 ? P.x : P.out) + (size_t)half * TH * DM, P.out + (size_t)half * TH * DM, (bf16_t*)(ws + WS_H) + (size_t)half * TH * DM,
                                        P.post_mix_g + (size_t)l * DM, P.pre_ffn_g + (size_t)l * DM,
                                        (unsigned*)(ws + WS_XS) + (size_t)(inst * 2) * TH * 4, (unsigned*)(ws + WS_XS) + (size_t)(inst * 2 + 1) * TH * 4,
                                        (unsigned*)(ws + WS_CTL) + 4608 + (inst * 2) * 256, (unsigned*)(ws + WS_CTL) + 4608 + (inst * 2 + 1) * 256};
                      pg8::gemm_phase(lds, g, S, E);
                      if (half == 0) phase_norm_alow(P, l, 1, lds);
                  } else { pg8::Gemm g{(const bf16_t*)(ws + WS_MG), (const bf16_t*)(ws + WS_WMO), 1024, 1024, 1024, 0, 0}; pg8::Order S; S.init(TH, 1024, gridDim.x, blockIdx.x, 1);
                      pg8::EpiSplit E{(bf16_t*)(ws + WS_Y), 1024, (bf16_t*)(ws + WS_Y), 1024, 1 << 20, nullptr}; pg8::gemm_phase(lds, g, S, E); } break;
        case 7: if (!fuse) { phase_resid((l == 0 ? P.x : P.out) + (size_t)half * TH * DM, P.out + (size_t)half * TH * DM, (const bf16_t*)(ws + WS_Y), P.post_mix_g + (size_t)l * DM, P.pre_ffn_g + (size_t)l * DM,
                            (bf16_t*)(ws + WS_H) + (size_t)half * TH * DM, TH);
                if (half == 0) phase_norm_alow(P, l, 1, lds); }
                break;
        case 8: { pg8::Gemm g{(const bf16_t*)(ws + WS_H), (const bf16_t*)(ws + WS_WFF), 1024, 1024, 1024, 0, 0}; pg8::Order S; S.init(T_ALL, 5632, gridDim.x, blockIdx.x, 1);
                  pg8::EpiFFN E{(bf16_t*)(ws + WS_U), (float*)(ws + WS_HG), (float*)(ws + WS_HU), P.ff_conv_w + (size_t)l * 3 * FF, P.ff_conv_b + (size_t)l * FF, lds + pg8::STAGE_BYTES};
                  pg8::gemm_phase(lds, g, S, E); } break;
        case 9: phase_ffn_fix(P, l); break;
        case 10: { pg8::Gemm g{(const bf16_t*)(ws + WS_U), (const bf16_t*)(ws + WS_WD), FF, FF, FF, 0, 0}; pg8::Order S; S.init(T_ALL, 1024, gridDim.x, blockIdx.x, 1);
                   pg8::EpiSplit E{(bf16_t*)(ws + WS_Y2), 1024, (bf16_t*)(ws + WS_Y2), 1024, 1 << 20, nullptr}; pg8::gemm_phase(lds, g, S, E); } break;
        default: phase_resid(P.out, P.out, (const bf16_t*)(ws + WS_Y2), P.post_ffn_g + (size_t)l * DM, nullptr, nullptr, T_ALL);
                 if (l == 0) { phase_convert(P, 1, lds); phase_norm_alow(P, 1, 0, lds); }
                 break;
        }
        const bool empty = (k == 0 && l == 1) || (k == 1) || (k == 7 && fuse);
        if (ph + 1 < hi && !empty) { if (hi < lo) grid.sync(); else xcd_barrier(xb); }
    }
}

constexpr int N_PHASES = 2 * (1 + 2 * 7 + 4);

#ifndef MULTI_LAUNCH
#define MULTI_LAUNCH 0
#endif

extern "C" void kernel_launch(void* const* d_in, const int* in_sizes, int n_in, void* d_out, int out_size, void* d_ws, size_t ws_size, hipStream_t stream) {
    static int grid = 0;
    if (grid == 0) {
        if (n_in != 20 || ws_size < WS_END) { fprintf(stderr, "kernel_launch: unexpected n_in %d / ws_size %zu (need %zu)\n", n_in, ws_size, (size_t)WS_END); grid = -1; return; }
        int dev = 0, cus = 0, per_cu = 0;
        hipGetDevice(&dev); hipDeviceGetAttribute(&cus, hipDeviceAttributeMultiprocessorCount, dev);
        if (hipFuncSetAttribute((const void*)fwd_kernel, hipFuncAttributeMaxDynamicSharedMemorySize, LDS_BYTES) != hipSuccess) { fprintf(stderr, "kernel_launch: hipFuncSetAttribute failed\n"); grid = -1; return; }
        if (hipOccupancyMaxActiveBlocksPerMultiprocessor(&per_cu, (const void*)fwd_kernel, NTHR, LDS_BYTES) != hipSuccess || per_cu < 1) per_cu = 1;
        (void)hipGetLastError();
        grid = cus * per_cu;
        if (grid > 256) grid = 256;
    }
    if (grid < 0) return;
    hipMemsetAsync((char*)d_ws + WS_CTL, 0, 32768, stream);
    Params p{};
    p.x = (const float*)d_in[0]; p.pos = (const int*)d_in[1]; p.w_in = (const float*)d_in[2]; p.w_alpha_up = (const float*)d_in[3]; p.b_alpha = (const float*)d_in[4];
    p.gla_norm_g = (const float*)d_in[5]; p.sc_conv_w = (const float*)d_in[6]; p.w_gate = (const float*)d_in[7]; p.b_gate = (const float*)d_in[8]; p.w_branch = (const float*)d_in[9];
    p.w_mix_out = (const float*)d_in[10]; p.pre_mix_g = (const float*)d_in[11]; p.post_mix_g = (const float*)d_in[12]; p.pre_ffn_g = (const float*)d_in[13]; p.post_ffn_g = (const float*)d_in[14];
    p.w_ff_gate = (const float*)d_in[15]; p.w_ff_up = (const float*)d_in[16]; p.ff_conv_w = (const float*)d_in[17]; p.ff_conv_b = (const float*)d_in[18]; p.w_ff_down = (const float*)d_in[19];
    p.out = (float*)d_out; p.ws = (unsigned char*)d_ws;
#if MULTI_LAUNCH
    for (int ph = 0; ph < N_PHASES; ++ph) { p.ph_lo = ph; p.ph_hi = ph + 1; hipLaunchKernelGGL(fwd_kernel, dim3(grid), dim3(NTHR), LDS_BYTES, stream, p); }
#else
    p.ph_lo = 0; p.ph_hi = N_PHASES;
    void* args[] = {&p};
    hipError_t e = hipLaunchCooperativeKernel((const void*)fwd_kernel, dim3(grid), dim3(NTHR), args, LDS_BYTES, stream);
    if (e != hipSuccess) fprintf(stderr, "cooperative launch failed: %s (grid %d)\n", hipGetErrorString(e), grid);
#endif
}
```

```cpp
#include <hip/hip_runtime.h>
#include <hip/hip_cooperative_groups.h>
#include <cstdint>
#include <cstdio>
namespace cg = cooperative_groups;

#define LAS __attribute__((address_space(3)))
typedef unsigned short bf16_t;
typedef short bf16x8 __attribute__((ext_vector_type(8)));
typedef float f32x4 __attribute__((ext_vector_type(4)));
typedef float f32x2 __attribute__((ext_vector_type(2)));
typedef unsigned u32x4 __attribute__((ext_vector_type(4)));
typedef unsigned u32x2 __attribute__((ext_vector_type(2)));

constexpr int T_ALL = 32768, TH = 16384, DM = 1024, ZC = 7680, GC = 3072, FF = 2816;
constexpr int ZQ = 0, ZK = 256, ZV = 512, ZG = 1024, ZSC = 1536, ZSB = 2048, ZSX = 2560, ZDQ = 3072, ZDK = 4608, ZDV = 6144;
constexpr int IN_COLS = 7696;
constexpr float EPS = 1e-6f;
constexpr int NTHR = 512;
constexpr int LDS_BYTES = 147456;
constexpr int LDS_SLOT = LDS_BYTES - 16;

constexpr size_t WS_CTL = 0;
constexpr size_t WS_BAR = 4096;
constexpr size_t WS_W1 = 32768;
constexpr size_t WS_WBR = WS_W1 + (size_t)10752 * 1024 * 2;
constexpr size_t WS_WMO = WS_WBR + (size_t)3 * 1024 * 512 * 2;
constexpr size_t WS_WFF = WS_WMO + (size_t)1024 * 1024 * 2;
constexpr size_t WS_WD = WS_WFF + (size_t)5632 * 1024 * 2;
constexpr size_t WS_RC = WS_WD + (size_t)1024 * 2816 * 2;
constexpr size_t WS_XS = WS_RC + (size_t)1024 * 1024;
constexpr size_t WS_RS = WS_RC + (size_t)T_ALL * 64 * 4;
constexpr size_t WS_H = WS_RS + (size_t)T_ALL * 64 * 4;
constexpr size_t WS_ALOW = WS_H + (size_t)T_ALL * 1024 * 2;
constexpr size_t WS_LSE = WS_ALOW + (size_t)TH * 16 * 4;
constexpr size_t WS_DSEG = WS_LSE + (size_t)TH * 12 * 4;
constexpr size_t WS_BIG = WS_DSEG + (size_t)256 * 64 * 4;
constexpr size_t WS_Z = WS_BIG;
constexpr size_t WS_GT = WS_Z + (size_t)TH * ZC * 2;
constexpr size_t WS_MG = WS_GT + (size_t)TH * GC * 2;
constexpr size_t WS_END = WS_MG + (size_t)TH * 1024 * 2;
constexpr size_t WS_Y = WS_BIG;
constexpr size_t WS_G = WS_BIG;
constexpr size_t WS_U = WS_BIG + (size_t)T_ALL * FF * 2;
constexpr size_t WS_Y2 = WS_BIG;
constexpr size_t WS_HG = WS_BIG + (size_t)T_ALL * 1024 * 4;
constexpr size_t WS_HU = WS_HG + (size_t)128 * 4 * FF * 4;
static_assert(WS_HU + (size_t)128 * 2 * FF * 4 <= WS_U, "halo fits between Y2 and the activation buffer");
static_assert(WS_U + (size_t)T_ALL * FF * 2 <= WS_END, "ffn overlay");

struct Params {
    const float* x; const int* pos; const float* w_in; const float* w_alpha_up; const float* b_alpha; const float* gla_norm_g; const float* sc_conv_w;
    const float* w_gate; const float* b_gate; const float* w_branch; const float* w_mix_out; const float* pre_mix_g; const float* post_mix_g;
    const float* pre_ffn_g; const float* post_ffn_g; const float* w_ff_gate; const float* w_ff_up; const float* ff_conv_w; const float* ff_conv_b; const float* w_ff_down;
    float* out; unsigned char* ws; int ph_lo, ph_hi;
};

__device__ __forceinline__ int get_tid() { int t = threadIdx.x; asm volatile("" : "+v"(t)); return t; }
__device__ __forceinline__ unsigned cvt_pk_bf16(float lo, float hi) { unsigned r; asm volatile("v_cvt_pk_bf16_f32 %0, %1, %2" : "=v"(r) : "v"(lo), "v"(hi)); return r; }
__device__ __forceinline__ float bflo(unsigned w) { return __uint_as_float(w << 16); }
__device__ __forceinline__ float bfhi(unsigned w) { return __uint_as_float(w & 0xffff0000u); }
__device__ __forceinline__ float bf2f(unsigned short b) { return __uint_as_float(((unsigned)b) << 16); }
__device__ __forceinline__ unsigned short f2bf(float f) { return (unsigned short)(cvt_pk_bf16(f, 0.f) & 0xffffu); }
__device__ __forceinline__ void unpack8(const u32x4 w, float (&f)[8]) { f[0] = bflo(w.x); f[1] = bfhi(w.x); f[2] = bflo(w.y); f[3] = bfhi(w.y); f[4] = bflo(w.z); f[5] = bfhi(w.z); f[6] = bflo(w.w); f[7] = bfhi(w.w); }
__device__ __forceinline__ u32x4 pack8(const float (&f)[8]) { u32x4 w; w.x = cvt_pk_bf16(f[0], f[1]); w.y = cvt_pk_bf16(f[2], f[3]); w.z = cvt_pk_bf16(f[4], f[5]); w.w = cvt_pk_bf16(f[6], f[7]); return w; }
__device__ __forceinline__ bf16x8 as_bf16x8(const u32x4 w) { union { u32x4 u; bf16x8 b; } c; c.u = w; return c.b; }

namespace pg8 {
constexpr int BM = 256, BK = 64, HALF = 128, HTB = HALF * BK * 2, STAGE_BYTES = 8 * HTB, NXCD = 8, WGM = 8;
__device__ __forceinline__ int lds_byte(int r, int c) { const int st = (r >> 4) * 2 + (c >> 5), rr = r & 15, cc = c & 31, ob = rr * 64 + cc * 2; return st * 1024 + (ob ^ (((ob >> 9) & 1) << 5)); }
__device__ __forceinline__ void stage_rc(int b, int& R, int& C) { const int st = b / 1024, sb = b % 1024, swz = sb ^ (((sb >> 9) & 1) << 5); R = (st >> 1) * 16 + swz / 64; C = (st & 1) * 32 + (swz % 64) / 2; }
__device__ __forceinline__ int perm32(int rho) { const int n = rho >> 4, i = rho & 15; return 8 * (i >> 2) + 4 * n + (i & 3); }

struct Unit { int pm, pn, g; };
struct Gemm { const bf16_t* A; const bf16_t* Bt; int lda, ldb, K; size_t gA, gB; };

struct Order {
    int nM, nN, nwg, G, c, ng;
    __device__ void init(int M, int N, int G_, int c_, int ng_) { nM = M / BM; nN = N / BM; nwg = nM * nN; G = G_; c = c_; ng = ng_; }
    __device__ bool next(int i, Unit& u) const {
        const int ti = i / ng; u.g = i - ti * ng;
        const long L = (long)ti * G + c; if (L >= nwg) return false;
        int wgid = (int)L; { const int q = nwg / NXCD, r = nwg % NXCD, xcd = wgid % NXCD, off = wgid / NXCD; wgid = (xcd < r ? xcd * (q + 1) : r * (q + 1) + (xcd - r) * q) + off; }
        const int nig = WGM * nN, gid = wgid / nig, fm = gid * WGM, gsz = (nM - fm) < WGM ? (nM - fm) : WGM;
        u.pm = fm + ((wgid % nig) % gsz); u.pn = (wgid % nig) / gsz; return true;
    }
};

template <class Epi>
__device__ __forceinline__ void gemm_phase(LAS unsigned char* lds, const Gemm g, const Order& S, const Epi& E) {
    const int tid = get_tid(), wid = __builtin_amdgcn_readfirstlane(tid >> 6), lane = tid & 63, wr = wid >> 2, wc = wid & 3, fr = lane & 15, fq = lane >> 4;
    const int K = g.K, nt = K / BK;
    unsigned voffA[2], voffB[2];
#pragma unroll
    for (int i = 0; i < 2; ++i) { int R, C; stage_rc(tid * 16 + i * 8192, R, C); const int Rb = Epi::PERM ? ((R & ~31) + perm32(R & 31)) : R;
        voffA[i] = (unsigned)(R * g.lda + C) * 2u; voffB[i] = (unsigned)(Rb * g.ldb + C) * 2u; }
    const size_t kstep = (size_t)(BK * 2);
    const size_t hstepA = (size_t)HALF * g.lda * 2, hstepB = (size_t)HALF * g.ldb * 2;
    const size_t tstepA = 2 * hstepA, tstepB = 2 * hstepB;
    const unsigned ldsw = (unsigned)wid * 1024u;
    const int aoff = lds_byte(wr * 64 + fr, fq * 8), boff = lds_byte(wc * 32 + fr, fq * 8);
#define PG8_SA(b, h) (((b) * 2 + (h)) * HTB)
#define PG8_SB(b, h) ((4 + (b) * 2 + (h)) * HTB)
#define PG8_STAGE(bufoff, gbase, voff) do { _Pragma("unroll") for (int _i = 0; _i < 2; ++_i) \
        __builtin_amdgcn_global_load_lds((const unsigned*)((const char*)(gbase) + (voff)[_i]), (LAS unsigned*)(lds + (bufoff) + ldsw + _i * 8192), 16, 0, 0); } while (0)
#define PG8_LDA(dst, b, h) do { _Pragma("unroll") for (int m = 0; m < 4; ++m) _Pragma("unroll") for (int k = 0; k < 2; ++k) dst[m][k] = *(const LAS bf16x8*)(lds + PG8_SA(b, h) + aoff + m * 2048 + k * 1024); } while (0)
#define PG8_LDB(dst, b, h) do { _Pragma("unroll") for (int n = 0; n < 2; ++n) _Pragma("unroll") for (int k = 0; k < 2; ++k) dst[n][k] = *(const LAS bf16x8*)(lds + PG8_SB(b, h) + boff + n * 2048 + k * 1024); } while (0)
#define PG8_MMA(ai, bj, At, Bt) do { __builtin_amdgcn_s_setprio(1); _Pragma("unroll") for (int m = 0; m < 4; ++m) _Pragma("unroll") for (int n = 0; n < 2; ++n) _Pragma("unroll") for (int k = 0; k < 2; ++k) \
        acc[ai][bj][m][n] = __builtin_amdgcn_mfma_f32_16x16x32_bf16(Bt[n][k], At[m][k], acc[ai][bj][m][n], 0, 0, 0); __builtin_amdgcn_s_setprio(0); } while (0)
#define PG8_WAIT_V(n) asm volatile("s_waitcnt vmcnt(" #n ")" ::: "memory")
#define PG8_WAIT_L(n) asm volatile("s_waitcnt lgkmcnt(" #n ")" ::: "memory")
#define PG8_BAR __builtin_amdgcn_s_barrier()
#define PG8_SCHED __builtin_amdgcn_sched_barrier(0)
    Unit cur, nxt; int ui = 0;
    if (!S.next(0, cur)) return;
    f32x4 acc[2][2][4][2];
#pragma unroll
    for (int a = 0; a < 2; ++a)
#pragma unroll
        for (int b = 0; b < 2; ++b)
#pragma unroll
            for (int m = 0; m < 4; ++m)
#pragma unroll
                for (int n = 0; n < 2; ++n) acc[a][b][m][n] = (f32x4){0.f, 0.f, 0.f, 0.f};
    bf16x8 At[4][2], B0[2][2], B1[2][2];
    const char* cA = (const char*)(g.A + (size_t)cur.g * g.gA) + (size_t)cur.pm * tstepA; const char* cB = (const char*)(g.Bt + (size_t)cur.g * g.gB) + (size_t)cur.pn * tstepB;
    PG8_STAGE(PG8_SB(0, 0), cB, voffB); PG8_STAGE(PG8_SB(0, 1), cB + hstepB, voffB); PG8_STAGE(PG8_SA(0, 0), cA, voffA); PG8_STAGE(PG8_SA(0, 1), cA + hstepA, voffA);
    if (wr == 1) PG8_BAR;
    PG8_WAIT_V(2); PG8_BAR;
    PG8_STAGE(PG8_SB(1, 0), cB + kstep, voffB); PG8_STAGE(PG8_SA(1, 0), cA + kstep, voffA); PG8_STAGE(PG8_SB(1, 1), cB + hstepB + kstep, voffB);
    PG8_WAIT_V(6); PG8_BAR;
    for (;;) {
        const bool has_next = S.next(ui + 1, nxt);
        const char* nA = has_next ? (const char*)(g.A + (size_t)nxt.g * g.gA) + (size_t)nxt.pm * tstepA : cA; const char* nB = has_next ? (const char*)(g.Bt + (size_t)nxt.g * g.gB) + (size_t)nxt.pn * tstepB : cB;
        for (int t = 0; t < nt; t += 2) {
            const bool last = (t == nt - 2);
            const char* a1 = cA + (size_t)(t + 1) * kstep;
            const char* a2 = last ? nA : cA + (size_t)(t + 2) * kstep; const char* b2 = last ? nB : cB + (size_t)(t + 2) * kstep;
            const char* a3 = a2 + kstep; const char* b3 = b2 + kstep;
            PG8_LDB(B0, 0, 0); PG8_LDB(B1, 0, 1); PG8_SCHED; PG8_LDA(At, 0, 0); PG8_STAGE(PG8_SA(1, 1), a1 + hstepA, voffA);
            PG8_WAIT_V(8); PG8_WAIT_L(0); PG8_BAR; PG8_MMA(0, 0, At, B0); PG8_MMA(0, 1, At, B1); PG8_BAR; PG8_SCHED;
            PG8_LDA(At, 0, 1); PG8_STAGE(PG8_SB(0, 0), b2, voffB); PG8_STAGE(PG8_SB(0, 1), b2 + hstepB, voffB); PG8_STAGE(PG8_SA(0, 0), a2, voffA);
            PG8_WAIT_V(8); PG8_WAIT_L(0); PG8_BAR; PG8_MMA(1, 0, At, B0); PG8_MMA(1, 1, At, B1); PG8_BAR; PG8_SCHED;
            PG8_LDB(B0, 1, 0); PG8_LDB(B1, 1, 1); PG8_SCHED; PG8_LDA(At, 1, 0); PG8_STAGE(PG8_SA(0, 1), a2 + hstepA, voffA);
            PG8_WAIT_V(8); PG8_WAIT_L(0); PG8_BAR; PG8_MMA(0, 0, At, B0); PG8_MMA(0, 1, At, B1); PG8_BAR; PG8_SCHED;
            PG8_LDA(At, 1, 1); PG8_STAGE(PG8_SB(1, 0), b3, voffB); PG8_STAGE(PG8_SB(1, 1), b3 + hstepB, voffB); PG8_STAGE(PG8_SA(1, 0), a3, voffA);
            PG8_WAIT_V(8); PG8_WAIT_L(0); PG8_BAR; PG8_MMA(1, 0, At, B0); PG8_MMA(1, 1, At, B1); PG8_BAR; PG8_SCHED;
        }
        if (wr == 0) PG8_BAR;
        if constexpr (!Epi::AFTER_DRAIN) E(acc, cur, wr, wc, fr, fq);
        if (!has_next) break;
        if constexpr (!Epi::KEEP_ACC) {
#pragma unroll
        for (int a = 0; a < 2; ++a)
#pragma unroll
            for (int b = 0; b < 2; ++b)
#pragma unroll
                for (int m = 0; m < 4; ++m)
#pragma unroll
                    for (int n = 0; n < 2; ++n) acc[a][b][m][n] = (f32x4){0.f, 0.f, 0.f, 0.f};
        }
        cur = nxt; cA = nA; cB = nB; ++ui;
        if (wr == 1) PG8_BAR;
    }
    PG8_WAIT_V(0);
    PG8_BAR;
    if constexpr (Epi::AFTER_DRAIN) E.fused(acc, cur, wr, wc, fr, fq, lds);
#undef PG8_SA
#undef PG8_SB
#undef PG8_STAGE
#undef PG8_LDA
#undef PG8_LDB
#undef PG8_MMA
#undef PG8_WAIT_V
#undef PG8_WAIT_L
#undef PG8_BAR
#undef PG8_SCHED
}

struct EpiF32 {
    static constexpr bool PERM = false, AFTER_DRAIN = false, KEEP_ACC = false;
    float* C; int ldc;
    __device__ __forceinline__ void operator()(const f32x4 (&acc)[2][2][4][2], const Unit& u, int wr, int wc, int fr, int fq) const {
        const int row0 = u.pm * BM + wr * 64 + fr, col0 = u.pn * BM + wc * 32 + 4 * fq;
#pragma unroll
        for (int ai = 0; ai < 2; ++ai)
#pragma unroll
            for (int m = 0; m < 4; ++m) { float* rowp = C + (size_t)(row0 + ai * HALF + m * 16) * ldc + col0;
#pragma unroll
                for (int bj = 0; bj < 2; ++bj)
#pragma unroll
                    for (int n = 0; n < 2; ++n) *(f32x4*)(rowp + bj * HALF + n * 16) = acc[ai][bj][m][n]; }
    }
};
struct EpiSplit {
    static constexpr bool PERM = true, AFTER_DRAIN = false, KEEP_ACC = false;
    bf16_t* O0; int ld0; bf16_t* O1; int ld1; int split; const float* bias1;
    __device__ __forceinline__ void operator()(const f32x4 (&acc)[2][2][4][2], const Unit& u, int wr, int wc, int fr, int fq) const {
        const int row0 = u.pm * BM + wr * 64 + fr;
        const bool second = u.pn >= split;
        bf16_t* base = second ? O1 : O0; const int ld = second ? ld1 : ld0;
        const int col0 = (second ? (u.pn - split) : u.pn) * BM + wc * 32 + 8 * fq;
        const bool sig = second && (bias1 != nullptr);
        f32x4 bv[2][2];
#pragma unroll
        for (int bj = 0; bj < 2; ++bj)
#pragma unroll
            for (int n = 0; n < 2; ++n) bv[bj][n] = sig ? *(const f32x4*)(bias1 + col0 + bj * HALF + 4 * n) : (f32x4){0.f, 0.f, 0.f, 0.f};
#pragma unroll
        for (int ai = 0; ai < 2; ++ai)
#pragma unroll
            for (int m = 0; m < 4; ++m) { bf16_t* rowp = base + (size_t)(row0 + ai * HALF + m * 16) * ld + col0;
#pragma unroll
                for (int bj = 0; bj < 2; ++bj) { f32x4 v0 = acc[ai][bj][m][0] + bv[bj][0], v1 = acc[ai][bj][m][1] + bv[bj][1];
                    if (sig) {
#pragma unroll
                        for (int j = 0; j < 4; ++j) { v0[j] = __builtin_amdgcn_rcpf(1.0f + __expf(-v0[j])); v1[j] = __builtin_amdgcn_rcpf(1.0f + __expf(-v1[j])); } }
                    u32x4 w; w.x = cvt_pk_bf16(v0[0], v0[1]); w.y = cvt_pk_bf16(v0[2], v0[3]); w.z = cvt_pk_bf16(v1[0], v1[1]); w.w = cvt_pk_bf16(v1[2], v1[3]);
                    *(u32x4*)(rowp + bj * HALF) = w; } }
    }
};
struct EpiMerge {
    static constexpr bool PERM = true, AFTER_DRAIN = false, KEEP_ACC = true;
    const bf16_t* GT; bf16_t* MG;
    __device__ __forceinline__ void operator()(f32x4 (&acc)[2][2][4][2], const Unit& u, int wr, int wc, int fr, int fq) const {
        const int row0 = u.pm * BM + wr * 64 + fr, col0 = u.pn * BM + wc * 32 + 8 * fq;
        const bool last = (u.g == 2);
#pragma unroll
        for (int ai = 0; ai < 2; ++ai) {
            u32x4 gw[4][2], gn[4][2];
#pragma unroll
            for (int m = 0; m < 4; ++m)
#pragma unroll
                for (int bj = 0; bj < 2; ++bj) { const size_t row = (size_t)(row0 + ai * HALF + m * 16); const int col = col0 + bj * HALF;
                    gw[m][bj] = *(const u32x4*)(GT + row * GC + u.g * 1024 + col);
                    gn[m][bj] = last ? (u32x4){0x3f803f80u, 0x3f803f80u, 0x3f803f80u, 0x3f803f80u} : *(const u32x4*)(GT + row * GC + (u.g + 1) * 1024 + col); }
#pragma unroll
            for (int m = 0; m < 4; ++m)
#pragma unroll
                for (int bj = 0; bj < 2; ++bj) { const size_t row = (size_t)(row0 + ai * HALF + m * 16); const int col = col0 + bj * HALF;
                    float gf[8], nf[8], v[8]; unpack8(gw[m][bj], gf); unpack8(gn[m][bj], nf);
#pragma unroll
                    for (int j = 0; j < 4; ++j) { v[j] = gf[j] * acc[ai][bj][m][0][j]; v[4 + j] = gf[4 + j] * acc[ai][bj][m][1][j]; }
                    if (last) { *(u32x4*)(MG + row * 1024 + col) = pack8(v); acc[ai][bj][m][0] = (f32x4){0.f, 0.f, 0.f, 0.f}; acc[ai][bj][m][1] = (f32x4){0.f, 0.f, 0.f, 0.f}; }
                    else {
#pragma unroll
                        for (int j = 0; j < 4; ++j) { acc[ai][bj][m][0][j] = v[j] * __builtin_amdgcn_rcpf(fmaxf(nf[j], 1e-30f)); acc[ai][bj][m][1][j] = v[4 + j] * __builtin_amdgcn_rcpf(fmaxf(nf[4 + j], 1e-30f)); } }
                }
        }
    }
};

__device__ __forceinline__ float dpp_row_shr1(float x) { return __int_as_float(__builtin_amdgcn_update_dpp(0, __float_as_int(x), 0x111, 0xf, 0xf, false)); }
__device__ __forceinline__ float dpp_row_shr2(float x) { return __int_as_float(__builtin_amdgcn_update_dpp(0, __float_as_int(x), 0x112, 0xf, 0xf, false)); }
__device__ __forceinline__ float dpp_row_ror1(float x) { return __int_as_float(__builtin_amdgcn_update_dpp(0, __float_as_int(x), 0x121, 0xf, 0xf, false)); }
__device__ __forceinline__ float dpp_row_ror2(float x) { return __int_as_float(__builtin_amdgcn_update_dpp(0, __float_as_int(x), 0x122, 0xf, 0xf, false)); }
__device__ __forceinline__ f32x2 gelu_tanh_mul2(f32x2 gt, f32x2 up) {
    const f32x2 g2 = gt * gt;
    const f32x2 t = gt * (g2 * 0.044715f + 1.0f);
    const f32x2 sx = t * (-2.0f * 0.7978845608028654f * 1.4426950408889634f);
    f32x2 e; e.x = __builtin_amdgcn_exp2f(sx.x); e.y = __builtin_amdgcn_exp2f(sx.y);
    const f32x2 d = e + 1.0f;
    f32x2 r; r.x = __builtin_amdgcn_rcpf(d.x); r.y = __builtin_amdgcn_rcpf(d.y);
    return gt * r * up;
}
__device__ __forceinline__ float gelu_tanh_mul(float gt, float up) {
    const float uu = 0.7978845608028654f * (gt + 0.044715f * gt * gt * gt);
    return gt * __builtin_amdgcn_rcpf(1.0f + __expf(-2.0f * uu)) * up;
}
struct EpiFFN {
    static constexpr bool PERM = true, AFTER_DRAIN = false, KEEP_ACC = false;
    bf16_t* ACT; float* HG; float* HU; const float* cw; const float* cb; LAS unsigned char* xlds;
    __device__ __forceinline__ void operator()(const f32x4 (&acc)[2][2][4][2], const Unit& u, int wr, int wc, int fr, int fq) const {
        const int chl = wc * 32 + 8 * fq, chg = u.pn * 128 + chl;
        LAS float* XG = (LAS float*)xlds;
        if (fr >= 14) {
#pragma unroll
            for (int ai = 0; ai < 2; ++ai) { LAS float* p = XG + ((2 * ai + wr) * 2 + (fr - 14)) * 128 + chl; *(LAS f32x4*)p = acc[ai][0][3][0]; *(LAS f32x4*)(p + 4) = acc[ai][0][3][1]; }
            if (wr == 1) { float* hp = HG + ((size_t)u.pm * 4 + 2 + (fr - 14)) * FF + chg; *(f32x4*)hp = acc[1][0][3][0]; *(f32x4*)(hp + 4) = acc[1][0][3][1]; }
        }
        if (fr < 2 && wr == 0) {
            float* hp = HG + ((size_t)u.pm * 4 + fr) * FF + chg; *(f32x4*)hp = acc[0][0][0][0]; *(f32x4*)(hp + 4) = acc[0][0][0][1];
            float* up = HU + ((size_t)u.pm * 2 + fr) * FF + chg; *(f32x4*)up = acc[0][1][0][0]; *(f32x4*)(up + 4) = acc[0][1][0][1];
        }
        asm volatile("s_waitcnt lgkmcnt(0)" ::: "memory"); __builtin_amdgcn_s_barrier(); asm volatile("" ::: "memory");
        float w0[8], w1[8], w2[8], bb[8];
        { const f32x4 a0 = *(const f32x4*)(cw + chg), a1 = *(const f32x4*)(cw + chg + 4), b0 = *(const f32x4*)(cw + FF + chg), b1 = *(const f32x4*)(cw + FF + chg + 4),
                      c0 = *(const f32x4*)(cw + 2 * FF + chg), c1 = *(const f32x4*)(cw + 2 * FF + chg + 4), d0 = *(const f32x4*)(cb + chg), d1 = *(const f32x4*)(cb + chg + 4);
#pragma unroll
          for (int j = 0; j < 4; ++j) { w0[j] = a0[j]; w0[4 + j] = a1[j]; w1[j] = b0[j]; w1[4 + j] = b1[j]; w2[j] = c0[j]; w2[4 + j] = c1[j]; bb[j] = d0[j]; bb[4 + j] = d1[j]; } }
#pragma unroll
        for (int ai = 0; ai < 2; ++ai)
#pragma unroll
            for (int m = 0; m < 4; ++m) {
                const int B = 2 * ai + wr;
                float g8[8], u8[8], q15[8], q14[8], o[8];
#pragma unroll
                for (int j = 0; j < 4; ++j) { g8[j] = acc[ai][0][m][0][j]; g8[4 + j] = acc[ai][0][m][1][j]; u8[j] = acc[ai][1][m][0][j]; u8[4 + j] = acc[ai][1][m][1][j]; }
                if (m == 0) {
                    if (B > 0) { const LAS float* p = XG + ((B - 1) * 2) * 128 + chl; const f32x4 r0a = *(const LAS f32x4*)p, r0b = *(const LAS f32x4*)(p + 4), r1a = *(const LAS f32x4*)(p + 128), r1b = *(const LAS f32x4*)(p + 132);
#pragma unroll
                        for (int j = 0; j < 4; ++j) { q14[j] = r0a[j]; q14[4 + j] = r0b[j]; q15[j] = r1a[j]; q15[4 + j] = r1b[j]; } }
                    else {
#pragma unroll
                        for (int j = 0; j < 8; ++j) { q14[j] = 0.f; q15[j] = 0.f; } }
                    float p1a[8], p2a[8];
#pragma unroll
                    for (int e = 0; e < 8; ++e) { const float s1 = dpp_row_shr1(g8[e]), s2 = dpp_row_shr2(g8[e]);
                        p1a[e] = (fr >= 1) ? s1 : q15[e]; p2a[e] = (fr >= 2) ? s2 : ((fr == 1) ? q15[e] : q14[e]); }
#pragma unroll
                    for (int e = 0; e < 8; e += 2) { const f32x2 gt = (f32x2){w0[e], w0[e + 1]} * (f32x2){p2a[e], p2a[e + 1]} + (f32x2){w1[e], w1[e + 1]} * (f32x2){p1a[e], p1a[e + 1]} + (f32x2){w2[e], w2[e + 1]} * (f32x2){g8[e], g8[e + 1]} + (f32x2){bb[e], bb[e + 1]};
                        const f32x2 r = gelu_tanh_mul2(gt, (f32x2){u8[e], u8[e + 1]}); o[e] = r.x; o[e + 1] = r.y; }
                } else {
                    float p1a[8], p2a[8];
#pragma unroll
                    for (int e = 0; e < 8; ++e) { const float pv = (e < 4) ? acc[ai][0][m - 1][0][e & 3] : acc[ai][0][m - 1][1][e & 3];
                        const float s1 = dpp_row_shr1(g8[e]), s2 = dpp_row_shr2(g8[e]), r1 = dpp_row_ror1(pv), r2 = dpp_row_ror2(pv);
                        p1a[e] = (fr >= 1) ? s1 : r1; p2a[e] = (fr >= 2) ? s2 : r2; }
#pragma unroll
                    for (int e = 0; e < 8; e += 2) { const f32x2 gt = (f32x2){w0[e], w0[e + 1]} * (f32x2){p2a[e], p2a[e + 1]} + (f32x2){w1[e], w1[e + 1]} * (f32x2){p1a[e], p1a[e + 1]} + (f32x2){w2[e], w2[e + 1]} * (f32x2){g8[e], g8[e + 1]} + (f32x2){bb[e], bb[e + 1]};
                        const f32x2 r = gelu_tanh_mul2(gt, (f32x2){u8[e], u8[e + 1]}); o[e] = r.x; o[e + 1] = r.y; }
                }
                const int rloc = 128 * ai + 64 * wr + 16 * m + fr;
                if (!(B == 0 && m == 0 && fr < 2)) *(u32x4*)(ACT + (size_t)(u.pm * BM + rloc) * FF + chg) = pack8(o);
            }
    }
};

struct EpiNormRes {
    static constexpr bool PERM = false, AFTER_DRAIN = true, KEEP_ACC = false;
    const float* xin; float* xout; bf16_t* H2; const float* g1; const float* g2; unsigned* xs1; unsigned* xs2; unsigned* cnt1; unsigned* cnt2;
    __device__ __forceinline__ void exchange(const f32x4 (&v)[2][2][4][2], const Unit& u, int wr, int wc, int fr, int fq, LAS unsigned char* lds, unsigned* xs, unsigned* cnt) const {
        LAS float* Pp = (LAS float*)lds;
        LAS float* S = (LAS float*)(lds + 4096);
        const int tid = get_tid();
#pragma unroll
        for (int ai = 0; ai < 2; ++ai)
#pragma unroll
            for (int m = 0; m < 4; ++m) { float sq = 0.f;
#pragma unroll
                for (int bj = 0; bj < 2; ++bj)
#pragma unroll
                    for (int n = 0; n < 2; ++n) { const f32x4 x = v[ai][bj][m][n]; sq += (x[0] * x[0] + x[1] * x[1]) + (x[2] * x[2] + x[3] * x[3]); }
                sq += __shfl_xor(sq, 16); sq += __shfl_xor(sq, 32);
                if (fq == 0) Pp[(ai * HALF + wr * 64 + m * 16 + fr) * 4 + wc] = sq; }
        asm volatile("s_waitcnt lgkmcnt(0)" ::: "memory"); __builtin_amdgcn_s_barrier(); asm volatile("" ::: "memory");
        if (tid < 256) { const f32x4 p = *(const LAS f32x4*)(Pp + tid * 4);
            __hip_atomic_store(xs + ((size_t)(u.pm * BM + tid)) * 4 + u.pn, __float_as_uint((p[0] + p[1]) + (p[2] + p[3])), __ATOMIC_RELAXED, __HIP_MEMORY_SCOPE_AGENT); }
        asm volatile("s_waitcnt vmcnt(0)" ::: "memory");
        __syncthreads();
        if (tid == 0) {
            __hip_atomic_fetch_add(cnt + u.pm * 4, 1u, __ATOMIC_RELAXED, __HIP_MEMORY_SCOPE_AGENT);
            unsigned sp = 0u;
            while (__hip_atomic_load(cnt + u.pm * 4, __ATOMIC_RELAXED, __HIP_MEMORY_SCOPE_AGENT) < 4u) { __builtin_amdgcn_s_sleep(1); if (++sp > (1u << 22)) break; }
            __builtin_amdgcn_fence(__ATOMIC_ACQUIRE, "agent");
            asm volatile("s_waitcnt vmcnt(0)" ::: "memory");
        }
        __syncthreads();
        if (tid < 256) { const unsigned* q = xs + ((size_t)(u.pm * BM + tid)) * 4; float t = 0.f;
#pragma unroll
            for (int k = 0; k < 4; ++k) t += __uint_as_float(__hip_atomic_load(q + k, __ATOMIC_RELAXED, __HIP_MEMORY_SCOPE_AGENT));
            S[tid] = rsqrtf(t * (1.0f / 1024.0f) + EPS); }
        asm volatile("s_waitcnt lgkmcnt(0)" ::: "memory"); __syncthreads();
    }
    __device__ __forceinline__ void fused(f32x4 (&acc)[2][2][4][2], const Unit& u, int wr, int wc, int fr, int fq, LAS unsigned char* lds) const {
        const LAS float* S = (const LAS float*)(lds + 4096);
        const int col0 = u.pn * BM + wc * 32 + 4 * fq;
        exchange(acc, u, wr, wc, fr, fq, lds, xs1, cnt1);
        {
            f32x4 gv[2][2];
#pragma unroll
            for (int bj = 0; bj < 2; ++bj)
#pragma unroll
                for (int n = 0; n < 2; ++n) gv[bj][n] = *(const f32x4*)(g1 + col0 + bj * HALF + n * 16);
#pragma unroll
            for (int ai = 0; ai < 2; ++ai) {
                f32x4 xv[4][2][2];
#pragma unroll
                for (int m = 0; m < 4; ++m)
#pragma unroll
                    for (int bj = 0; bj < 2; ++bj)
#pragma unroll
                        for (int n = 0; n < 2; ++n) xv[m][bj][n] = *(const f32x4*)(xin + (size_t)(u.pm * BM + ai * HALF + wr * 64 + m * 16 + fr) * DM + col0 + bj * HALF + n * 16);
#pragma unroll
                for (int m = 0; m < 4; ++m) { const int r = ai * HALF + wr * 64 + m * 16 + fr; const float r1 = S[r];
#pragma unroll
                    for (int bj = 0; bj < 2; ++bj)
#pragma unroll
                        for (int n = 0; n < 2; ++n) { acc[ai][bj][m][n] = xv[m][bj][n] + acc[ai][bj][m][n] * r1 * gv[bj][n];
                            *(f32x4*)(xout + (size_t)(u.pm * BM + r) * DM + col0 + bj * HALF + n * 16) = acc[ai][bj][m][n]; } }
            }
        }
        asm volatile("s_waitcnt lgkmcnt(0)" ::: "memory"); __syncthreads();
        exchange(acc, u, wr, wc, fr, fq, lds, xs2, cnt2);
        {
            f32x4 gv[2][2];
#pragma unroll
            for (int bj = 0; bj < 2; ++bj)
#pragma unroll
                for (int n = 0; n < 2; ++n) gv[bj][n] = *(const f32x4*)(g2 + col0 + bj * HALF + n * 16);
#pragma unroll
            for (int ai = 0; ai < 2; ++ai)
#pragma unroll
                for (int m = 0; m < 4; ++m) { const int r = ai * HALF + wr * 64 + m * 16 + fr; const float r2 = S[r];
#pragma unroll
                    for (int bj = 0; bj < 2; ++bj)
#pragma unroll
                        for (int n = 0; n < 2; ++n) { const f32x4 h = acc[ai][bj][m][n] * r2 * gv[bj][n]; u32x2 w; w.x = cvt_pk_bf16(h[0], h[1]); w.y = cvt_pk_bf16(h[2], h[3]);
                            *(u32x2*)(H2 + (size_t)(u.pm * BM + r) * DM + col0 + bj * HALF + n * 16) = w; } }
        }
        asm volatile("s_waitcnt lgkmcnt(0)" ::: "memory"); __syncthreads();
    }
    __device__ __forceinline__ void operator()(const f32x4 (&)[2][2][4][2], const Unit&, int, int, int, int) const {}
};
}

__device__ __forceinline__ void transpose_tile(const float* src, int ld, int k0, int n0s, bf16_t* dst, int dk, int n0d, LAS float* tile) {
    const int tid = get_tid();
    { const int r = tid >> 4, c4 = (tid & 15) * 4;
#pragma unroll
      for (int i = 0; i < 2; ++i) { const f32x4 v = *(const f32x4*)(src + (size_t)(k0 + r + 32 * i) * ld + n0s + c4);
          LAS float* t = tile + (r + 32 * i) * 65 + c4; t[0] = v[0]; t[1] = v[1]; t[2] = v[2]; t[3] = v[3]; } }
    __syncthreads();
    { const int n = tid >> 3, ks = (tid & 7) * 8; float e[8];
#pragma unroll
      for (int j = 0; j < 8; ++j) e[j] = tile[(ks + j) * 65 + n];
      *(u32x4*)(dst + (size_t)(n0d + n) * dk + k0 + ks) = pack8(e); }
    __syncthreads();
}

__device__ void phase_convert(const Params& P, int l, LAS unsigned char* lds) {
    LAS float* tile = (LAS float*)lds;
    unsigned char* ws = P.ws;
    bf16_t* W1 = (bf16_t*)(ws + WS_W1); bf16_t* WBR = (bf16_t*)(ws + WS_WBR); bf16_t* WMO = (bf16_t*)(ws + WS_WMO); bf16_t* WFF = (bf16_t*)(ws + WS_WFF); bf16_t* WD = (bf16_t*)(ws + WS_WD);
    const float* win = P.w_in + (size_t)l * 1024 * IN_COLS;
#define SEG(src, ld, ktiles, ntiles, n0s, dst, dk, n0d) if (r < (ktiles) * (ntiles)) { const int kt = r / (ntiles), ntl = r % (ntiles); transpose_tile(src, ld, kt * 64, (n0s) + ntl * 64, dst, dk, (n0d) + ntl * 64, tile); continue; } r -= (ktiles) * (ntiles);
    constexpr int total = 16 * 120 + 16 * 48 + 3 * 8 * 16 + 16 * 16 + 16 * 44 + 16 * 44 + 44 * 16;
    for (int it = blockIdx.x; it < total; it += gridDim.x) {
        int r = it;
        SEG(win, IN_COLS, 16, 8, 0, W1, 1024, ZQ)
        SEG(win, IN_COLS, 16, 8, 512, W1, 1024, ZV)
        SEG(win, IN_COLS, 16, 8, 1024, W1, 1024, ZG)
        SEG(win, IN_COLS, 16, 8, 1552, W1, 1024, ZSB)
        SEG(win, IN_COLS, 16, 8, 2064, W1, 1024, ZSC)
        SEG(win, IN_COLS, 16, 8, 2576, W1, 1024, ZSX)
        SEG(win, IN_COLS, 16, 72, 3088, W1, 1024, ZDQ)
        SEG(P.w_gate + (size_t)l * 1024 * 3072, 3072, 16, 48, 0, W1, 1024, 7680)
        SEG(P.w_branch + ((size_t)l * 3 + 0) * 512 * 1024, 1024, 8, 16, 0, WBR, 512, 0)
        SEG(P.w_branch + ((size_t)l * 3 + 1) * 512 * 1024, 1024, 8, 16, 0, WBR + (size_t)1024 * 512, 512, 0)
        SEG(P.w_branch + ((size_t)l * 3 + 2) * 512 * 1024, 1024, 8, 16, 0, WBR + (size_t)2 * 1024 * 512, 512, 0)
        SEG(P.w_mix_out + (size_t)l * 1024 * 1024, 1024, 16, 16, 0, WMO, 1024, 0)
        if (r < 16 * 44) { const int kt = r / 44, ntl = r % 44; transpose_tile(P.w_ff_gate + (size_t)l * 1024 * FF, FF, kt * 64, ntl * 64, WFF, 1024, 256 * (ntl >> 1) + 64 * (ntl & 1), tile); continue; } r -= 16 * 44;
        if (r < 16 * 44) { const int kt = r / 44, ntl = r % 44; transpose_tile(P.w_ff_up + (size_t)l * 1024 * FF, FF, kt * 64, ntl * 64, WFF, 1024, 256 * (ntl >> 1) + 128 + 64 * (ntl & 1), tile); continue; } r -= 16 * 44;
        SEG(P.w_ff_down + (size_t)l * FF * 1024, 1024, 44, 16, 0, WD, FF, 0)
    }
#undef SEG
    { const int t = get_tid();
      if (l == 0 && blockIdx.x == 0 && t < 64) ((float*)(ws + WS_RC))[t] = exp2f(-(float)t * (13.287712379549449f / 64.0f)) * 0.15915494309189535f; }
}

__device__ __forceinline__ float wave_sum(float v) {
#pragma unroll
    for (int o = 32; o >= 1; o >>= 1) v += __shfl_xor(v, o);
    return v;
}

__device__ void phase_norm_alow(const Params& P, int l, int half, LAS unsigned char* lds) {
    const int tid = get_tid(), lane = tid & 63, wave = tid >> 6;
    LAS float* WaT = (LAS float*)lds;
    const float* win = P.w_in + (size_t)l * 1024 * IN_COLS + 1536;
    for (int i = tid; i < 1024 * 4; i += NTHR) { const int k = i >> 2, c4 = (i & 3) * 4; const f32x4 v = *(const f32x4*)(win + (size_t)k * IN_COLS + c4);
        WaT[(c4 + 0) * 1024 + k] = v[0]; WaT[(c4 + 1) * 1024 + k] = v[1]; WaT[(c4 + 2) * 1024 + k] = v[2]; WaT[(c4 + 3) * 1024 + k] = v[3]; }
    __syncthreads();
    const float* xs = (l == 0 ? P.x : P.out) + (size_t)half * TH * DM;
    const float* gg = P.pre_mix_g + (size_t)l * DM;
    bf16_t* H = (bf16_t*)(P.ws + WS_H) + (size_t)half * TH * DM; float* AL = (float*)(P.ws + WS_ALOW);
    f32x4 gv[4];
#pragma unroll
    for (int i = 0; i < 4; ++i) gv[i] = *(const f32x4*)(gg + i * 256 + lane * 4);
    const int rstride = gridDim.x * 8;
    int row = blockIdx.x * 8 + wave;
    f32x4 nv[4];
    if (row < TH) {
#pragma unroll
        for (int i = 0; i < 4; ++i) nv[i] = *(const f32x4*)(xs + (size_t)row * DM + i * 256 + lane * 4);
    }
    for (; row < TH; row += rstride) {
        f32x4 v[4]; float ss = 0.f;
#pragma unroll
        for (int i = 0; i < 4; ++i) { v[i] = nv[i]; ss += v[i][0] * v[i][0] + v[i][1] * v[i][1] + v[i][2] * v[i][2] + v[i][3] * v[i][3]; }
        if (row + rstride < TH) {
#pragma unroll
            for (int i = 0; i < 4; ++i) nv[i] = *(const f32x4*)(xs + (size_t)(row + rstride) * DM + i * 256 + lane * 4);
        }
        ss = wave_sum(ss);
        const float r = rsqrtf(ss * (1.0f / DM) + EPS);
        float a[16];
#pragma unroll
        for (int c = 0; c < 16; ++c) a[c] = 0.f;
#pragma unroll
        for (int i = 0; i < 4; ++i) { f32x4 h = v[i] * r * gv[i];
            u32x2 w; w.x = cvt_pk_bf16(h[0], h[1]); w.y = cvt_pk_bf16(h[2], h[3]);
            *(u32x2*)(H + (size_t)row * DM + i * 256 + lane * 4) = w;
#pragma unroll
            for (int c = 0; c < 16; ++c) { const f32x4 wv = *(const LAS f32x4*)(WaT + c * 1024 + i * 256 + lane * 4); a[c] += h[0] * wv[0] + h[1] * wv[1] + h[2] * wv[2] + h[3] * wv[3]; } }
        float b8[8], b4[4], b2[2], b1;
        { const bool up = (lane & 32) != 0;
#pragma unroll
          for (int c = 0; c < 8; ++c) { const float keep = up ? a[c + 8] : a[c], send = up ? a[c] : a[c + 8]; b8[c] = keep + __shfl_xor(send, 32); } }
        { const bool up = (lane & 16) != 0;
#pragma unroll
          for (int c = 0; c < 4; ++c) { const float keep = up ? b8[c + 4] : b8[c], send = up ? b8[c] : b8[c + 4]; b4[c] = keep + __shfl_xor(send, 16); } }
        { const bool up = (lane & 8) != 0;
#pragma unroll
          for (int c = 0; c < 2; ++c) { const float keep = up ? b4[c + 2] : b4[c], send = up ? b4[c] : b4[c + 2]; b2[c] = keep + __shfl_xor(send, 8); } }
        { const bool up = (lane & 4) != 0; const float keep = up ? b2[1] : b2[0], send = up ? b2[0] : b2[1]; b1 = keep + __shfl_xor(send, 4); }
        b1 += __shfl_xor(b1, 2); b1 += __shfl_xor(b1, 1);
        if ((lane & 3) == 0) { const int co = ((lane >> 5) & 1) * 8 + ((lane >> 4) & 1) * 4 + ((lane >> 3) & 1) * 2 + ((lane >> 2) & 1); AL[(size_t)row * 16 + co] = b1; }
    }
}

__device__ void phase_resid(const float* xin, float* xout, const bf16_t* Y, const float* pg, const float* ng, bf16_t* H2, int nrows) {
    const int tid = get_tid(), lane = tid & 63, wave = tid >> 6;
    f32x4 pgv[4], ngv[4];
#pragma unroll
    for (int i = 0; i < 4; ++i) { pgv[i] = *(const f32x4*)(pg + i * 256 + lane * 4); ngv[i] = ng ? *(const f32x4*)(ng + i * 256 + lane * 4) : (f32x4){0.f, 0.f, 0.f, 0.f}; }
    const int stride = gridDim.x * 8;
    int row = blockIdx.x * 8 + wave;
    u32x2 ny[4]; f32x4 nx[4];
    if (row < nrows) {
#pragma unroll
        for (int i = 0; i < 4; ++i) { ny[i] = *(const u32x2*)(Y + (size_t)row * DM + i * 256 + lane * 4); nx[i] = *(const f32x4*)(xin + (size_t)row * DM + i * 256 + lane * 4); }
    }
    for (; row < nrows; row += stride) {
        f32x4 y[4], xv[4];
#pragma unroll
        for (int i = 0; i < 4; ++i) { y[i] = (f32x4){bflo(ny[i].x), bfhi(ny[i].x), bflo(ny[i].y), bfhi(ny[i].y)}; xv[i] = nx[i]; }
        const int rn = row + stride;
        if (rn < nrows) {
#pragma unroll
            for (int i = 0; i < 4; ++i) { ny[i] = *(const u32x2*)(Y + (size_t)rn * DM + i * 256 + lane * 4); nx[i] = *(const f32x4*)(xin + (size_t)rn * DM + i * 256 + lane * 4); }
        }
        float ss = 0.f;
#pragma unroll
        for (int i = 0; i < 4; ++i) ss += y[i][0] * y[i][0] + y[i][1] * y[i][1] + y[i][2] * y[i][2] + y[i][3] * y[i][3];
        ss = wave_sum(ss);
        const float r = rsqrtf(ss * (1.0f / DM) + EPS);
        float s2 = 0.f;
#pragma unroll
        for (int i = 0; i < 4; ++i) { xv[i] = xv[i] + y[i] * r * pgv[i]; *(f32x4*)(xout + (size_t)row * DM + i * 256 + lane * 4) = xv[i];
            s2 += xv[i][0] * xv[i][0] + xv[i][1] * xv[i][1] + xv[i][2] * xv[i][2] + xv[i][3] * xv[i][3]; }
        if (ng) {
            s2 = wave_sum(s2);
            const float r2 = rsqrtf(s2 * (1.0f / DM) + EPS);
#pragma unroll
            for (int i = 0; i < 4; ++i) { const f32x4 h = xv[i] * r2 * ngv[i]; u32x2 w; w.x = cvt_pk_bf16(h[0], h[1]); w.y = cvt_pk_bf16(h[2], h[3]);
                *(u32x2*)(H2 + (size_t)row * DM + i * 256 + lane * 4) = w; }
        }
    }
}

__device__ void phase_combine(const Params& P) {
    bf16_t* Z = (bf16_t*)(P.ws + WS_Z); const float* LSE = (const float*)(P.ws + WS_LSE);
    const int stride = gridDim.x * NTHR;
    for (int idx0 = blockIdx.x * NTHR + get_tid(); idx0 < TH * 64; idx0 += 2 * stride) {
        float lw[2][3]; u32x4 va[2], vb[2], vc[2]; bf16_t* pp[2]; bool ok[2];
#pragma unroll
        for (int k = 0; k < 2; ++k) { const int idx = idx0 + k * stride; ok[k] = idx < TH * 64; const int id2 = ok[k] ? idx : idx0;
            const int tok = id2 >> 6, c8 = id2 & 63, hh = c8 >> 4, d0 = (c8 & 15) * 8;
            lw[k][0] = LSE[tok * 12 + hh]; lw[k][1] = LSE[tok * 12 + 4 + hh]; lw[k][2] = LSE[tok * 12 + 8 + hh];
            pp[k] = Z + (size_t)tok * ZC + ZDQ + hh * 128 + d0;
            va[k] = *(const u32x4*)pp[k]; vb[k] = *(const u32x4*)(pp[k] + 512); vc[k] = *(const u32x4*)(pp[k] + 1024); }
#pragma unroll
        for (int k = 0; k < 2; ++k) {
            const float mx = fmaxf(lw[k][0], fmaxf(lw[k][1], lw[k][2]));
            float w0 = __expf(lw[k][0] - mx), w1 = __expf(lw[k][1] - mx), w2 = __expf(lw[k][2] - mx);
            const float inv = 1.0f / (w0 + w1 + w2); w0 *= inv; w1 *= inv; w2 *= inv;
            float a[8], b[8], c[8], o[8];
            unpack8(va[k], a); unpack8(vb[k], b); unpack8(vc[k], c);
#pragma unroll
            for (int j = 0; j < 8; ++j) o[j] = w0 * a[j] + w1 * b[j] + w2 * c[j];
            if (ok[k]) *(u32x4*)pp[k] = pack8(o);
        }
    }
}

__device__ void phase_ffn_fix(const Params& P, int l) {
    bf16_t* ACT = (bf16_t*)(P.ws + WS_U); const float* HG = (const float*)(P.ws + WS_HG); const float* HU = (const float*)(P.ws + WS_HU);
    const float* cw = P.ff_conv_w + (size_t)l * 3 * FF; const float* cb = P.ff_conv_b + (size_t)l * FF;
    for (int idx = blockIdx.x * NTHR + get_tid(); idx < 128 * (FF / 8); idx += gridDim.x * NTHR) {
        const int pm = idx / (FF / 8), c0 = (idx % (FF / 8)) * 8;
        float o0[8], o1[8];
#pragma unroll
        for (int hf = 0; hf < 2; ++hf) {
            const int c = c0 + 4 * hf;
            const f32x4 z = (f32x4){0.f, 0.f, 0.f, 0.f};
            const bool first = (pm & 7) == 0;
            const f32x4 gm2 = first ? z : *(const f32x4*)(HG + ((size_t)(pm - 1) * 4 + 2) * FF + c), gm1 = first ? z : *(const f32x4*)(HG + ((size_t)(pm - 1) * 4 + 3) * FF + c);
            const f32x4 g0 = *(const f32x4*)(HG + ((size_t)pm * 4 + 0) * FF + c), g1 = *(const f32x4*)(HG + ((size_t)pm * 4 + 1) * FF + c);
            const f32x4 u0 = *(const f32x4*)(HU + ((size_t)pm * 2 + 0) * FF + c), u1 = *(const f32x4*)(HU + ((size_t)pm * 2 + 1) * FF + c);
            const f32x4 w0 = *(const f32x4*)(cw + c), w1 = *(const f32x4*)(cw + FF + c), w2 = *(const f32x4*)(cw + 2 * FF + c), bb = *(const f32x4*)(cb + c);
#pragma unroll
            for (int j = 0; j < 4; ++j) { o0[4 * hf + j] = pg8::gelu_tanh_mul(w0[j] * gm2[j] + w1[j] * gm1[j] + w2[j] * g0[j] + bb[j], u0[j]);
                                          o1[4 * hf + j] = pg8::gelu_tanh_mul(w0[j] * gm1[j] + w1[j] * g0[j] + w2[j] * g1[j] + bb[j], u1[j]); }
        }
        *(u32x4*)(ACT + (size_t)(pm * 256 + 0) * FF + c0) = pack8(o0);
        *(u32x4*)(ACT + (size_t)(pm * 256 + 1) * FF + c0) = pack8(o1);
    }
}

__device__ __forceinline__ void sc_item(const Params& P, int l, int si) {
    bf16_t* Z = (bf16_t*)(P.ws + WS_Z);
    const int tid = get_tid(), cgi = tid & 63, run = tid >> 6, c0 = cgi * 8, t0 = si * 128 + run * 16;
    const float* cw = P.sc_conv_w + (size_t)l * 3 * 512;
    float w0[8], w1[8], w2[8];
#pragma unroll
    for (int j = 0; j < 8; ++j) { w0[j] = cw[c0 + j]; w1[j] = cw[512 + c0 + j]; w2[j] = cw[1024 + c0 + j]; }
    float p1[8], p2[8];
    if ((t0 & 2047) != 0) {
        float a[8], b[8];
        unpack8(*(const u32x4*)(Z + (size_t)(t0 - 1) * ZC + ZSC + c0), a); unpack8(*(const u32x4*)(Z + (size_t)(t0 - 1) * ZC + ZSX + c0), b);
#pragma unroll
        for (int j = 0; j < 8; ++j) p1[j] = a[j] * b[j];
        unpack8(*(const u32x4*)(Z + (size_t)(t0 - 2) * ZC + ZSC + c0), a); unpack8(*(const u32x4*)(Z + (size_t)(t0 - 2) * ZC + ZSX + c0), b);
#pragma unroll
        for (int j = 0; j < 8; ++j) p2[j] = a[j] * b[j];
    } else {
#pragma unroll
        for (int j = 0; j < 8; ++j) { p1[j] = 0.f; p2[j] = 0.f; } }
    for (int tt = 0; tt < 16; tt += 4) {
        u32x4 va[4], vb[4], vs[4];
#pragma unroll
        for (int k = 0; k < 4; ++k) { const bf16_t* zr = Z + (size_t)(t0 + tt + k) * ZC; va[k] = *(const u32x4*)(zr + ZSC + c0); vb[k] = *(const u32x4*)(zr + ZSX + c0); vs[k] = *(const u32x4*)(zr + ZSB + c0); }
#pragma unroll
        for (int k = 0; k < 4; ++k) {
            float a[8], b[8], sb[8], o[8];
            unpack8(va[k], a); unpack8(vb[k], b); unpack8(vs[k], sb);
#pragma unroll
            for (int j = 0; j < 8; ++j) { const float p0 = a[j] * b[j]; o[j] = sb[j] * (w0[j] * p2[j] + w1[j] * p1[j] + w2[j] * p0); p2[j] = p1[j]; p1[j] = p0; }
            *(u32x4*)(Z + (size_t)(t0 + tt + k) * ZC + ZSB + c0) = pack8(o);
        }
    }
}

__device__ __forceinline__ void attn_item(const Params& P, int half, int item, LAS unsigned char* lds, unsigned* ctr) {
    const int tid = get_tid(), lane = tid & 63, w = __builtin_amdgcn_readfirstlane(tid >> 6), g = lane >> 4, c = lane & 15;
    const int b = item / 192, rem = item % 192, gi = rem / 64, r2 = rem % 64;
    const int dil = (gi == 0) ? 1 : (gi == 1 ? 4 : 16), nb = 16 / dil;
    const int n = r2 % nb, t2 = r2 / nb, hh = t2 & 3, rr = t2 >> 2;
    bf16_t* Z = (bf16_t*)(P.ws + WS_Z);
    const float* RC = (const float*)(P.ws + WS_RC); const float* RS = (const float*)(P.ws + WS_RS);
    float* LSE = (float*)(P.ws + WS_LSE);
    const int colq = ZDQ + gi * 512 + hh * 128, colk = ZDK + gi * 512 + hh * 128, colv = ZDV + gi * 512 + hh * 128;
    const int rowb = b * 2048, gtb = half * TH;
    constexpr int KSTR = 272, VSTR = 528;
    LAS unsigned char* Ks = lds; LAS unsigned char* Vt = lds + 256 * KSTR;
    constexpr float QSCALE = 0.08838834764831845f * 1.4426950408889634f;

    const int km = tid >> 1, khf = tid & 1, klk = (n - 1) * 128 + km;
    const int vkb = tid & 31, vdb = tid >> 5, vlk0 = (n - 1) * 128 + vkb * 8;
    const int qi = 16 * w + c, qrow = rowb + (n * 128 + qi) * dil + rr;
    u32x4 kx1[4], kx2[4]; f32x4 kinv[8]; float kpos = 0.f;
    u32x4 rv[8];
    u32x4 qx1[2], qx2[2]; f32x4 qinv[4]; float qpos;
    if (klk >= 0) {
        const int krow = rowb + klk * dil + rr;
        const bf16_t* kp = Z + (size_t)krow * ZC + colk + khf * 32;
        kpos = (float)P.pos[gtb + krow];
#pragma unroll
        for (int cc = 0; cc < 4; ++cc) { kx1[cc] = *(const u32x4*)(kp + cc * 8); kx2[cc] = *(const u32x4*)(kp + 64 + cc * 8);
            kinv[2 * cc] = *(const f32x4*)(RC + khf * 32 + cc * 8); kinv[2 * cc + 1] = *(const f32x4*)(RC + khf * 32 + cc * 8 + 4); }
    } else {
#pragma unroll
        for (int cc = 0; cc < 4; ++cc) { kx1[cc] = (u32x4){0u, 0u, 0u, 0u}; kx2[cc] = (u32x4){0u, 0u, 0u, 0u};
            kinv[2 * cc] = (f32x4){0.f, 0.f, 0.f, 0.f}; kinv[2 * cc + 1] = (f32x4){0.f, 0.f, 0.f, 0.f}; }
    }
    if (vlk0 >= 0) {
#pragma unroll
        for (int kk = 0; kk < 8; ++kk) { const int row = rowb + (vlk0 + kk) * dil + rr; rv[kk] = *(const u32x4*)(Z + (size_t)row * ZC + colv + vdb * 8); }
    } else {
#pragma unroll
        for (int kk = 0; kk < 8; ++kk) rv[kk] = (u32x4){0u, 0u, 0u, 0u};
    }
    {
        const bf16_t* qp = Z + (size_t)qrow * ZC + colq + 8 * g;
        qpos = (float)P.pos[gtb + qrow];
#pragma unroll
        for (int kh = 0; kh < 2; ++kh) { qx1[kh] = *(const u32x4*)(qp + kh * 32); qx2[kh] = *(const u32x4*)(qp + 64 + kh * 32);
            qinv[2 * kh] = *(const f32x4*)(RC + kh * 32 + 8 * g); qinv[2 * kh + 1] = *(const f32x4*)(RC + kh * 32 + 8 * g + 4); }
    }
    {
        LAS unsigned char* kd = Ks + km * KSTR;
#pragma unroll
        for (int cc = 0; cc < 4; ++cc) {
            float x1[8], x2[8], o1[8], o2[8];
            unpack8(kx1[cc], x1); unpack8(kx2[cc], x2);
            f32x4 c0, c1, s0, s1;
#pragma unroll
            for (int j = 0; j < 4; ++j) { const float r0 = __builtin_amdgcn_fractf(kpos * kinv[2 * cc][j]), r1 = __builtin_amdgcn_fractf(kpos * kinv[2 * cc + 1][j]);
                c0[j] = __builtin_amdgcn_cosf(r0); s0[j] = __builtin_amdgcn_sinf(r0); c1[j] = __builtin_amdgcn_cosf(r1); s1[j] = __builtin_amdgcn_sinf(r1); }
#pragma unroll
            for (int j = 0; j < 4; j += 2) {
                { const f32x2 X1 = (f32x2){x1[j], x1[j + 1]}, X2 = (f32x2){x2[j], x2[j + 1]}, C = (f32x2){c0[j], c0[j + 1]}, Sn = (f32x2){s0[j], s0[j + 1]};
                  const f32x2 A = X1 * C - X2 * Sn, B = X2 * C + X1 * Sn; o1[j] = A.x; o1[j + 1] = A.y; o2[j] = B.x; o2[j + 1] = B.y; }
                { const f32x2 X1 = (f32x2){x1[4 + j], x1[5 + j]}, X2 = (f32x2){x2[4 + j], x2[5 + j]}, C = (f32x2){c1[j], c1[j + 1]}, Sn = (f32x2){s1[j], s1[j + 1]};
                  const f32x2 A = X1 * C - X2 * Sn, B = X2 * C + X1 * Sn; o1[4 + j] = A.x; o1[5 + j] = A.y; o2[4 + j] = B.x; o2[5 + j] = B.y; } }
            *(LAS u32x4*)(kd + (khf * 32 + cc * 8) * 2) = pack8(o1); *(LAS u32x4*)(kd + (64 + khf * 32 + cc * 8) * 2) = pack8(o2);
        }
    }
    {
#pragma unroll
        for (int dd = 0; dd < 8; ++dd) {
            const int wi = dd >> 1; u32x4 o;
            if (dd & 1) { o.x = __builtin_amdgcn_perm(rv[1][wi], rv[0][wi], 0x07060302u); o.y = __builtin_amdgcn_perm(rv[3][wi], rv[2][wi], 0x07060302u); o.z = __builtin_amdgcn_perm(rv[5][wi], rv[4][wi], 0x07060302u); o.w = __builtin_amdgcn_perm(rv[7][wi], rv[6][wi], 0x07060302u); }
            else { o.x = __builtin_amdgcn_perm(rv[1][wi], rv[0][wi], 0x05040100u); o.y = __builtin_amdgcn_perm(rv[3][wi], rv[2][wi], 0x05040100u); o.z = __builtin_amdgcn_perm(rv[5][wi], rv[4][wi], 0x05040100u); o.w = __builtin_amdgcn_perm(rv[7][wi], rv[6][wi], 0x05040100u); }
            *(LAS u32x4*)(Vt + (vdb * 8 + dd) * VSTR + vkb * 16) = o;
        }
    }
    bf16x8 Qf[4];
    {
#pragma unroll
        for (int kh = 0; kh < 2; ++kh) {
            float x1[8], x2[8], o1[8], o2[8];
            unpack8(qx1[kh], x1); unpack8(qx2[kh], x2);
            f32x4 c0, c1, s0, s1;
#pragma unroll
            for (int j = 0; j < 4; ++j) { const float r0 = __builtin_amdgcn_fractf(qpos * qinv[2 * kh][j]), r1 = __builtin_amdgcn_fractf(qpos * qinv[2 * kh + 1][j]);
                c0[j] = __builtin_amdgcn_cosf(r0); s0[j] = __builtin_amdgcn_sinf(r0); c1[j] = __builtin_amdgcn_cosf(r1); s1[j] = __builtin_amdgcn_sinf(r1); }
#pragma unroll
            for (int j = 0; j < 4; j += 2) {
                { const f32x2 X1 = (f32x2){x1[j], x1[j + 1]} * QSCALE, X2 = (f32x2){x2[j], x2[j + 1]} * QSCALE, C = (f32x2){c0[j], c0[j + 1]}, Sn = (f32x2){s0[j], s0[j + 1]};
                  const f32x2 A = X1 * C - X2 * Sn, B = X2 * C + X1 * Sn; o1[j] = A.x; o1[j + 1] = A.y; o2[j] = B.x; o2[j + 1] = B.y; }
                { const f32x2 X1 = (f32x2){x1[4 + j], x1[5 + j]} * QSCALE, X2 = (f32x2){x2[4 + j], x2[5 + j]} * QSCALE, C = (f32x2){c1[j], c1[j + 1]}, Sn = (f32x2){s1[j], s1[j + 1]};
                  const f32x2 A = X1 * C - X2 * Sn, B = X2 * C + X1 * Sn; o1[4 + j] = A.x; o1[5 + j] = A.y; o2[4 + j] = B.x; o2[5 + j] = B.y; } }
            Qf[kh] = as_bf16x8(pack8(o1)); Qf[kh + 2] = as_bf16x8(pack8(o2));
        }
    }
    __syncthreads();
    unsigned nxt_id = 0u;
    if (tid == 0) nxt_id = atomicAdd(ctr, 1u);
    const int m0 = (16 * w < 96) ? 16 * w : 96;
    f32x4 S[10];
#pragma unroll
    for (int jt = 0; jt < 10; ++jt) {
        S[jt] = (f32x4){0.f, 0.f, 0.f, 0.f};
        const LAS unsigned char* kr = Ks + (m0 + jt * 16 + c) * KSTR + 16 * g;
#pragma unroll
        for (int ks = 0; ks < 4; ++ks) { const bf16x8 a = *(const LAS bf16x8*)(kr + ks * 64); S[jt] = __builtin_amdgcn_mfma_f32_16x16x32_bf16(a, Qf[ks], S[jt], 0, 0, 0); }
    }
    float mx = -INFINITY;
    const int dbase = qi + 128 - m0 - 4 * g;
    const unsigned dlim = (unsigned)((n == 0) ? (qi < 128 ? qi : 128) : 128);
#pragma unroll
    for (int jt = 0; jt < 10; ++jt)
#pragma unroll
        for (int jj = 0; jj < 4; ++jj) { const bool ok = (unsigned)(dbase - (jt * 16 + jj)) <= dlim;
            const float s = ok ? S[jt][jj] : -INFINITY; S[jt][jj] = s; mx = fmaxf(mx, s); }
    mx = fmaxf(mx, __shfl_xor(mx, 16)); mx = fmaxf(mx, __shfl_xor(mx, 32));
    float den = 0.f;
#pragma unroll
    for (int jt = 0; jt < 10; ++jt) { const f32x4 d = S[jt] - mx; f32x4 p; p[0] = __builtin_amdgcn_exp2f(d[0]); p[1] = __builtin_amdgcn_exp2f(d[1]); p[2] = __builtin_amdgcn_exp2f(d[2]); p[3] = __builtin_amdgcn_exp2f(d[3]);
        S[jt] = p; den += (p[0] + p[1]) + (p[2] + p[3]); }
    den += __shfl_xor(den, 16); den += __shfl_xor(den, 32);
    bf16x8 Pf[5];
#pragma unroll
    for (int k5 = 0; k5 < 5; ++k5) { u32x4 pw; pw.x = cvt_pk_bf16(S[2 * k5][0], S[2 * k5][1]); pw.y = cvt_pk_bf16(S[2 * k5][2], S[2 * k5][3]); pw.z = cvt_pk_bf16(S[2 * k5 + 1][0], S[2 * k5 + 1][1]); pw.w = cvt_pk_bf16(S[2 * k5 + 1][2], S[2 * k5 + 1][3]); Pf[k5] = as_bf16x8(pw); }
    const float inv = 1.0f / den;
    bf16_t* op = Z + (size_t)qrow * ZC + colq + 4 * g;
#pragma unroll
    for (int dt = 0; dt < 8; ++dt) {
        f32x4 O = (f32x4){0.f, 0.f, 0.f, 0.f};
        const LAS unsigned char* vr = Vt + (dt * 16 + c) * VSTR + (m0 + 4 * g) * 2;
#pragma unroll
        for (int k5 = 0; k5 < 5; ++k5) { const u32x2 lo = *(const LAS u32x2*)(vr + k5 * 64), hi = *(const LAS u32x2*)(vr + k5 * 64 + 32);
            const bf16x8 a = as_bf16x8((u32x4){lo.x, lo.y, hi.x, hi.y}); O = __builtin_amdgcn_mfma_f32_16x16x32_bf16(a, Pf[k5], O, 0, 0, 0); }
        u32x2 ow; ow.x = cvt_pk_bf16(O[0] * inv, O[1] * inv); ow.y = cvt_pk_bf16(O[2] * inv, O[3] * inv);
        *(u32x2*)(op + dt * 16) = ow;
    }
    if (g == 0) LSE[(size_t)qrow * 12 + gi * 4 + hh] = (mx + __builtin_amdgcn_logf(den)) * 0.6931471805599453f;
    if (tid == 0) *(LAS unsigned*)(lds + LDS_SLOT) = nxt_id;
    __syncthreads();
}

__device__ __forceinline__ float logsig16(float x) { return (fminf(x, 0.f) - __logf(1.0f + __expf(-fabsf(x)))) * (1.0f / 16.0f); }

#define LBAR() do { asm volatile("s_waitcnt lgkmcnt(0)" ::: "memory"); __builtin_amdgcn_s_barrier(); asm volatile("" ::: "memory"); } while (0)
__device__ void gla_item(const Params& P, int l, int b, int h, int seg, LAS unsigned char* lds) {
    const int tid = get_tid(), lane = tid & 63, w = __builtin_amdgcn_readfirstlane(tid >> 6), g = lane >> 4, c = lane & 15;
    bf16_t* Z = (bf16_t*)(P.ws + WS_Z); const float* AL = (const float*)(P.ws + WS_ALOW);
    LAS float* WUP = (LAS float*)(lds + 0);
    LAS float* BUP = (LAS float*)(lds + 4096);
    LAS float* ARAW = (LAS float*)(lds + 4352);
    LAS float* LC = (LAS float*)(lds + 8448);
    LAS float* SEG = (LAS float*)(lds + 24832);
    LAS float* DEC = (LAS float*)(lds + 26880);
    LAS unsigned char* QP = lds + 29184;
    LAS unsigned char* KP = lds + 38400;
    LAS unsigned char* KPP = lds + 47616;
    LAS unsigned char* AIN = lds + 56832;
    LAS unsigned char* VS = lds + 66048;
    LAS unsigned char* OT = lds + 83456;
    constexpr int QS = 144, VSS = 272;
    for (int i = tid; i < 1024; i += NTHR) { const int r = i >> 6, d = i & 63; WUP[i] = P.w_alpha_up[((size_t)l * 16 + r) * 256 + h * 64 + d]; }
    if (tid < 64) BUP[tid] = P.b_alpha[(size_t)l * 256 + h * 64 + tid];
    f32x4 Sacc[4];
#pragma unroll
    for (int dt = 0; dt < 4; ++dt) Sacc[dt] = (f32x4){0.f, 0.f, 0.f, 0.f};
    const int rowb = b * 2048 + seg * 256;
    const int t_ = tid >> 3, d8 = (tid & 7) * 8;
    u32x4 nq, nk, nv0, nv1; f32x4 na = (f32x4){0.f, 0.f, 0.f, 0.f};
    {
        const size_t r0 = (size_t)(rowb + t_) * ZC;
        nq = *(const u32x4*)(Z + r0 + ZQ + h * 64 + d8); nk = *(const u32x4*)(Z + r0 + ZK + h * 64 + d8);
        nv0 = *(const u32x4*)(Z + (size_t)(rowb + (tid >> 4)) * ZC + ZV + h * 128 + (tid & 15) * 8);
        nv1 = *(const u32x4*)(Z + (size_t)(rowb + 32 + (tid >> 4)) * ZC + ZV + h * 128 + (tid & 15) * 8);
        if (tid < 256) na = *(const f32x4*)(AL + (size_t)(rowb + (tid >> 2)) * 16 + (tid & 3) * 4);
    }
    float Lseg[8];
#pragma unroll
    for (int j = 0; j < 8; ++j) Lseg[j] = 0.f;
    float* DSEG = (float*)(P.ws + WS_DSEG);
    for (int n = 0; n < 4; ++n) {
        if ((n & 3) == 0) {
#pragma unroll
            for (int dt = 0; dt < 4; ++dt) Sacc[dt] = (f32x4){0.f, 0.f, 0.f, 0.f};
#pragma unroll
            for (int j = 0; j < 8; ++j) Lseg[j] = 0.f;
        }
        const int row0 = rowb + n * 64;
        const u32x4 cq = nq, ck = nk;
        *(LAS u32x4*)(VS + (tid >> 4) * VSS + (tid & 15) * 16) = nv0;
        *(LAS u32x4*)(VS + (32 + (tid >> 4)) * VSS + (tid & 15) * 16) = nv1;
        if (tid < 256) *(LAS f32x4*)(ARAW + (tid >> 2) * 16 + (tid & 3) * 4) = na;
        if (n + 1 < 4) {
            const int rn = row0 + 64; const size_t r0 = (size_t)(rn + t_) * ZC;
            nq = *(const u32x4*)(Z + r0 + ZQ + h * 64 + d8); nk = *(const u32x4*)(Z + r0 + ZK + h * 64 + d8);
            nv0 = *(const u32x4*)(Z + (size_t)(rn + (tid >> 4)) * ZC + ZV + h * 128 + (tid & 15) * 8);
            nv1 = *(const u32x4*)(Z + (size_t)(rn + 32 + (tid >> 4)) * ZC + ZV + h * 128 + (tid & 15) * 8);
            if (tid < 256) na = *(const f32x4*)(AL + (size_t)(rn + (tid >> 2)) * 16 + (tid & 3) * 4);
        }
        LBAR();
        {
            float x[8];
#pragma unroll
            for (int j = 0; j < 8; ++j) x[j] = BUP[d8 + j];
#pragma unroll
            for (int r = 0; r < 16; ++r) { const float a = ARAW[t_ * 16 + r]; const f32x4 w0 = *(const LAS f32x4*)(WUP + r * 64 + d8), w1 = *(const LAS f32x4*)(WUP + r * 64 + d8 + 4);
#pragma unroll
                for (int j = 0; j < 4; ++j) { x[j] += a * w0[j]; x[4 + j] += a * w1[j]; } }
            f32x4 o0, o1;
#pragma unroll
            for (int j = 0; j < 4; ++j) { o0[j] = logsig16(x[j]); o1[j] = logsig16(x[4 + j]); }
            *(LAS f32x4*)(LC + t_ * 64 + d8) = o0; *(LAS f32x4*)(LC + t_ * 64 + d8 + 4) = o1;
        }
        LBAR();
        {
            const int d = tid & 63, sg = tid >> 6; float cum[8]; float run = 0.f;
#pragma unroll
            for (int i = 0; i < 8; ++i) { run += LC[(sg * 8 + i) * 64 + d]; cum[i] = run; }
            SEG[sg * 64 + d] = run;
            LBAR();
            float off = 0.f;
#pragma unroll
            for (int s = 0; s < 7; ++s) off += (s < sg) ? SEG[s * 64 + d] : 0.f;
#pragma unroll
            for (int i = 0; i < 8; ++i) LC[(sg * 8 + i) * 64 + d] = cum[i] + off;
        }
        LBAR();
        {
            const f32x4 L0 = *(const LAS f32x4*)(LC + t_ * 64 + d8), L1 = *(const LAS f32x4*)(LC + t_ * 64 + d8 + 4);
            const f32x4 E0 = *(const LAS f32x4*)(LC + 63 * 64 + d8), E1 = *(const LAS f32x4*)(LC + 63 * 64 + d8 + 4);
            float qf[8], kf[8], qo[8], ko[8], k2[8], q2[8];
            unpack8(cq, qf); unpack8(ck, kf);
#pragma unroll
            for (int j = 0; j < 8; ++j) { const float L = (j < 4) ? L0[j & 3] : L1[j & 3], Le = (j < 4) ? E0[j & 3] : E1[j & 3];
                qo[j] = qf[j] * __expf(L) * 0.125f; ko[j] = kf[j] * __expf(-L); k2[j] = kf[j] * __expf(Le - L); q2[j] = qf[j] * __expf(L + Lseg[j]) * 0.125f; Lseg[j] += Le; }
            *(LAS u32x4*)(QP + t_ * QS + d8 * 2) = pack8(qo); *(LAS u32x4*)(KP + t_ * QS + d8 * 2) = pack8(ko); *(LAS u32x4*)(KPP + t_ * QS + d8 * 2) = pack8(k2);
            *(u32x4*)(Z + (size_t)(row0 + t_) * ZC + ZQ + h * 64 + d8) = pack8(q2);
            if (t_ == 0) {
#pragma unroll
                for (int j = 0; j < 8; ++j) DEC[d8 + j] = __expf((j < 4) ? E0[j & 3] : E1[j & 3]); }
        }
        LBAR();
#pragma unroll
        for (int q = 0; q < 2; ++q) {
            const int idx = 2 * w + q, it = idx >> 2, jt = idx & 3;
            f32x4 A = (f32x4){0.f, 0.f, 0.f, 0.f};
            if (jt <= it) {
#pragma unroll
                for (int ks = 0; ks < 2; ++ks) { const bf16x8 a = *(const LAS bf16x8*)(QP + (it * 16 + c) * QS + (ks * 32 + 8 * g) * 2), bb = *(const LAS bf16x8*)(KP + (jt * 16 + c) * QS + (ks * 32 + 8 * g) * 2);
                    A = __builtin_amdgcn_mfma_f32_16x16x32_bf16(a, bb, A, 0, 0, 0); }
            }
#pragma unroll
            for (int jj = 0; jj < 4; ++jj) { const int i = it * 16 + 4 * g + jj, j = jt * 16 + c; const float v = (j <= i) ? A[jj] : 0.f;
                *(LAS unsigned short*)(AIN + i * QS + j * 2) = f2bf(v); }
        }
        LBAR();
        bf16x8 Vb[2];
#pragma unroll
        for (int ks = 0; ks < 2; ++ks) { unsigned short e[8];
#pragma unroll
            for (int j = 0; j < 8; ++j) e[j] = *(const LAS unsigned short*)(VS + (ks * 32 + 8 * g + j) * VSS + (16 * w + c) * 2);
            u32x4 pw; pw.x = e[0] | ((unsigned)e[1] << 16); pw.y = e[2] | ((unsigned)e[3] << 16); pw.z = e[4] | ((unsigned)e[5] << 16); pw.w = e[6] | ((unsigned)e[7] << 16); Vb[ks] = as_bf16x8(pw); }
        bf16x8 Sb[2];
#pragma unroll
        for (int k2 = 0; k2 < 2; ++k2) { u32x4 pw; pw.x = cvt_pk_bf16(Sacc[2 * k2][0], Sacc[2 * k2][1]); pw.y = cvt_pk_bf16(Sacc[2 * k2][2], Sacc[2 * k2][3]);
            pw.z = cvt_pk_bf16(Sacc[2 * k2 + 1][0], Sacc[2 * k2 + 1][1]); pw.w = cvt_pk_bf16(Sacc[2 * k2 + 1][2], Sacc[2 * k2 + 1][3]); Sb[k2] = as_bf16x8(pw); }
        f32x4 Oacc[4];
#pragma unroll
        for (int it = 0; it < 4; ++it) {
            Oacc[it] = (f32x4){0.f, 0.f, 0.f, 0.f};
#pragma unroll
            for (int ks = 0; ks < 2; ++ks) { const bf16x8 a = *(const LAS bf16x8*)(AIN + (it * 16 + c) * QS + (ks * 32 + 8 * g) * 2); Oacc[it] = __builtin_amdgcn_mfma_f32_16x16x32_bf16(a, Vb[ks], Oacc[it], 0, 0, 0); }
#pragma unroll
            for (int k2 = 0; k2 < 2; ++k2) { const u32x2 lo = *(const LAS u32x2*)(QP + (it * 16 + c) * QS + (32 * k2 + 4 * g) * 2), hi = *(const LAS u32x2*)(QP + (it * 16 + c) * QS + (32 * k2 + 16 + 4 * g) * 2);
                const bf16x8 a = as_bf16x8((u32x4){lo.x, lo.y, hi.x, hi.y}); Oacc[it] = __builtin_amdgcn_mfma_f32_16x16x32_bf16(a, Sb[k2], Oacc[it], 0, 0, 0); }
        }
#pragma unroll
        for (int dt = 0; dt < 4; ++dt) {
            const f32x4 dc = *(const LAS f32x4*)(DEC + dt * 16 + 4 * g);
            Sacc[dt] = Sacc[dt] * dc;
#pragma unroll
            for (int ks = 0; ks < 2; ++ks) { unsigned short e[8];
#pragma unroll
                for (int j = 0; j < 8; ++j) e[j] = *(const LAS unsigned short*)(KPP + (ks * 32 + 8 * g + j) * QS + (dt * 16 + c) * 2);
                u32x4 pw; pw.x = e[0] | ((unsigned)e[1] << 16); pw.y = e[2] | ((unsigned)e[3] << 16); pw.z = e[4] | ((unsigned)e[5] << 16); pw.w = e[6] | ((unsigned)e[7] << 16);
                Sacc[dt] = __builtin_amdgcn_mfma_f32_16x16x32_bf16(as_bf16x8(pw), Vb[ks], Sacc[dt], 0, 0, 0); }
        }
#pragma unroll
        for (int it = 0; it < 4; ++it)
#pragma unroll
            for (int jj = 0; jj < 4; ++jj) *(LAS unsigned short*)(OT + (it * 16 + 4 * g + jj) * VSS + (16 * w + c) * 2) = f2bf(Oacc[it][jj]);
        LBAR();
        {
            const u32x4 o0 = *(const LAS u32x4*)(OT + (tid >> 4) * VSS + (tid & 15) * 16), o1 = *(const LAS u32x4*)(OT + (32 + (tid >> 4)) * VSS + (tid & 15) * 16);
            *(u32x4*)(Z + (size_t)(row0 + (tid >> 4)) * ZC + ZV + h * 128 + (tid & 15) * 8) = o0;
            *(u32x4*)(Z + (size_t)(row0 + 32 + (tid >> 4)) * ZC + ZV + h * 128 + (tid & 15) * 8) = o1;
        }
        if ((n & 3) == 3) {
            const int rs0 = rowb;
#pragma unroll
            for (int dt = 0; dt < 4; ++dt)
#pragma unroll
                for (int jj = 0; jj < 4; ++jj) { const int d = dt * 16 + 4 * g + jj, dv = 16 * w + c; *((float*)(Z + (size_t)(rs0 + d * 4 + (dv >> 5)) * ZC + ZK + h * 64) + (dv & 31)) = Sacc[dt][jj]; }            if (t_ == 0) {
#pragma unroll
                for (int j = 0; j < 8; ++j) DSEG[(size_t)((b * 4 + h) * 8 + seg) * 64 + d8 + j] = __expf(Lseg[j]); }
        }
    }
    __syncthreads();
}


__device__ void gla_C(const Params& P, int l, int item, LAS unsigned char* lds) {
    const int tid = get_tid(), lane = tid & 63, w = __builtin_amdgcn_readfirstlane(tid >> 6), g = lane >> 4, c = lane & 15;
    const int seg = item & 7, bh = item >> 3, b = bh >> 2, h = bh & 3;
    bf16_t* Z = (bf16_t*)(P.ws + WS_Z);
    LAS float* SSQ = (LAS float*)lds;
    LAS unsigned char* OT = lds + 8192;
    const float ng = P.gla_norm_g[(size_t)l * 128 + 16 * w + c];
    const float* DSEG = (const float*)(P.ws + WS_DSEG);
    float Sin[2][8];
#pragma unroll
    for (int ks = 0; ks < 2; ++ks)
#pragma unroll
        for (int e = 0; e < 8; ++e) Sin[ks][e] = 0.f;
    for (int sq = 0; sq < seg; ++sq) {
        const int rs0 = b * 2048 + sq * 256; const size_t it2 = (size_t)bh * 8 + sq;
#pragma unroll
        for (int ks = 0; ks < 2; ++ks)
#pragma unroll
            for (int e = 0; e < 8; ++e) { const int d = ks * 32 + 8 * g + e, dv = 16 * w + c;
                Sin[ks][e] = DSEG[it2 * 64 + d] * Sin[ks][e] + *((const float*)(Z + (size_t)(rs0 + d * 4 + (dv >> 5)) * ZC + ZK + h * 64) + (dv & 31)); }
    }
    bf16x8 Sb[2];
#pragma unroll
    for (int ks = 0; ks < 2; ++ks) Sb[ks] = as_bf16x8(pack8(Sin[ks]));
    const int row0 = b * 2048 + seg * 256;
    unsigned short gtr[16][4], olr[16][4];
#pragma unroll
    for (int rt = 0; rt < 16; ++rt)
#pragma unroll
        for (int jj = 0; jj < 4; ++jj) { const bf16_t* zr = Z + (size_t)(row0 + rt * 16 + 4 * g + jj) * ZC + h * 128 + 16 * w + c; gtr[rt][jj] = zr[ZG]; olr[rt][jj] = zr[ZV]; }
    f32x4 O[16];
#pragma unroll
    for (int rt = 0; rt < 16; ++rt) {
#pragma unroll
        for (int jj = 0; jj < 4; ++jj) O[rt][jj] = bf2f(olr[rt][jj]);
        if (seg > 0) {
#pragma unroll
            for (int ks = 0; ks < 2; ++ks) { const bf16x8 a = as_bf16x8(*(const u32x4*)(Z + (size_t)(row0 + rt * 16 + c) * ZC + ZQ + h * 64 + ks * 32 + 8 * g)); O[rt] = __builtin_amdgcn_mfma_f32_16x16x32_bf16(a, Sb[ks], O[rt], 0, 0, 0); }
        }
    }
    {
#pragma unroll
        for (int rt = 0; rt < 16; ++rt) {
            float sv[4];
#pragma unroll
            for (int jj = 0; jj < 4; ++jj) sv[jj] = O[rt][jj] * O[rt][jj];
#pragma unroll
            for (int m = 1; m <= 8; m <<= 1)
#pragma unroll
                for (int jj = 0; jj < 4; ++jj) sv[jj] += __shfl_xor(sv[jj], m);
            if (c == 0) {
#pragma unroll
                for (int jj = 0; jj < 4; ++jj) SSQ[w * 256 + rt * 16 + 4 * g + jj] = sv[jj]; }
        }
    }
    __syncthreads();
#pragma unroll
    for (int rt = 0; rt < 16; ++rt)
#pragma unroll
        for (int jj = 0; jj < 4; ++jj) { const int t = rt * 16 + 4 * g + jj; float tot = 0.f;
#pragma unroll
            for (int ww = 0; ww < 8; ++ww) tot += SSQ[ww * 256 + t];
            const float rs = rsqrtf(tot * (1.0f / 128.0f) + EPS);
            const float gt = bf2f(gtr[rt][jj]);
            *(LAS unsigned short*)(OT + t * 272 + (16 * w + c) * 2) = f2bf(O[rt][jj] * rs * ng * (gt * __builtin_amdgcn_rcpf(1.0f + __expf(-gt)))); }
    __syncthreads();
#pragma unroll
    for (int i = 0; i < 8; ++i) { const int p = tid + i * NTHR, r = p >> 4, sg = p & 15;
        *(u32x4*)(Z + (size_t)(row0 + r) * ZC + ZG + h * 128 + sg * 8) = *(const LAS u32x4*)(OT + r * 272 + sg * 16); }
    __syncthreads();
}

__device__ __forceinline__ int next_item(unsigned* ctr, LAS unsigned char* lds) {
    __syncthreads();
    if (threadIdx.x == 0) *(LAS unsigned*)(lds + LDS_SLOT) = atomicAdd(ctr, 1u);
    __syncthreads();
    return (int)*(LAS unsigned*)(lds + LDS_SLOT);
}

__device__ void phase_branches(const Params& P, int l, int half, LAS unsigned char* lds) {
    unsigned* ctr = (unsigned*)(P.ws + WS_CTL) + 64 * (l * 2 + half);
    for (int it = blockIdx.x; it < 256; it += gridDim.x) gla_item(P, l, it >> 5, (it >> 3) & 3, it & 7, lds);
    int it = next_item(ctr, lds);
    while (it < 1536 + 128) {
        if (it < 1536) { attn_item(P, half, it, lds, ctr); it = (int)*(LAS unsigned*)(lds + LDS_SLOT); }
        else { sc_item(P, l, it - 1536); it = next_item(ctr, lds); }
    }
}


#define XB_TMO      128
#define XB_XCNT(j)  (256  + 64 * (j))
#define XB_XSUB(j)  (1280 + 64 * (j))
#define XB_XGEN(j)  (2304 + 64 * (j))
#define XB_TOP      3328
#define XB_TOPGEN   3392
#define XCD_BAR_WORDS 3456
#define XB_SPIN_CAP (1u << 20)
__device__ __forceinline__ unsigned xb_ld(unsigned* p)              { return __hip_atomic_load(p, __ATOMIC_RELAXED, __HIP_MEMORY_SCOPE_AGENT); }
__device__ __forceinline__ unsigned xb_add(unsigned* p, unsigned v) { return __hip_atomic_fetch_add(p, v, __ATOMIC_RELAXED, __HIP_MEMORY_SCOPE_AGENT); }
__device__ __forceinline__ unsigned xb_xcc_id() { return (unsigned)__builtin_amdgcn_s_getreg((3 << 11) | 20) & 0xFu; }
#define XB_SPIN(cond, bar) do { unsigned _sp = 0; while (cond) { __builtin_amdgcn_s_sleep(1); \
    if ((++_sp & 255u) == 0u) { if (xb_ld(&(bar)[XB_TMO])) break; if (_sp > XB_SPIN_CAP) { atomicAdd(&(bar)[XB_TMO], 1u); break; } } } } while (0)
struct XcdBarrier { unsigned* bar; unsigned x; volatile LAS unsigned* st; };
__device__ __forceinline__ XcdBarrier xcd_barrier_post(unsigned* bar, volatile LAS unsigned* st) {
    XcdBarrier b; b.bar = bar; b.x = xb_xcc_id(); b.st = st;
    if (threadIdx.x == 0) (void)xb_add(&bar[XB_XCNT(b.x)], 1u);
    return b;
}
__device__ __forceinline__ void xcd_barrier_complete(unsigned* bar, unsigned x, unsigned& nloc, unsigned& nx) {
    const unsigned G = gridDim.x * gridDim.y * gridDim.z;
    unsigned sum, cnt, mine, sp = 0u;
    for (;;) {
        sum = 0u; cnt = 0u; mine = 0u;
#pragma unroll
        for (unsigned j = 0; j < 16; ++j) { const unsigned c = xb_ld(&bar[XB_XCNT(j)]); sum += c; cnt += (c > 0u) ? 1u : 0u; mine = (j == x) ? c : mine; }
        if (sum == G) break;
        __builtin_amdgcn_s_sleep(1);
        if ((++sp & 255u) == 0u) { if (xb_ld(&bar[XB_TMO])) break; if (sp > XB_SPIN_CAP) { atomicAdd(&bar[XB_TMO], 1u); break; } }
    }
    nloc = mine > 0u ? mine : 1u; nx = cnt > 0u ? cnt : 1u;
}
__device__ __forceinline__ void xcd_barrier(const XcdBarrier& b) {
    asm volatile("s_waitcnt vmcnt(0)" ::: "memory");
    __syncthreads();
    if (threadIdx.x == 0) {
        unsigned* bar = b.bar;
        __builtin_amdgcn_s_waitcnt(0);
        unsigned nloc = b.st[0], nx = b.st[1];
        if (nloc == 0u) { xcd_barrier_complete(bar, b.x, nloc, nx); b.st[0] = nloc; b.st[1] = nx; }
        const unsigned old = xb_add(&bar[XB_XSUB(b.x)], 1u);
        const unsigned gen = old / nloc;
        if (old + 1u == (gen + 1u) * nloc) {
            __builtin_amdgcn_fence(__ATOMIC_RELEASE, "agent");
            asm volatile("s_waitcnt vmcnt(0)" ::: "memory");
            const unsigned og = xb_add(&bar[XB_TOP], 1u);
            const unsigned tg = og / nx;
            if (og + 1u == (tg + 1u) * nx) xb_add(&bar[XB_TOPGEN], 1u);
            else XB_SPIN(xb_ld(&bar[XB_TOPGEN]) == tg, bar);
            __builtin_amdgcn_fence(__ATOMIC_ACQUIRE, "agent");
            xb_add(&bar[XB_XGEN(b.x)], 1u);
            asm volatile("s_waitcnt vmcnt(0)" ::: "memory");
        } else {
            XB_SPIN(xb_ld(&bar[XB_XGEN(b.x)]) == gen, bar);
            __builtin_amdgcn_fence(__ATOMIC_ACQUIRE, "agent");
            asm volatile("s_waitcnt vmcnt(0)" ::: "memory");
        }
    }
    __syncthreads();
}

__global__ void __launch_bounds__(NTHR, 2) fwd_kernel(Params P) {
    extern __shared__ __attribute__((aligned(16))) unsigned char smem[];
    LAS unsigned char* lds = (LAS unsigned char*)smem;
    cg::grid_group grid = cg::this_grid();
    if (threadIdx.x < 4) ((LAS unsigned*)(lds + LDS_BYTES - 32))[threadIdx.x] = 0u;
    __syncthreads();
    const XcdBarrier xb = xcd_barrier_post((unsigned*)(P.ws + WS_BAR), (volatile LAS unsigned*)(lds + LDS_BYTES - 32));
    unsigned char* ws = P.ws;
    const int lo = P.ph_lo, hi = P.ph_hi;
    const bool fuse = (gridDim.x == 256);
    for (int ph = lo; ph < hi; ++ph) {
        const int l = ph / 19, q = ph % 19;
        const int half = (q >= 8 && q <= 14) ? 1 : 0;
        const int k = (q == 0) ? 0 : (q <= 14 ? 1 + (q - 1) % 7 : q - 7);
        switch (k) {
        case 0: if (l == 0) { phase_convert(P, l, lds); phase_norm_alow(P, 0, 0, lds); } break;
        case 1: break;
        case 2: { pg8::Gemm g{(const bf16_t*)(ws + WS_H) + (size_t)half * TH * DM, (const bf16_t*)(ws + WS_W1), 1024, 1024, 1024, 0, 0}; pg8::Order S; S.init(TH, 10752, gridDim.x, blockIdx.x, 1);
                  pg8::EpiSplit E{(bf16_t*)(ws + WS_Z), ZC, (bf16_t*)(ws + WS_GT), GC, 30, P.b_gate + (size_t)l * GC}; pg8::gemm_phase(lds, g, S, E); } break;
        case 3: phase_branches(P, l, half, lds); break;
        case 4: for (int it = blockIdx.x; it < 256; it += gridDim.x) gla_C(P, l, it, lds); phase_combine(P); break;
        case 5: { pg8::Gemm g{(const bf16_t*)(ws + WS_Z) + ZG, (const bf16_t*)(ws + WS_WBR), ZC, 512, 512, (size_t)1024, (size_t)1024 * 512};
                  pg8::Order S; S.init(TH, 1024, gridDim.x, blockIdx.x, 3);
                  pg8::EpiMerge E{(const bf16_t*)(ws + WS_GT), (bf16_t*)(ws + WS_MG)}; pg8::gemm_phase(lds, g, S, E); } break;
        case 6: if (fuse) {
                      const int inst = l * 2 + half;
                      pg8::Gemm g{(const bf16_t*)(ws + WS_MG), (const bf16_t*)(ws + WS_WMO), 1024, 1024, 1024, 0, 0}; pg8::Order S; S.init(TH, 1024, gridDim.x, blockIdx.x, 1);
                      pg8::EpiNormRes E{(l == 0 ? P.x : P.out) + (size_t)half * TH * DM, P.out + (size_t)half * TH * DM, (bf16_t*)(ws + WS_H) + (size_t)half * TH * DM,
                                        P.post_mix_g + (size_t)l * DM, P.pre_ffn_g + (size_t)l * DM,
                                        (unsigned*)(ws + WS_XS) + (size_t)(inst * 2) * TH * 4, (unsigned*)(ws + WS_XS) + (size_t)(inst * 2 + 1) * TH * 4,
                                        (unsigned*)(ws + WS_CTL) + 4608 + (inst * 2) * 256, (unsigned*)(ws + WS_CTL) + 4608 + (inst * 2 + 1) * 256};
                      pg8::gemm_phase(lds, g, S, E);
                      if (half == 0) phase_norm_alow(P, l, 1, lds);
                  } else { pg8::Gemm g{(const bf16_t*)(ws + WS_MG), (const bf16_t*)(ws + WS_WMO), 1024, 1024, 1024, 0, 0}; pg8::Order S; S.init(TH, 1024, gridDim.x, blockIdx.x, 1);
                      pg8::EpiSplit E{(bf16_t*)(ws + WS_Y), 1024, (bf16_t*)(ws + WS_Y), 1024, 1 << 20, nullptr}; pg8::gemm_phase(lds, g, S, E); } break;
        case 7: if (!fuse) { phase_resid((l == 0 ? P.x : P.out) + (size_t)half * TH * DM, P.out + (size_t)half * TH * DM, (const bf16_t*)(ws + WS_Y), P.post_mix_g + (size_t)l * DM, P.pre_ffn_g + (size_t)l * DM,
                            (bf16_t*)(ws + WS_H) + (size_t)half * TH * DM, TH);
                if (half == 0) phase_norm_alow(P, l, 1, lds); }
                break;
        case 8: { pg8::Gemm g{(const bf16_t*)(ws + WS_H), (const bf16_t*)(ws + WS_WFF), 1024, 1024, 1024, 0, 0}; pg8::Order S; S.init(T_ALL, 5632, gridDim.x, blockIdx.x, 1);
                  pg8::EpiFFN E{(bf16_t*)(ws + WS_U), (float*)(ws + WS_HG), (float*)(ws + WS_HU), P.ff_conv_w + (size_t)l * 3 * FF, P.ff_conv_b + (size_t)l * FF, lds + pg8::STAGE_BYTES};
                  pg8::gemm_phase(lds, g, S, E); } break;
        case 9: phase_ffn_fix(P, l); break;
        case 10: { pg8::Gemm g{(const bf16_t*)(ws + WS_U), (const bf16_t*)(ws + WS_WD), FF, FF, FF, 0, 0}; pg8::Order S; S.init(T_ALL, 1024, gridDim.x, blockIdx.x, 1);
                   pg8::EpiSplit E{(bf16_t*)(ws + WS_Y2), 1024, (bf16_t*)(ws + WS_Y2), 1024, 1 << 20, nullptr}; pg8::gemm_phase(lds, g, S, E); } break;
        default: phase_resid(P.out, P.out, (const bf16_t*)(ws + WS_Y2), P.post_ffn_g + (size_t)l * DM, nullptr, nullptr, T_ALL);
                 if (l == 0) { phase_convert(P, 1, lds); phase_norm_alow(P, 1, 0, lds); }
                 break;
        }
        const bool empty = (k == 0 && l == 1) || (k == 1) || (k == 7 && fuse);
        if (ph + 1 < hi && !empty) { if (hi < lo) grid.sync(); else xcd_barrier(xb); }
    }
}

constexpr int N_PHASES = 2 * (1 + 2 * 7 + 4);

#ifndef MULTI_LAUNCH
#define MULTI_LAUNCH 0
#endif

extern "C" void kernel_launch(void* const* d_in, const int* in_sizes, int n_in, void* d_out, int out_size, void* d_ws, size_t ws_size, hipStream_t stream) {
    static int grid = 0;
    if (grid == 0) {
        if (n_in != 20 || ws_size < WS_END) { fprintf(stderr, "kernel_launch: unexpected n_in %d / ws_size %zu (need %zu)\n", n_in, ws_size, (size_t)WS_END); grid = -1; return; }
        int dev = 0, cus = 0, per_cu = 0;
        hipGetDevice(&dev); hipDeviceGetAttribute(&cus, hipDeviceAttributeMultiprocessorCount, dev);
        if (hipFuncSetAttribute((const void*)fwd_kernel, hipFuncAttributeMaxDynamicSharedMemorySize, LDS_BYTES) != hipSuccess) { fprintf(stderr, "kernel_launch: hipFuncSetAttribute failed\n"); grid = -1; return; }
        if (hipOccupancyMaxActiveBlocksPerMultiprocessor(&per_cu, (const void*)fwd_kernel, NTHR, LDS_BYTES) != hipSuccess || per_cu < 1) per_cu = 1;
        (void)hipGetLastError();
        grid = cus * per_cu;
        if (grid > 256) grid = 256;
    }
    if (grid < 0) return;
    hipMemsetAsync((char*)d_ws + WS_CTL, 0, 32768, stream);
    Params p{};
    p.x = (const float*)d_in[0]; p.pos = (const int*)d_in[1]; p.w_in = (const float*)d_in[2]; p.w_alpha_up = (const float*)d_in[3]; p.b_alpha = (const float*)d_in[4];
    p.gla_norm_g = (const float*)d_in[5]; p.sc_conv_w = (const float*)d_in[6]; p.w_gate = (const float*)d_in[7]; p.b_gate = (const float*)d_in[8]; p.w_branch = (const float*)d_in[9];
    p.w_mix_out = (const float*)d_in[10]; p.pre_mix_g = (const float*)d_in[11]; p.post_mix_g = (const float*)d_in[12]; p.pre_ffn_g = (const float*)d_in[13]; p.post_ffn_g = (const float*)d_in[14];
    p.w_ff_gate = (const float*)d_in[15]; p.w_ff_up = (const float*)d_in[16]; p.ff_conv_w = (const float*)d_in[17]; p.ff_conv_b = (const float*)d_in[18]; p.w_ff_down = (const float*)d_in[19];
    p.out = (float*)d_out; p.ws = (unsigned char*)d_ws;
#if MULTI_LAUNCH
    for (int ph = 0; ph < N_PHASES; ++ph) { p.ph_lo = ph; p.ph_hi = ph + 1; hipLaunchKernelGGL(fwd_kernel, dim3(grid), dim3(NTHR), LDS_BYTES, stream, p); }
#else
    p.ph_lo = 0; p.ph_hi = N_PHASES;
    void* args[] = {&p};
    hipError_t e = hipLaunchCooperativeKernel((const void*)fwd_kernel, dim3(grid), dim3(NTHR), args, LDS_BYTES, stream);
    if (e != hipSuccess) fprintf(stderr, "cooperative launch failed: %s (grid %d)\n", hipGetErrorString(e), grid);
#endif
}
```

```cpp
#include <hip/hip_runtime.h>
#include <hip/hip_cooperative_groups.h>
#include <cstdint>
#include <cstdio>
namespace cg = cooperative_groups;

#define LAS __attribute__((address_space(3)))
typedef unsigned short bf16_t;
typedef short bf16x8 __attribute__((ext_vector_type(8)));
typedef float f32x4 __attribute__((ext_vector_type(4)));
typedef float f32x2 __attribute__((ext_vector_type(2)));
typedef unsigned u32x4 __attribute__((ext_vector_type(4)));
typedef unsigned u32x2 __attribute__((ext_vector_type(2)));

constexpr int T_ALL = 32768, TH = 16384, DM = 1024, ZC = 7680, GC = 3072, FF = 2816;
constexpr int ZQ = 0, ZK = 256, ZV = 512, ZG = 1024, ZSC = 1536, ZSB = 2048, ZSX = 2560, ZDQ = 3072, ZDK = 4608, ZDV = 6144;
constexpr int IN_COLS = 7696;
constexpr float EPS = 1e-6f;
constexpr int NTHR = 512;
constexpr int LDS_BYTES = 147456;
constexpr int LDS_SLOT = LDS_BYTES - 16;

constexpr size_t WS_CTL = 0;
constexpr size_t WS_BAR = 4096;
constexpr size_t WS_W1 = 32768;
constexpr size_t WS_WBR = WS_W1 + (size_t)10752 * 1024 * 2;
constexpr size_t WS_WMO = WS_WBR + (size_t)3 * 1024 * 512 * 2;
constexpr size_t WS_WFF = WS_WMO + (size_t)1024 * 1024 * 2;
constexpr size_t WS_WD = WS_WFF + (size_t)5632 * 1024 * 2;
constexpr size_t WS_RC = WS_WD + (size_t)1024 * 2816 * 2;
constexpr size_t WS_XS = WS_RC + (size_t)1024 * 1024;
constexpr size_t WS_RS = WS_RC + (size_t)T_ALL * 64 * 4;
constexpr size_t WS_H = WS_RS + (size_t)T_ALL * 64 * 4;
constexpr size_t WS_ALOW = WS_H + (size_t)T_ALL * 1024 * 2;
constexpr size_t WS_LSE = WS_ALOW + (size_t)TH * 16 * 4;
constexpr size_t WS_DSEG = WS_LSE + (size_t)TH * 12 * 4;
constexpr size_t WS_BIG = WS_DSEG + (size_t)256 * 64 * 4;
constexpr size_t WS_Z = WS_BIG;
constexpr size_t WS_GT = WS_Z + (size_t)TH * ZC * 2;
constexpr size_t WS_MG = WS_GT + (size_t)TH * GC * 2;
constexpr size_t WS_END = WS_MG + (size_t)TH * 1024 * 2;
constexpr size_t WS_Y = WS_BIG;
constexpr size_t WS_G = WS_BIG;
constexpr size_t WS_U = WS_BIG + (size_t)T_ALL * FF * 2;
constexpr size_t WS_Y2 = WS_BIG;
constexpr size_t WS_HG = WS_BIG + (size_t)T_ALL * 1024 * 4;
constexpr size_t WS_HU = WS_HG + (size_t)128 * 4 * FF * 4;
static_assert(WS_HU + (size_t)128 * 2 * FF * 4 <= WS_U, "halo fits between Y2 and the activation buffer");
static_assert(WS_U + (size_t)T_ALL * FF * 2 <= WS_END, "ffn overlay");

struct Params {
    const float* x; const int* pos; const float* w_in; const float* w_alpha_up; const float* b_alpha; const float* gla_norm_g; const float* sc_conv_w;
    const float* w_gate; const float* b_gate; const float* w_branch; const float* w_mix_out; const float* pre_mix_g; const float* post_mix_g;
    const float* pre_ffn_g; const float* post_ffn_g; const float* w_ff_gate; const float* w_ff_up; const float* ff_conv_w; const float* ff_conv_b; const float* w_ff_down;
    float* out; unsigned char* ws; int ph_lo, ph_hi;
};

__device__ __forceinline__ int get_tid() { int t = threadIdx.x; asm volatile("" : "+v"(t)); return t; }
__device__ __forceinline__ unsigned cvt_pk_bf16(float lo, float hi) { unsigned r; asm volatile("v_cvt_pk_bf16_f32 %0, %1, %2" : "=v"(r) : "v"(lo), "v"(hi)); return r; }
__device__ __forceinline__ float bflo(unsigned w) { return __uint_as_float(w << 16); }
__device__ __forceinline__ float bfhi(unsigned w) { return __uint_as_float(w & 0xffff0000u); }
__device__ __forceinline__ float bf2f(unsigned short b) { return __uint_as_float(((unsigned)b) << 16); }
__device__ __forceinline__ unsigned short f2bf(float f) { return (unsigned short)(cvt_pk_bf16(f, 0.f) & 0xffffu); }
__device__ __forceinline__ void unpack8(const u32x4 w, float (&f)[8]) { f[0] = bflo(w.x); f[1] = bfhi(w.x); f[2] = bflo(w.y); f[3] = bfhi(w.y); f[4] = bflo(w.z); f[5] = bfhi(w.z); f[6] = bflo(w.w); f[7] = bfhi(w.w); }
__device__ __forceinline__ u32x4 pack8(const float (&f)[8]) { u32x4 w; w.x = cvt_pk_bf16(f[0], f[1]); w.y = cvt_pk_bf16(f[2], f[3]); w.z = cvt_pk_bf16(f[4], f[5]); w.w = cvt_pk_bf16(f[6], f[7]); return w; }
__device__ __forceinline__ bf16x8 as_bf16x8(const u32x4 w) { union { u32x4 u; bf16x8 b; } c; c.u = w; return c.b; }

namespace pg8 {
constexpr int BM = 256, BK = 64, HALF = 128, HTB = HALF * BK * 2, STAGE_BYTES = 8 * HTB, NXCD = 8, WGM = 8;
__device__ __forceinline__ int lds_byte(int r, int c) { const int st = (r >> 4) * 2 + (c >> 5), rr = r & 15, cc = c & 31, ob = rr * 64 + cc * 2; return st * 1024 + (ob ^ (((ob >> 9) & 1) << 5)); }
__device__ __forceinline__ void stage_rc(int b, int& R, int& C) { const int st = b / 1024, sb = b % 1024, swz = sb ^ (((sb >> 9) & 1) << 5); R = (st >> 1) * 16 + swz / 64; C = (st & 1) * 32 + (swz % 64) / 2; }
__device__ __forceinline__ int perm32(int rho) { const int n = rho >> 4, i = rho & 15; return 8 * (i >> 2) + 4 * n + (i & 3); }

struct Unit { int pm, pn, g; };
struct Gemm { const bf16_t* A; const bf16_t* Bt; int lda, ldb, K; size_t gA, gB; };

struct Order {
    int nM, nN, nwg, G, c, ng;
    __device__ void init(int M, int N, int G_, int c_, int ng_) { nM = M / BM; nN = N / BM; nwg = nM * nN; G = G_; c = c_; ng = ng_; }
    __device__ bool next(int i, Unit& u) const {
        const int ti = i / ng; u.g = i - ti * ng;
        const long L = (long)ti * G + c; if (L >= nwg) return false;
        int wgid = (int)L; { const int q = nwg / NXCD, r = nwg % NXCD, xcd = wgid % NXCD, off = wgid / NXCD; wgid = (xcd < r ? xcd * (q + 1) : r * (q + 1) + (xcd - r) * q) + off; }
        const int nig = WGM * nN, gid = wgid / nig, fm = gid * WGM, gsz = (nM - fm) < WGM ? (nM - fm) : WGM;
        u.pm = fm + ((wgid % nig) % gsz); u.pn = (wgid % nig) / gsz; return true;
    }
};

template <class Epi>
__device__ __forceinline__ void gemm_phase(LAS unsigned char* lds, const Gemm g, const Order& S, const Epi& E) {
    const int tid = get_tid(), wid = __builtin_amdgcn_readfirstlane(tid >> 6), lane = tid & 63, wr = wid >> 2, wc = wid & 3, fr = lane & 15, fq = lane >> 4;
    const int K = g.K, nt = K / BK;
    unsigned voffA[2], voffB[2];
#pragma unroll
    for (int i = 0; i < 2; ++i) { int R, C; stage_rc(tid * 16 + i * 8192, R, C); const int Rb = Epi::PERM ? ((R & ~31) + perm32(R & 31)) : R;
        voffA[i] = (unsigned)(R * g.lda + C) * 2u; voffB[i] = (unsigned)(Rb * g.ldb + C) * 2u; }
    const size_t kstep = (size_t)(BK * 2);
    const size_t hstepA = (size_t)HALF * g.lda * 2, hstepB = (size_t)HALF * g.ldb * 2;
    const size_t tstepA = 2 * hstepA, tstepB = 2 * hstepB;
    const unsigned ldsw = (unsigned)wid * 1024u;
    const int aoff = lds_byte(wr * 64 + fr, fq * 8), boff = lds_byte(wc * 32 + fr, fq * 8);
#define PG8_SA(b, h) (((b) * 2 + (h)) * HTB)
#define PG8_SB(b, h) ((4 + (b) * 2 + (h)) * HTB)
#define PG8_STAGE(bufoff, gbase, voff) do { _Pragma("unroll") for (int _i = 0; _i < 2; ++_i) \
        __builtin_amdgcn_global_load_lds((const unsigned*)((const char*)(gbase) + (voff)[_i]), (LAS unsigned*)(lds + (bufoff) + ldsw + _i * 8192), 16, 0, 0); } while (0)
#define PG8_LDA(dst, b, h) do { _Pragma("unroll") for (int m = 0; m < 4; ++m) _Pragma("unroll") for (int k = 0; k < 2; ++k) dst[m][k] = *(const LAS bf16x8*)(lds + PG8_SA(b, h) + aoff + m * 2048 + k * 1024); } while (0)
#define PG8_LDB(dst, b, h) do { _Pragma("unroll") for (int n = 0; n < 2; ++n) _Pragma("unroll") for (int k = 0; k < 2; ++k) dst[n][k] = *(const LAS bf16x8*)(lds + PG8_SB(b, h) + boff + n * 2048 + k * 1024); } while (0)
#define PG8_MMA(ai, bj, At, Bt) do { __builtin_amdgcn_s_setprio(1); _Pragma("unroll") for (int m = 0; m < 4; ++m) _Pragma("unroll") for (int n = 0; n < 2; ++n) _Pragma("unroll") for (int k = 0; k < 2; ++k) \
        acc[ai][bj][m][n] = __builtin_amdgcn_mfma_f32_16x16x32_bf16(Bt[n][k], At[m][k], acc[ai][bj][m][n], 0, 0, 0); __builtin_amdgcn_s_setprio(0); } while (0)
#define PG8_WAIT_V(n) asm volatile("s_waitcnt vmcnt(" #n ")" ::: "memory")
#define PG8_WAIT_L(n) asm volatile("s_waitcnt lgkmcnt(" #n ")" ::: "memory")
#define PG8_BAR __builtin_amdgcn_s_barrier()
#define PG8_SCHED __builtin_amdgcn_sched_barrier(0)
    Unit cur, nxt; int ui = 0;
    if (!S.next(0, cur)) return;
    f32x4 acc[2][2][4][2];
#pragma unroll
    for (int a = 0; a < 2; ++a)
#pragma unroll
        for (int b = 0; b < 2; ++b)
#pragma unroll
            for (int m = 0; m < 4; ++m)
#pragma unroll
                for (int n = 0; n < 2; ++n) acc[a][b][m][n] = (f32x4){0.f, 0.f, 0.f, 0.f};
    bf16x8 At[4][2], B0[2][2], B1[2][2];
    const char* cA = (const char*)(g.A + (size_t)cur.g * g.gA) + (size_t)cur.pm * tstepA; const char* cB = (const char*)(g.Bt + (size_t)cur.g * g.gB) + (size_t)cur.pn * tstepB;
    PG8_STAGE(PG8_SB(0, 0), cB, voffB); PG8_STAGE(PG8_SB(0, 1), cB + hstepB, voffB); PG8_STAGE(PG8_SA(0, 0), cA, voffA); PG8_STAGE(PG8_SA(0, 1), cA + hstepA, voffA);
    if (wr == 1) PG8_BAR;
    PG8_WAIT_V(2); PG8_BAR;
    PG8_STAGE(PG8_SB(1, 0), cB + kstep, voffB); PG8_STAGE(PG8_SA(1, 0), cA + kstep, voffA); PG8_STAGE(PG8_SB(1, 1), cB + hstepB + kstep, voffB);
    PG8_WAIT_V(6); PG8_BAR;
    for (;;) {
        const bool has_next = S.next(ui + 1, nxt);
        const char* nA = has_next ? (const char*)(g.A + (size_t)nxt.g * g.gA) + (size_t)nxt.pm * tstepA : cA; const char* nB = has_next ? (const char*)(g.Bt + (size_t)nxt.g * g.gB) + (size_t)nxt.pn * tstepB : cB;
        for (int t = 0; t < nt; t += 2) {
            const bool last = (t == nt - 2);
            const char* a1 = cA + (size_t)(t + 1) * kstep;
            const char* a2 = last ? nA : cA + (size_t)(t + 2) * kstep; const char* b2 = last ? nB : cB + (size_t)(t + 2) * kstep;
            const char* a3 = a2 + kstep; const char* b3 = b2 + kstep;
            PG8_LDB(B0, 0, 0); PG8_LDB(B1, 0, 1); PG8_SCHED; PG8_LDA(At, 0, 0); PG8_STAGE(PG8_SA(1, 1), a1 + hstepA, voffA);
            PG8_WAIT_V(8); PG8_WAIT_L(0); PG8_BAR; PG8_MMA(0, 0, At, B0); PG8_MMA(0, 1, At, B1); PG8_BAR; PG8_SCHED;
            PG8_LDA(At, 0, 1); PG8_STAGE(PG8_SB(0, 0), b2, voffB); PG8_STAGE(PG8_SB(0, 1), b2 + hstepB, voffB); PG8_STAGE(PG8_SA(0, 0), a2, voffA);
            PG8_WAIT_V(8); PG8_WAIT_L(0); PG8_BAR; PG8_MMA(1, 0, At, B0); PG8_MMA(1, 1, At, B1); PG8_BAR; PG8_SCHED;
            PG8_LDB(B0, 1, 0); PG8_LDB(B1, 1, 1); PG8_SCHED; PG8_LDA(At, 1, 0); PG8_STAGE(PG8_SA(0, 1), a2 + hstepA, voffA);
            PG8_WAIT_V(8); PG8_WAIT_L(0); PG8_BAR; PG8_MMA(0, 0, At, B0); PG8_MMA(0, 1, At, B1); PG8_BAR; PG8_SCHED;
            PG8_LDA(At, 1, 1); PG8_STAGE(PG8_SB(1, 0), b3, voffB); PG8_STAGE(PG8_SB(1, 1), b3 + hstepB, voffB); PG8_STAGE(PG8_SA(1, 0), a3, voffA);
            PG8_WAIT_V(8); PG8_WAIT_L(0); PG8_BAR; PG8_MMA(1, 0, At, B0); PG8_MMA(1, 1, At, B1); PG8_BAR; PG8_SCHED;
        }
        if (wr == 0) PG8_BAR;
        if constexpr (!Epi::AFTER_DRAIN) E(acc, cur, wr, wc, fr, fq);
        if (!has_next) break;
        if constexpr (!Epi::KEEP_ACC) {
#pragma unroll
        for (int a = 0; a < 2; ++a)
#pragma unroll
            for (int b = 0; b < 2; ++b)
#pragma unroll
                for (int m = 0; m < 4; ++m)
#pragma unroll
                    for (int n = 0; n < 2; ++n) acc[a][b][m][n] = (f32x4){0.f, 0.f, 0.f, 0.f};
        }
        cur = nxt; cA = nA; cB = nB; ++ui;
        if (wr == 1) PG8_BAR;
    }
    PG8_WAIT_V(0);
    PG8_BAR;
    if constexpr (Epi::AFTER_DRAIN) E.fused(acc, cur, wr, wc, fr, fq, lds);
#undef PG8_SA
#undef PG8_SB
#undef PG8_STAGE
#undef PG8_LDA
#undef PG8_LDB
#undef PG8_MMA
#undef PG8_WAIT_V
#undef PG8_WAIT_L
#undef PG8_BAR
#undef PG8_SCHED
}

struct EpiF32 {
    static constexpr bool PERM = false, AFTER_DRAIN = false, KEEP_ACC = false;
    float* C; int ldc;
    __device__ __forceinline__ void operator()(const f32x4 (&acc)[2][2][4][2], const Unit& u, int wr, int wc, int fr, int fq) const {
        const int row0 = u.pm * BM + wr * 64 + fr, col0 = u.pn * BM + wc * 32 + 4 * fq;
#pragma unroll
        for (int ai = 0; ai < 2; ++ai)
#pragma unroll
            for (int m = 0; m < 4; ++m) { float* rowp = C + (size_t)(row0 + ai * HALF + m * 16) * ldc + col0;
#pragma unroll
                for (int bj = 0; bj < 2; ++bj)
#pragma unroll
                    for (int n = 0; n < 2; ++n) *(f32x4*)(rowp + bj * HALF + n * 16) = acc[ai][bj][m][n]; }
    }
};
struct EpiSplit {
    static constexpr bool PERM = true, AFTER_DRAIN = false, KEEP_ACC = false;
    bf16_t* O0; int ld0; bf16_t* O1; int ld1; int split; const float* bias1;
    __device__ __forceinline__ void operator()(const f32x4 (&acc)[2][2][4][2], const Unit& u, int wr, int wc, int fr, int fq) const {
        const int row0 = u.pm * BM + wr * 64 + fr;
        const bool second = u.pn >= split;
        bf16_t* base = second ? O1 : O0; const int ld = second ? ld1 : ld0;
        const int col0 = (second ? (u.pn - split) : u.pn) * BM + wc * 32 + 8 * fq;
        const bool sig = second && (bias1 != nullptr);
        f32x4 bv[2][2];
#pragma unroll
        for (int bj = 0; bj < 2; ++bj)
#pragma unroll
            for (int n = 0; n < 2; ++n) bv[bj][n] = sig ? *(const f32x4*)(bias1 + col0 + bj * HALF + 4 * n) : (f32x4){0.f, 0.f, 0.f, 0.f};
#pragma unroll
        for (int ai = 0; ai < 2; ++ai)
#pragma unroll
            for (int m = 0; m < 4; ++m) { bf16_t* rowp = base + (size_t)(row0 + ai * HALF + m * 16) * ld + col0;
#pragma unroll
                for (int bj = 0; bj < 2; ++bj) { f32x4 v0 = acc[ai][bj][m][0] + bv[bj][0], v1 = acc[ai][bj][m][1] + bv[bj][1];
                    if (sig) {
#pragma unroll
                        for (int j = 0; j < 4; ++j) { v0[j] = __builtin_amdgcn_rcpf(1.0f + __expf(-v0[j])); v1[j] = __builtin_amdgcn_rcpf(1.0f + __expf(-v1[j])); } }
                    u32x4 w; w.x = cvt_pk_bf16(v0[0], v0[1]); w.y = cvt_pk_bf16(v0[2], v0[3]); w.z = cvt_pk_bf16(v1[0], v1[1]); w.w = cvt_pk_bf16(v1[2], v1[3]);
                    *(u32x4*)(rowp + bj * HALF) = w; } }
    }
};
struct EpiMerge {
    static constexpr bool PERM = true, AFTER_DRAIN = false, KEEP_ACC = true;
    const bf16_t* GT; bf16_t* MG;
    __device__ __forceinline__ void operator()(f32x4 (&acc)[2][2][4][2], const Unit& u, int wr, int wc, int fr, int fq) const {
        const int row0 = u.pm * BM + wr * 64 + fr, col0 = u.pn * BM + wc * 32 + 8 * fq;
        const bool last = (u.g == 2);
#pragma unroll
        for (int ai = 0; ai < 2; ++ai) {
            u32x4 gw[4][2], gn[4][2];
#pragma unroll
            for (int m = 0; m < 4; ++m)
#pragma unroll
                for (int bj = 0; bj < 2; ++bj) { const size_t row = (size_t)(row0 + ai * HALF + m * 16); const int col = col0 + bj * HALF;
                    gw[m][bj] = *(const u32x4*)(GT + row * GC + u.g * 1024 + col);
                    gn[m][bj] = last ? (u32x4){0x3f803f80u, 0x3f803f80u, 0x3f803f80u, 0x3f803f80u} : *(const u32x4*)(GT + row * GC + (u.g + 1) * 1024 + col); }
#pragma unroll
            for (int m = 0; m < 4; ++m)
#pragma unroll
                for (int bj = 0; bj < 2; ++bj) { const size_t row = (size_t)(row0 + ai * HALF + m * 16); const int col = col0 + bj * HALF;
                    float gf[8], nf[8], v[8]; unpack8(gw[m][bj], gf); unpack8(gn[m][bj], nf);
#pragma unroll
                    for (int j = 0; j < 4; ++j) { v[j] = gf[j] * acc[ai][bj][m][0][j]; v[4 + j] = gf[4 + j] * acc[ai][bj][m][1][j]; }
                    if (last) { *(u32x4*)(MG + row * 1024 + col) = pack8(v); acc[ai][bj][m][0] = (f32x4){0.f, 0.f, 0.f, 0.f}; acc[ai][bj][m][1] = (f32x4){0.f, 0.f, 0.f, 0.f}; }
                    else {
#pragma unroll
                        for (int j = 0; j < 4; ++j) { acc[ai][bj][m][0][j] = v[j] * __builtin_amdgcn_rcpf(fmaxf(nf[j], 1e-30f)); acc[ai][bj][m][1][j] = v[4 + j] * __builtin_amdgcn_rcpf(fmaxf(nf[4 + j], 1e-30f)); } }
                }
        }
    }
};

__device__ __forceinline__ float dpp_row_shr1(float x) { return __int_as_float(__builtin_amdgcn_update_dpp(0, __float_as_int(x), 0x111, 0xf, 0xf, false)); }
__device__ __forceinline__ float dpp_row_shr2(float x) { return __int_as_float(__builtin_amdgcn_update_dpp(0, __float_as_int(x), 0x112, 0xf, 0xf, false)); }
__device__ __forceinline__ float dpp_row_ror1(float x) { return __int_as_float(__builtin_amdgcn_update_dpp(0, __float_as_int(x), 0x121, 0xf, 0xf, false)); }
__device__ __forceinline__ float dpp_row_ror2(float x) { return __int_as_float(__builtin_amdgcn_update_dpp(0, __float_as_int(x), 0x122, 0xf, 0xf, false)); }
__device__ __forceinline__ f32x2 gelu_tanh_mul2(f32x2 gt, f32x2 up) {
    const f32x2 g2 = gt * gt;
    const f32x2 t = gt * (g2 * 0.044715f + 1.0f);
    const f32x2 sx = t * (-2.0f * 0.7978845608028654f * 1.4426950408889634f);
    f32x2 e; e.x = __builtin_amdgcn_exp2f(sx.x); e.y = __builtin_amdgcn_exp2f(sx.y);
    const f32x2 d = e + 1.0f;
    f32x2 r; r.x = __builtin_amdgcn_rcpf(d.x); r.y = __builtin_amdgcn_rcpf(d.y);
    return gt * r * up;
}
__device__ __forceinline__ float gelu_tanh_mul(float gt, float up) {
    const float uu = 0.7978845608028654f * (gt + 0.044715f * gt * gt * gt);
    return gt * __builtin_amdgcn_rcpf(1.0f + __expf(-2.0f * uu)) * up;
}
struct EpiFFN {
    static constexpr bool PERM = true, AFTER_DRAIN = false, KEEP_ACC = false;
    bf16_t* ACT; float* HG; float* HU; const float* cw; const float* cb; LAS unsigned char* xlds;
    __device__ __forceinline__ void operator()(const f32x4 (&acc)[2][2][4][2], const Unit& u, int wr, int wc, int fr, int fq) const {
        const int chl = wc * 32 + 8 * fq, chg = u.pn * 128 + chl;
        LAS float* XG = (LAS float*)xlds;
        if (fr >= 14) {
#pragma unroll
            for (int ai = 0; ai < 2; ++ai) { LAS float* p = XG + ((2 * ai + wr) * 2 + (fr - 14)) * 128 + chl; *(LAS f32x4*)p = acc[ai][0][3][0]; *(LAS f32x4*)(p + 4) = acc[ai][0][3][1]; }
            if (wr == 1) { float* hp = HG + ((size_t)u.pm * 4 + 2 + (fr - 14)) * FF + chg; *(f32x4*)hp = acc[1][0][3][0]; *(f32x4*)(hp + 4) = acc[1][0][3][1]; }
        }
        if (fr < 2 && wr == 0) {
            float* hp = HG + ((size_t)u.pm * 4 + fr) * FF + chg; *(f32x4*)hp = acc[0][0][0][0]; *(f32x4*)(hp + 4) = acc[0][0][0][1];
            float* up = HU + ((size_t)u.pm * 2 + fr) * FF + chg; *(f32x4*)up = acc[0][1][0][0]; *(f32x4*)(up + 4) = acc[0][1][0][1];
        }
        asm volatile("s_waitcnt lgkmcnt(0)" ::: "memory"); __builtin_amdgcn_s_barrier(); asm volatile("" ::: "memory");
        float w0[8], w1[8], w2[8], bb[8];
        { const f32x4 a0 = *(const f32x4*)(cw + chg), a1 = *(const f32x4*)(cw + chg + 4), b0 = *(const f32x4*)(cw + FF + chg), b1 = *(const f32x4*)(cw + FF + chg + 4),
                      c0 = *(const f32x4*)(cw + 2 * FF + chg), c1 = *(const f32x4*)(cw + 2 * FF + chg + 4), d0 = *(const f32x4*)(cb + chg), d1 = *(const f32x4*)(cb + chg + 4);
#pragma unroll
          for (int j = 0; j < 4; ++j) { w0[j] = a0[j]; w0[4 + j] = a1[j]; w1[j] = b0[j]; w1[4 + j] = b1[j]; w2[j] = c0[j]; w2[4 + j] = c1[j]; bb[j] = d0[j]; bb[4 + j] = d1[j]; } }
#pragma unroll
        for (int ai = 0; ai < 2; ++ai)
#pragma unroll
            for (int m = 0; m < 4; ++m) {
                const int B = 2 * ai + wr;
                float g8[8], u8[8], q15[8], q14[8], o[8];
#pragma unroll
                for (int j = 0; j < 4; ++j) { g8[j] = acc[ai][0][m][0][j]; g8[4 + j] = acc[ai][0][m][1][j]; u8[j] = acc[ai][1][m][0][j]; u8[4 + j] = acc[ai][1][m][1][j]; }
                if (m == 0) {
                    if (B > 0) { const LAS float* p = XG + ((B - 1) * 2) * 128 + chl; const f32x4 r0a = *(const LAS f32x4*)p, r0b = *(const LAS f32x4*)(p + 4), r1a = *(const LAS f32x4*)(p + 128), r1b = *(const LAS f32x4*)(p + 132);
#pragma unroll
                        for (int j = 0; j < 4; ++j) { q14[j] = r0a[j]; q14[4 + j] = r0b[j]; q15[j] = r1a[j]; q15[4 + j] = r1b[j]; } }
                    else {
#pragma unroll
                        for (int j = 0; j < 8; ++j) { q14[j] = 0.f; q15[j] = 0.f; } }
                    float p1a[8], p2a[8];
#pragma unroll
                    for (int e = 0; e < 8; ++e) { const float s1 = dpp_row_shr1(g8[e]), s2 = dpp_row_shr2(g8[e]);
                        p1a[e] = (fr >= 1) ? s1 : q15[e]; p2a[e] = (fr >= 2) ? s2 : ((fr == 1) ? q15[e] : q14[e]); }
#pragma unroll
                    for (int e = 0; e < 8; e += 2) { const f32x2 gt = (f32x2){w0[e], w0[e + 1]} * (f32x2){p2a[e], p2a[e + 1]} + (f32x2){w1[e], w1[e + 1]} * (f32x2){p1a[e], p1a[e + 1]} + (f32x2){w2[e], w2[e + 1]} * (f32x2){g8[e], g8[e + 1]} + (f32x2){bb[e], bb[e + 1]};
                        const f32x2 r = gelu_tanh_mul2(gt, (f32x2){u8[e], u8[e + 1]}); o[e] = r.x; o[e + 1] = r.y; }
                } else {
                    float p1a[8], p2a[8];
#pragma unroll
                    for (int e = 0; e < 8; ++e) { const float pv = (e < 4) ? acc[ai][0][m - 1][0][e & 3] : acc[ai][0][m - 1][1][e & 3];
                        const float s1 = dpp_row_shr1(g8[e]), s2 = dpp_row_shr2(g8[e]), r1 = dpp_row_ror1(pv), r2 = dpp_row_ror2(pv);
                        p1a[e] = (fr >= 1) ? s1 : r1; p2a[e] = (fr >= 2) ? s2 : r2; }
#pragma unroll
                    for (int e = 0; e < 8; e += 2) { const f32x2 gt = (f32x2){w0[e], w0[e + 1]} * (f32x2){p2a[e], p2a[e + 1]} + (f32x2){w1[e], w1[e + 1]} * (f32x2){p1a[e], p1a[e + 1]} + (f32x2){w2[e], w2[e + 1]} * (f32x2){g8[e], g8[e + 1]} + (f32x2){bb[e], bb[e + 1]};
                        const f32x2 r = gelu_tanh_mul2(gt, (f32x2){u8[e], u8[e + 1]}); o[e] = r.x; o[e + 1] = r.y; }
                }
                const int rloc = 128 * ai + 64 * wr + 16 * m + fr;
                if (!(B == 0 && m == 0 && fr < 2)) *(u32x4*)(ACT + (size_t)(u.pm * BM + rloc) * FF + chg) = pack8(o);
            }
    }
};

struct EpiNormRes {
    static constexpr bool PERM = false, AFTER_DRAIN = true, KEEP_ACC = false;
    const float* xin; float* xout; bf16_t* H2; const float* g1; const float* g2; unsigned* xs1; unsigned* xs2; unsigned* cnt1; unsigned* cnt2;
    __device__ __forceinline__ void exchange(const f32x4 (&v)[2][2][4][2], const Unit& u, int wr, int wc, int fr, int fq, LAS unsigned char* lds, unsigned* xs, unsigned* cnt) const {
        LAS float* Pp = (LAS float*)lds;
        LAS float* S = (LAS float*)(lds + 4096);
        const int tid = get_tid();
#pragma unroll
        for (int ai = 0; ai < 2; ++ai)
#pragma unroll
            for (int m = 0; m < 4; ++m) { float sq = 0.f;
#pragma unroll
                for (int bj = 0; bj < 2; ++bj)
#pragma unroll
                    for (int n = 0; n < 2; ++n) { const f32x4 x = v[ai][bj][m][n]; sq += (x[0] * x[0] + x[1] * x[1]) + (x[2] * x[2] + x[3] * x[3]); }
                sq += __shfl_xor(sq, 16); sq += __shfl_xor(sq, 32);
                if (fq == 0) Pp[(ai * HALF + wr * 64 + m * 16 + fr) * 4 + wc] = sq; }
        asm volatile("s_waitcnt lgkmcnt(0)" ::: "memory"); __builtin_amdgcn_s_barrier(); asm volatile("" ::: "memory");
        if (tid < 256) { const f32x4 p = *(const LAS f32x4*)(Pp + tid * 4);
            __hip_atomic_store(xs + ((size_t)(u.pm * BM + tid)) * 4 + u.pn, __float_as_uint((p[0] + p[1]) + (p[2] + p[3])), __ATOMIC_RELAXED, __HIP_MEMORY_SCOPE_AGENT); }
        asm volatile("s_waitcnt vmcnt(0)" ::: "memory");
        __syncthreads();
        if (tid == 0) {
            __hip_atomic_fetch_add(cnt + u.pm * 4, 1u, __ATOMIC_RELAXED, __HIP_MEMORY_SCOPE_AGENT);
            unsigned sp = 0u;
            while (__hip_atomic_load(cnt + u.pm * 4, __ATOMIC_RELAXED, __HIP_MEMORY_SCOPE_AGENT) < 4u) { __builtin_amdgcn_s_sleep(1); if (++sp > (1u << 22)) break; }
            __builtin_amdgcn_fence(__ATOMIC_ACQUIRE, "agent");
            asm volatile("s_waitcnt vmcnt(0)" ::: "memory");
        }
        __syncthreads();
        if (tid < 256) { const unsigned* q = xs + ((size_t)(u.pm * BM + tid)) * 4; float t = 0.f;
#pragma unroll
            for (int k = 0; k < 4; ++k) t += __uint_as_float(__hip_atomic_load(q + k, __ATOMIC_RELAXED, __HIP_MEMORY_SCOPE_AGENT));
            S[tid] = rsqrtf(t * (1.0f / 1024.0f) + EPS); }
        asm volatile("s_waitcnt lgkmcnt(0)" ::: "memory"); __syncthreads();
    }
    __device__ __forceinline__ void fused(f32x4 (&acc)[2][2][4][2], const Unit& u, int wr, int wc, int fr, int fq, LAS unsigned char* lds) const {
        const LAS float* S = (const LAS float*)(lds + 4096);
        const int col0 = u.pn * BM + wc * 32 + 4 * fq;
        exchange(acc, u, wr, wc, fr, fq, lds, xs1, cnt1);
        {
            f32x4 gv[2][2];
#pragma unroll
            for (int bj = 0; bj < 2; ++bj)
#pragma unroll
                for (int n = 0; n < 2; ++n) gv[bj][n] = *(const f32x4*)(g1 + col0 + bj * HALF + n * 16);
#pragma unroll
            for (int ai = 0; ai < 2; ++ai) {
                f32x4 xv[4][2][2];
#pragma unroll
                for (int m = 0; m < 4; ++m)
#pragma unroll
                    for (int bj = 0; bj < 2; ++bj)
#pragma unroll
                        for (int n = 0; n < 2; ++n) xv[m][bj][n] = *(const f32x4*)(xin + (size_t)(u.pm * BM + ai * HALF + wr * 64 + m * 16 + fr) * DM + col0 + bj * HALF + n * 16);
#pragma unroll
                for (int m = 0; m < 4; ++m) { const int r = ai * HALF + wr * 64 + m * 16 + fr; const float r1 = S[r];
#pragma unroll
                    for (int bj = 0; bj < 2; ++bj)
#pragma unroll
                        for (int n = 0; n < 2; ++n) { acc[ai][bj][m][n] = xv[m][bj][n] + acc[ai][bj][m][n] * r1 * gv[bj][n];
                            *(f32x4*)(xout + (size_t)(u.pm * BM + r) * DM + col0 + bj * HALF + n * 16) = acc[ai][bj][m][n]; } }
            }
        }
        asm volatile("s_waitcnt lgkmcnt(0)" ::: "memory"); __syncthreads();
        exchange(acc, u, wr, wc, fr, fq, lds, xs2, cnt2);
        {
            f32x4 gv[2][2];
#pragma unroll
            for (int bj = 0; bj < 2; ++bj)
#pragma unroll
                for (int n = 0; n < 2; ++n) gv[bj][n] = *(const f32x4*)(g2 + col0 + bj * HALF + n * 16);
#pragma unroll
            for (int ai = 0; ai < 2; ++ai)
#pragma unroll
                for (int m = 0; m < 4; ++m) { const int r = ai * HALF + wr * 64 + m * 16 + fr; const float r2 = S[r];
#pragma unroll
                    for (int bj = 0; bj < 2; ++bj)
#pragma unroll
                        for (int n = 0; n < 2; ++n) { const f32x4 h = acc[ai][bj][m][n] * r2 * gv[bj][n]; u32x2 w; w.x = cvt_pk_bf16(h[0], h[1]); w.y = cvt_pk_bf16(h[2], h[3]);
                            *(u32x2*)(H2 + (size_t)(u.pm * BM + r) * DM + col0 + bj * HALF + n * 16) = w; } }
        }
        asm volatile("s_waitcnt lgkmcnt(0)" ::: "memory"); __syncthreads();
    }
    __device__ __forceinline__ void operator()(const f32x4 (&)[2][2][4][2], const Unit&, int, int, int, int) const {}
};
}

__device__ __forceinline__ void transpose_tile(const float* src, int ld, int k0, int n0s, bf16_t* dst, int dk, int n0d, LAS float* tile) {
    const int tid = get_tid();
    { const int r = tid >> 4, c4 = (tid & 15) * 4;
#pragma unroll
      for (int i = 0; i < 2; ++i) { const f32x4 v = *(const f32x4*)(src + (size_t)(k0 + r + 32 * i) * ld + n0s + c4);
          LAS float* t = tile + (r + 32 * i) * 65 + c4; t[0] = v[0]; t[1] = v[1]; t[2] = v[2]; t[3] = v[3]; } }
    __syncthreads();
    { const int n = tid >> 3, ks = (tid & 7) * 8; float e[8];
#pragma unroll
      for (int j = 0; j < 8; ++j) e[j] = tile[(ks + j) * 65 + n];
      *(u32x4*)(dst + (size_t)(n0d + n) * dk + k0 + ks) = pack8(e); }
    __syncthreads();
}

__device__ void phase_convert(const Params& P, int l, LAS unsigned char* lds) {
    LAS float* tile = (LAS float*)lds;
    unsigned char* ws = P.ws;
    bf16_t* W1 = (bf16_t*)(ws + WS_W1); bf16_t* WBR = (bf16_t*)(ws + WS_WBR); bf16_t* WMO = (bf16_t*)(ws + WS_WMO); bf16_t* WFF = (bf16_t*)(ws + WS_WFF); bf16_t* WD = (bf16_t*)(ws + WS_WD);
    const float* win = P.w_in + (size_t)l * 1024 * IN_COLS;
#define SEG(src, ld, ktiles, ntiles, n0s, dst, dk, n0d) if (r < (ktiles) * (ntiles)) { const int kt = r / (ntiles), ntl = r % (ntiles); transpose_tile(src, ld, kt * 64, (n0s) + ntl * 64, dst, dk, (n0d) + ntl * 64, tile); continue; } r -= (ktiles) * (ntiles);
    constexpr int total = 16 * 120 + 16 * 48 + 3 * 8 * 16 + 16 * 16 + 16 * 44 + 16 * 44 + 44 * 16;
    for (int it = blockIdx.x; it < total; it += gridDim.x) {
        int r = it;
        SEG(win, IN_COLS, 16, 8, 0, W1, 1024, ZQ)
        SEG(win, IN_COLS, 16, 8, 512, W1, 1024, ZV)
        SEG(win, IN_COLS, 16, 8, 1024, W1, 1024, ZG)
        SEG(win, IN_COLS, 16, 8, 1552, W1, 1024, ZSB)
        SEG(win, IN_COLS, 16, 8, 2064, W1, 1024, ZSC)
        SEG(win, IN_COLS, 16, 8, 2576, W1, 1024, ZSX)
        SEG(win, IN_COLS, 16, 72, 3088, W1, 1024, ZDQ)
        SEG(P.w_gate + (size_t)l * 1024 * 3072, 3072, 16, 48, 0, W1, 1024, 7680)
        SEG(P.w_branch + ((size_t)l * 3 + 0) * 512 * 1024, 1024, 8, 16, 0, WBR, 512, 0)
        SEG(P.w_branch + ((size_t)l * 3 + 1) * 512 * 1024, 1024, 8, 16, 0, WBR + (size_t)1024 * 512, 512, 0)
        SEG(P.w_branch + ((size_t)l * 3 + 2) * 512 * 1024, 1024, 8, 16, 0, WBR + (size_t)2 * 1024 * 512, 512, 0)
        SEG(P.w_mix_out + (size_t)l * 1024 * 1024, 1024, 16, 16, 0, WMO, 1024, 0)
        if (r < 16 * 44) { const int kt = r / 44, ntl = r % 44; transpose_tile(P.w_ff_gate + (size_t)l * 1024 * FF, FF, kt * 64, ntl * 64, WFF, 1024, 256 * (ntl >> 1) + 64 * (ntl & 1), tile); continue; } r -= 16 * 44;
        if (r < 16 * 44) { const int kt = r / 44, ntl = r % 44; transpose_tile(P.w_ff_up + (size_t)l * 1024 * FF, FF, kt * 64, ntl * 64, WFF, 1024, 256 * (ntl >> 1) + 128 + 64 * (ntl & 1), tile); continue; } r -= 16 * 44;
        SEG(P.w_ff_down + (size_t)l * FF * 1024, 1024, 44, 16, 0, WD, FF, 0)
    }
#undef SEG
    { const int t = get_tid();
      if (l == 0 && blockIdx.x == 0 && t < 64) ((float*)(ws + WS_RC))[t] = exp2f(-(float)t * (13.287712379549449f / 64.0f)) * 0.15915494309189535f; }
}

__device__ __forceinline__ float wave_sum(float v) {
#pragma unroll
    for (int o = 32; o >= 1; o >>= 1) v += __shfl_xor(v, o);
    return v;
}

__device__ void phase_norm_alow(const Params& P, int l, int half, LAS unsigned char* lds) {
    const int tid = get_tid(), lane = tid & 63, wave = tid >> 6;
    LAS float* WaT = (LAS float*)lds;
    const float* win = P.w_in + (size_t)l * 1024 * IN_COLS + 1536;
    for (int i = tid; i < 1024 * 4; i += NTHR) { const int k = i >> 2, c4 = (i & 3) * 4; const f32x4 v = *(const f32x4*)(win + (size_t)k * IN_COLS + c4);
        WaT[(c4 + 0) * 1024 + k] = v[0]; WaT[(c4 + 1) * 1024 + k] = v[1]; WaT[(c4 + 2) * 1024 + k] = v[2]; WaT[(c4 + 3) * 1024 + k] = v[3]; }
    __syncthreads();
    const float* xs = (l == 0 ? P.x : P.out) + (size_t)half * TH * DM;
    const float* gg = P.pre_mix_g + (size_t)l * DM;
    bf16_t* H = (bf16_t*)(P.ws + WS_H) + (size_t)half * TH * DM; float* AL = (float*)(P.ws + WS_ALOW);
    f32x4 gv[4];
#pragma unroll
    for (int i = 0; i < 4; ++i) gv[i] = *(const f32x4*)(gg + i * 256 + lane * 4);
    const int rstride = gridDim.x * 8;
    int row = blockIdx.x * 8 + wave;
    f32x4 nv[4];
    if (row < TH) {
#pragma unroll
        for (int i = 0; i < 4; ++i) nv[i] = *(const f32x4*)(xs + (size_t)row * DM + i * 256 + lane * 4);
    }
    for (; row < TH; row += rstride) {
        f32x4 v[4]; float ss = 0.f;
#pragma unroll
        for (int i = 0; i < 4; ++i) { v[i] = nv[i]; ss += v[i][0] * v[i][0] + v[i][1] * v[i][1] + v[i][2] * v[i][2] + v[i][3] * v[i][3]; }
        if (row + rstride < TH) {
#pragma unroll
            for (int i = 0; i < 4; ++i) nv[i] = *(const f32x4*)(xs + (size_t)(row + rstride) * DM + i * 256 + lane * 4);
        }
        ss = wave_sum(ss);
        const float r = rsqrtf(ss * (1.0f / DM) + EPS);
        float a[16];
#pragma unroll
        for (int c = 0; c < 16; ++c) a[c] = 0.f;
#pragma unroll
        for (int i = 0; i < 4; ++i) { f32x4 h = v[i] * r * gv[i];
            u32x2 w; w.x = cvt_pk_bf16(h[0], h[1]); w.y = cvt_pk_bf16(h[2], h[3]);
            *(u32x2*)(H + (size_t)row * DM + i * 256 + lane * 4) = w;
#pragma unroll
            for (int c = 0; c < 16; ++c) { const f32x4 wv = *(const LAS f32x4*)(WaT + c * 1024 + i * 256 + lane * 4); a[c] += h[0] * wv[0] + h[1] * wv[1] + h[2] * wv[2] + h[3] * wv[3]; } }
        float b8[8], b4[4], b2[2], b1;
        { const bool up = (lane & 32) != 0;
#pragma unroll
          for (int c = 0; c < 8; ++c) { const float keep = up ? a[c + 8] : a[c], send = up ? a[c] : a[c + 8]; b8[c] = keep + __shfl_xor(send, 32); } }
        { const bool up = (lane & 16) != 0;
#pragma unroll
          for (int c = 0; c < 4; ++c) { const float keep = up ? b8[c + 4] : b8[c], send = up ? b8[c] : b8[c + 4]; b4[c] = keep + __shfl_xor(send, 16); } }
        { const bool up = (lane & 8) != 0;
#pragma unroll
          for (int c = 0; c < 2; ++c) { const float keep = up ? b4[c + 2] : b4[c], send = up ? b4[c] : b4[c + 2]; b2[c] = keep + __shfl_xor(send, 8); } }
        { const bool up = (lane & 4) != 0; const float keep = up ? b2[1] : b2[0], send = up ? b2[0] : b2[1]; b1 = keep + __shfl_xor(send, 4); }
        b1 += __shfl_xor(b1, 2); b1 += __shfl_xor(b1, 1);
        if ((lane & 3) == 0) { const int co = ((lane >> 5) & 1) * 8 + ((lane >> 4) & 1) * 4 + ((lane >> 3) & 1) * 2 + ((lane >> 2) & 1); AL[(size_t)row * 16 + co] = b1; }
    }
}

__device__ void phase_resid(const float* xin, float* xout, const bf16_t* Y, const float* pg, const float* ng, bf16_t* H2, int nrows) {
    const int tid = get_tid(), lane = tid & 63, wave = tid >> 6;
    f32x4 pgv[4], ngv[4];
#pragma unroll
    for (int i = 0; i < 4; ++i) { pgv[i] = *(const f32x4*)(pg + i * 256 + lane * 4); ngv[i] = ng ? *(const f32x4*)(ng + i * 256 + lane * 4) : (f32x4){0.f, 0.f, 0.f, 0.f}; }
    const int stride = gridDim.x * 8;
    int row = blockIdx.x * 8 + wave;
    u32x2 ny[4]; f32x4 nx[4];
    if (row < nrows) {
#pragma unroll
        for (int i = 0; i < 4; ++i) { ny[i] = *(const u32x2*)(Y + (size_t)row * DM + i * 256 + lane * 4); nx[i] = *(const f32x4*)(xin + (size_t)row * DM + i * 256 + lane * 4); }
    }
    for (; row < nrows; row += stride) {
        f32x4 y[4], xv[4];
#pragma unroll
        for (int i = 0; i < 4; ++i) { y[i] = (f32x4){bflo(ny[i].x), bfhi(ny[i].x), bflo(ny[i].y), bfhi(ny[i].y)}; xv[i] = nx[i]; }
        const int rn = row + stride;
        if (rn < nrows) {
#pragma unroll
            for (int i = 0; i < 4; ++i) { ny[i] = *(const u32x2*)(Y + (size_t)rn * DM + i * 256 + lane * 4); nx[i] = *(const f32x4*)(xin + (size_t)rn * DM + i * 256 + lane * 4); }
        }
        float ss = 0.f;
#pragma unroll
        for (int i = 0; i < 4; ++i) ss += y[i][0] * y[i][0] + y[i][1] * y[i][1] + y[i][2] * y[i][2] + y[i][3] * y[i][3];
        ss = wave_sum(ss);
        const float r = rsqrtf(ss * (1.0f / DM) + EPS);
        float s2 = 0.f;
#pragma unroll
        for (int i = 0; i < 4; ++i) { xv[i] = xv[i] + y[i] * r * pgv[i]; *(f32x4*)(xout + (size_t)row * DM + i * 256 + lane * 4) = xv[i];
            s2 += xv[i][0] * xv[i][0] + xv[i][1] * xv[i][1] + xv[i][2] * xv[i][2] + xv[i][3] * xv[i][3]; }
        if (ng) {
            s2 = wave_sum(s2);
            const float r2 = rsqrtf(s2 * (1.0f / DM) + EPS);
#pragma unroll
            for (int i = 0; i < 4; ++i) { const f32x4 h = xv[i] * r2 * ngv[i]; u32x2 w; w.x = cvt_pk_bf16(h[0], h[1]); w.y = cvt_pk_bf16(h[2], h[3]);
                *(u32x2*)(H2 + (size_t)row * DM + i * 256 + lane * 4) = w; }
        }
    }
}

__device__ void phase_combine(const Params& P) {
    bf16_t* Z = (bf16_t*)(P.ws + WS_Z); const float* LSE = (const float*)(P.ws + WS_LSE);
    const int stride = gridDim.x * NTHR;
    for (int idx0 = blockIdx.x * NTHR + get_tid(); idx0 < TH * 64; idx0 += 2 * stride) {
        float lw[2][3]; u32x4 va[2], vb[2], vc[2]; bf16_t* pp[2]; bool ok[2];
#pragma unroll
        for (int k = 0; k < 2; ++k) { const int idx = idx0 + k * stride; ok[k] = idx < TH * 64; const int id2 = ok[k] ? idx : idx0;
            const int tok = id2 >> 6, c8 = id2 & 63, hh = c8 >> 4, d0 = (c8 & 15) * 8;
            lw[k][0] = LSE[tok * 12 + hh]; lw[k][1] = LSE[tok * 12 + 4 + hh]; lw[k][2] = LSE[tok * 12 + 8 + hh];
            pp[k] = Z + (size_t)tok * ZC + ZDQ + hh * 128 + d0;
            va[k] = *(const u32x4*)pp[k]; vb[k] = *(const u32x4*)(pp[k] + 512); vc[k] = *(const u32x4*)(pp[k] + 1024); }
#pragma unroll
        for (int k = 0; k < 2; ++k) {
            const float mx = fmaxf(lw[k][0], fmaxf(lw[k][1], lw[k][2]));
            float w0 = __expf(lw[k][0] - mx), w1 = __expf(lw[k][1] - mx), w2 = __expf(lw[k][2] - mx);
            const float inv = 1.0f / (w0 + w1 + w2); w0 *= inv; w1 *= inv; w2 *= inv;
            float a[8], b[8], c[8], o[8];
            unpack8(va[k], a); unpack8(vb[k], b); unpack8(vc[k], c);
#pragma unroll
            for (int j = 0; j < 8; ++j) o[j] = w0 * a[j] + w1 * b[j] + w2 * c[j];
            if (ok[k]) *(u32x4*)pp[k] = pack8(o);
        }
    }
}

__device__ void phase_ffn_fix(const Params& P, int l) {
    bf16_t* ACT = (bf16_t*)(P.ws + WS_U); const float* HG = (const float*)(P.ws + WS_HG); const float* HU = (const float*)(P.ws + WS_HU);
    const float* cw = P.ff_conv_w + (size_t)l * 3 * FF; const float* cb = P.ff_conv_b + (size_t)l * FF;
    for (int idx = blockIdx.x * NTHR + get_tid(); idx < 128 * (FF / 8); idx += gridDim.x * NTHR) {
        const int pm = idx / (FF / 8), c0 = (idx % (FF / 8)) * 8;
        float o0[8], o1[8];
#pragma unroll
        for (int hf = 0; hf < 2; ++hf) {
            const int c = c0 + 4 * hf;
            const f32x4 z = (f32x4){0.f, 0.f, 0.f, 0.f};
            const bool first = (pm & 7) == 0;
            const f32x4 gm2 = first ? z : *(const f32x4*)(HG + ((size_t)(pm - 1) * 4 + 2) * FF + c), gm1 = first ? z : *(const f32x4*)(HG + ((size_t)(pm - 1) * 4 + 3) * FF + c);
            const f32x4 g0 = *(const f32x4*)(HG + ((size_t)pm * 4 + 0) * FF + c), g1 = *(const f32x4*)(HG + ((size_t)pm * 4 + 1) * FF + c);
            const f32x4 u0 = *(const f32x4*)(HU + ((size_t)pm * 2 + 0) * FF + c), u1 = *(const f32x4*)(HU + ((size_t)pm * 2 + 1) * FF + c);
            const f32x4 w0 = *(const f32x4*)(cw + c), w1 = *(const f32x4*)(cw + FF + c), w2 = *(const f32x4*)(cw + 2 * FF + c), bb = *(const f32x4*)(cb + c);
#pragma unroll
            for (int j = 0; j < 4; ++j) { o0[4 * hf + j] = pg8::gelu_tanh_mul(w0[j] * gm2[j] + w1[j] * gm1[j] + w2[j] * g0[j] + bb[j], u0[j]);
                                          o1[4 * hf + j] = pg8::gelu_tanh_mul(w0[j] * gm1[j] + w1[j] * g0[j] + w2[j] * g1[j] + bb[j], u1[j]); }
        }
        *(u32x4*)(ACT + (size_t)(pm * 256 + 0) * FF + c0) = pack8(o0);
        *(u32x4*)(ACT + (size_t)(pm * 256 + 1) * FF + c0) = pack8(o1);
    }
}

__device__ __forceinline__ void sc_item(const Params& P, int l, int si) {
    bf16_t* Z = (bf16_t*)(P.ws + WS_Z);
    const int tid = get_tid(), cgi = tid & 63, run = tid >> 6, c0 = cgi * 8, t0 = si * 128 + run * 16;
    const float* cw = P.sc_conv_w + (size_t)l * 3 * 512;
    float w0[8], w1[8], w2[8];
#pragma unroll
    for (int j = 0; j < 8; ++j) { w0[j] = cw[c0 + j]; w1[j] = cw[512 + c0 + j]; w2[j] = cw[1024 + c0 + j]; }
    float p1[8], p2[8];
    if ((t0 & 2047) != 0) {
        float a[8], b[8];
        unpack8(*(const u32x4*)(Z + (size_t)(t0 - 1) * ZC + ZSC + c0), a); unpack8(*(const u32x4*)(Z + (size_t)(t0 - 1) * ZC + ZSX + c0), b);
#pragma unroll
        for (int j = 0; j < 8; ++j) p1[j] = a[j] * b[j];
        unpack8(*(const u32x4*)(Z + (size_t)(t0 - 2) * ZC + ZSC + c0), a); unpack8(*(const u32x4*)(Z + (size_t)(t0 - 2) * ZC + ZSX + c0), b);
#pragma unroll
        for (int j = 0; j < 8; ++j) p2[j] = a[j] * b[j];
    } else {
#pragma unroll
        for (int j = 0; j < 8; ++j) { p1[j] = 0.f; p2[j] = 0.f; } }
    for (int tt = 0; tt < 16; tt += 4) {
        u32x4 va[4], vb[4], vs[4];
#pragma unroll
        for (int k = 0; k < 4; ++k) { const bf16_t* zr = Z + (size_t)(t0 + tt + k) * ZC; va[k] = *(const u32x4*)(zr + ZSC + c0); vb[k] = *(const u32x4*)(zr + ZSX + c0); vs[k] = *(const u32x4*)(zr + ZSB + c0); }
#pragma unroll
        for (int k = 0; k < 4; ++k) {
            float a[8], b[8], sb[8], o[8];
            unpack8(va[k], a); unpack8(vb[k], b); unpack8(vs[k], sb);
#pragma unroll
            for (int j = 0; j < 8; ++j) { const float p0 = a[j] * b[j]; o[j] = sb[j] * (w0[j] * p2[j] + w1[j] * p1[j] + w2[j] * p0); p2[j] = p1[j]; p1[j] = p0; }
            *(u32x4*)(Z + (size_t)(t0 + tt + k) * ZC + ZSB + c0) = pack8(o);
        }
    }
}

__device__ __forceinline__ void attn_item(const Params& P, int half, int item, LAS unsigned char* lds, unsigned* ctr) {
    const int tid = get_tid(), lane = tid & 63, w = __builtin_amdgcn_readfirstlane(tid >> 6), g = lane >> 4, c = lane & 15;
    const int b = item / 192, rem = item % 192, gi = rem / 64, r2 = rem % 64;
    const int dil = (gi == 0) ? 1 : (gi == 1 ? 4 : 16), nb = 16 / dil;
    const int n = r2 % nb, t2 = r2 / nb, hh = t2 & 3, rr = t2 >> 2;
    bf16_t* Z = (bf16_t*)(P.ws + WS_Z);
    const float* RC = (const float*)(P.ws + WS_RC); const float* RS = (const float*)(P.ws + WS_RS);
    float* LSE = (float*)(P.ws + WS_LSE);
    const int colq = ZDQ + gi * 512 + hh * 128, colk = ZDK + gi * 512 + hh * 128, colv = ZDV + gi * 512 + hh * 128;
    const int rowb = b * 2048, gtb = half * TH;
    constexpr int KSTR = 272, VSTR = 528;
    LAS unsigned char* Ks = lds; LAS unsigned char* Vt = lds + 256 * KSTR;
    constexpr float QSCALE = 0.08838834764831845f * 1.4426950408889634f;

    const int km = tid >> 1, khf = tid & 1, klk = (n - 1) * 128 + km;
    const int vkb = tid & 31, vdb = tid >> 5, vlk0 = (n - 1) * 128 + vkb * 8;
    const int qi = 16 * w + c, qrow = rowb + (n * 128 + qi) * dil + rr;
    u32x4 kx1[4], kx2[4]; f32x4 kinv[8]; float kpos = 0.f;
    u32x4 rv[8];
    u32x4 qx1[2], qx2[2]; f32x4 qinv[4]; float qpos;
    if (klk >= 0) {
        const int krow = rowb + klk * dil + rr;
        const bf16_t* kp = Z + (size_t)krow * ZC + colk + khf * 32;
        kpos = (float)P.pos[gtb + krow];
#pragma unroll
        for (int cc = 0; cc < 4; ++cc) { kx1[cc] = *(const u32x4*)(kp + cc * 8); kx2[cc] = *(const u32x4*)(kp + 64 + cc * 8);
            kinv[2 * cc] = *(const f32x4*)(RC + khf * 32 + cc * 8); kinv[2 * cc + 1] = *(const f32x4*)(RC + khf * 32 + cc * 8 + 4); }
    } else {
#pragma unroll
        for (int cc = 0; cc < 4; ++cc) { kx1[cc] = (u32x4){0u, 0u, 0u, 0u}; kx2[cc] = (u32x4){0u, 0u, 0u, 0u};
            kinv[2 * cc] = (f32x4){0.f, 0.f, 0.f, 0.f}; kinv[2 * cc + 1] = (f32x4){0.f, 0.f, 0.f, 0.f}; }
    }
    if (vlk0 >= 0) {
#pragma unroll
        for (int kk = 0; kk < 8; ++kk) { const int row = rowb + (vlk0 + kk) * dil + rr; rv[kk] = *(const u32x4*)(Z + (size_t)row * ZC + colv + vdb * 8); }
    } else {
#pragma unroll
        for (int kk = 0; kk < 8; ++kk) rv[kk] = (u32x4){0u, 0u, 0u, 0u};
    }
    {
        const bf16_t* qp = Z + (size_t)qrow * ZC + colq + 8 * g;
        qpos = (float)P.pos[gtb + qrow];
#pragma unroll
        for (int kh = 0; kh < 2; ++kh) { qx1[kh] = *(const u32x4*)(qp + kh * 32); qx2[kh] = *(const u32x4*)(qp + 64 + kh * 32);
            qinv[2 * kh] = *(const f32x4*)(RC + kh * 32 + 8 * g); qinv[2 * kh + 1] = *(const f32x4*)(RC + kh * 32 + 8 * g + 4); }
    }
    {
        LAS unsigned char* kd = Ks + km * KSTR;
#pragma unroll
        for (int cc = 0; cc < 4; ++cc) {
            float x1[8], x2[8], o1[8], o2[8];
            unpack8(kx1[cc], x1); unpack8(kx2[cc], x2);
            f32x4 c0, c1, s0, s1;
#pragma unroll
            for (int j = 0; j < 4; ++j) { const float r0 = __builtin_amdgcn_fractf(kpos * kinv[2 * cc][j]), r1 = __builtin_amdgcn_fractf(kpos * kinv[2 * cc + 1][j]);
                c0[j] = __builtin_amdgcn_cosf(r0); s0[j] = __builtin_amdgcn_sinf(r0); c1[j] = __builtin_amdgcn_cosf(r1); s1[j] = __builtin_amdgcn_sinf(r1); }
#pragma unroll
            for (int j = 0; j < 4; j += 2) {
                { const f32x2 X1 = (f32x2){x1[j], x1[j + 1]}, X2 = (f32x2){x2[j], x2[j + 1]}, C = (f32x2){c0[j], c0[j + 1]}, Sn = (f32x2){s0[j], s0[j + 1]};
                  const f32x2 A = X1 * C - X2 * Sn, B = X2 * C + X1 * Sn; o1[j] = A.x; o1[j + 1] = A.y; o2[j] = B.x; o2[j + 1] = B.y; }
                { const f32x2 X1 = (f32x2){x1[4 + j], x1[5 + j]}, X2 = (f32x2){x2[4 + j], x2[5 + j]}, C = (f32x2){c1[j], c1[j + 1]}, Sn = (f32x2){s1[j], s1[j + 1]};
                  const f32x2 A = X1 * C - X2 * Sn, B = X2 * C + X1 * Sn; o1[4 + j] = A.x; o1[5 + j] = A.y; o2[4 + j] = B.x; o2[5 + j] = B.y; } }
            *(LAS u32x4*)(kd + (khf * 32 + cc * 8) * 2) = pack8(o1); *(LAS u32x4*)(kd + (64 + khf * 32 + cc * 8) * 2) = pack8(o2);
        }
    }
    {
#pragma unroll
        for (int dd = 0; dd < 8; ++dd) {
            const int wi = dd >> 1; u32x4 o;
            if (dd & 1) { o.x = __builtin_amdgcn_perm(rv[1][wi], rv[0][wi], 0x07060302u); o.y = __builtin_amdgcn_perm(rv[3][wi], rv[2][wi], 0x07060302u); o.z = __builtin_amdgcn_perm(rv[5][wi], rv[4][wi], 0x07060302u); o.w = __builtin_amdgcn_perm(rv[7][wi], rv[6][wi], 0x07060302u); }
            else { o.x = __builtin_amdgcn_perm(rv[1][wi], rv[0][wi], 0x05040100u); o.y = __builtin_amdgcn_perm(rv[3][wi], rv[2][wi], 0x05040100u); o.z = __builtin_amdgcn_perm(rv[5][wi], rv[4][wi], 0x05040100u); o.w = __builtin_amdgcn_perm(rv[7][wi], rv[6][wi], 0x05040100u); }
            *(LAS u32x4*)(Vt + (vdb * 8 + dd) * VSTR + vkb * 16) = o;
        }
    }
    bf16x8 Qf[4];
    {
#pragma unroll
        for (int kh = 0; kh < 2; ++kh) {
            float x1[8], x2[8], o1[8], o2[8];
            unpack8(qx1[kh], x1); unpack8(qx2[kh], x2);
            f32x4 c0, c1, s0, s1;
#pragma unroll
            for (int j = 0; j < 4; ++j) { const float r0 = __builtin_amdgcn_fractf(qpos * qinv[2 * kh][j]), r1 = __builtin_amdgcn_fractf(qpos * qinv[2 * kh + 1][j]);
                c0[j] = __builtin_amdgcn_cosf(r0); s0[j] = __builtin_amdgcn_sinf(r0); c1[j] = __builtin_amdgcn_cosf(r1); s1[j] = __builtin_amdgcn_sinf(r1); }
#pragma unroll
            for (int j = 0; j < 4; j += 2) {
                { const f32x2 X1 = (f32x2){x1[j], x1[j + 1]} * QSCALE, X2 = (f32x2){x2[j], x2[j + 1]} * QSCALE, C = (f32x2){c0[j], c0[j + 1]}, Sn = (f32x2){s0[j], s0[j + 1]};
                  const f32x2 A = X1 * C - X2 * Sn, B = X2 * C + X1 * Sn; o1[j] = A.x; o1[j + 1] = A.y; o2[j] = B.x; o2[j + 1] = B.y; }
                { const f32x2 X1 = (f32x2){x1[4 + j], x1[5 + j]} * QSCALE, X2 = (f32x2){x2[4 + j], x2[5 + j]} * QSCALE, C = (f32x2){c1[j], c1[j + 1]}, Sn = (f32x2){s1[j], s1[j + 1]};
                  const f32x2 A = X1 * C - X2 * Sn, B = X2 * C + X1 * Sn; o1[4 + j] = A.x; o1[5 + j] = A.y; o2[4 + j] = B.x; o2[5 + j] = B.y; } }
            Qf[kh] = as_bf16x8(pack8(o1)); Qf[kh + 2] = as_bf16x8(pack8(o2));
        }
    }
    __syncthreads();
    unsigned nxt_id = 0u;
    if (tid == 0) nxt_id = atomicAdd(ctr, 1u);
    const int m0 = (16 * w < 96) ? 16 * w : 96;
    f32x4 S[10];
#pragma unroll
    for (int jt = 0; jt < 10; ++jt) {
        S[jt] = (f32x4){0.f, 0.f, 0.f, 0.f};
        const LAS unsigned char* kr = Ks + (m0 + jt * 16 + c) * KSTR + 16 * g;
#pragma unroll
        for (int ks = 0; ks < 4; ++ks) { const bf16x8 a = *(const LAS bf16x8*)(kr + ks * 64); S[jt] = __builtin_amdgcn_mfma_f32_16x16x32_bf16(a, Qf[ks], S[jt], 0, 0, 0); }
    }
    float mx = -INFINITY;
    const int dbase = qi + 128 - m0 - 4 * g;
    const unsigned dlim = (unsigned)((n == 0) ? (qi < 128 ? qi : 128) : 128);
#pragma unroll
    for (int jt = 0; jt < 10; ++jt)
#pragma unroll
        for (int jj = 0; jj < 4; ++jj) { const bool ok = (unsigned)(dbase - (jt * 16 + jj)) <= dlim;
            const float s = ok ? S[jt][jj] : -INFINITY; S[jt][jj] = s; mx = fmaxf(mx, s); }
    mx = fmaxf(mx, __shfl_xor(mx, 16)); mx = fmaxf(mx, __shfl_xor(mx, 32));
    float den = 0.f;
#pragma unroll
    for (int jt = 0; jt < 10; ++jt) { const f32x4 d = S[jt] - mx; f32x4 p; p[0] = __builtin_amdgcn_exp2f(d[0]); p[1] = __builtin_amdgcn_exp2f(d[1]); p[2] = __builtin_amdgcn_exp2f(d[2]); p[3] = __builtin_amdgcn_exp2f(d[3]);
        S[jt] = p; den += (p[0] + p[1]) + (p[2] + p[3]); }
    den += __shfl_xor(den, 16); den += __shfl_xor(den, 32);
    bf16x8 Pf[5];
#pragma unroll
    for (int k5 = 0; k5 < 5; ++k5) { u32x4 pw; pw.x = cvt_pk_bf16(S[2 * k5][0], S[2 * k5][1]); pw.y = cvt_pk_bf16(S[2 * k5][2], S[2 * k5][3]); pw.z = cvt_pk_bf16(S[2 * k5 + 1][0], S[2 * k5 + 1][1]); pw.w = cvt_pk_bf16(S[2 * k5 + 1][2], S[2 * k5 + 1][3]); Pf[k5] = as_bf16x8(pw); }
    const float inv = 1.0f / den;
    bf16_t* op = Z + (size_t)qrow * ZC + colq + 4 * g;
#pragma unroll
    for (int dt = 0; dt < 8; ++dt) {
        f32x4 O = (f32x4){0.f, 0.f, 0.f, 0.f};
        const LAS unsigned char* vr = Vt + (dt * 16 + c) * VSTR + (m0 + 4 * g) * 2;
#pragma unroll
        for (int k5 = 0; k5 < 5; ++k5) { const u32x2 lo = *(const LAS u32x2*)(vr + k5 * 64), hi = *(const LAS u32x2*)(vr + k5 * 64 + 32);
            const bf16x8 a = as_bf16x8((u32x4){lo.x, lo.y, hi.x, hi.y}); O = __builtin_amdgcn_mfma_f32_16x16x32_bf16(a, Pf[k5], O, 0, 0, 0); }
        u32x2 ow; ow.x = cvt_pk_bf16(O[0] * inv, O[1] * inv); ow.y = cvt_pk_bf16(O[2] * inv, O[3] * inv);
        *(u32x2*)(op + dt * 16) = ow;
    }
    if (g == 0) LSE[(size_t)qrow * 12 + gi * 4 + hh] = (mx + __builtin_amdgcn_logf(den)) * 0.6931471805599453f;
    if (tid == 0) *(LAS unsigned*)(lds + LDS_SLOT) = nxt_id;
    __syncthreads();
}

__device__ __forceinline__ float logsig16(float x) { return (fminf(x, 0.f) - __logf(1.0f + __expf(-fabsf(x)))) * (1.0f / 16.0f); }

#define LBAR() do { asm volatile("s_waitcnt lgkmcnt(0)" ::: "memory"); __builtin_amdgcn_s_barrier(); asm volatile("" ::: "memory"); } while (0)
__device__ void gla_item(const Params& P, int l, int b, int h, int seg, LAS unsigned char* lds) {
    const int tid = get_tid(), lane = tid & 63, w = __builtin_amdgcn_readfirstlane(tid >> 6), g = lane >> 4, c = lane & 15;
    bf16_t* Z = (bf16_t*)(P.ws + WS_Z); const float* AL = (const float*)(P.ws + WS_ALOW);
    LAS float* WUP = (LAS float*)(lds + 0);
    LAS float* BUP = (LAS float*)(lds + 4096);
    LAS float* ARAW = (LAS float*)(lds + 4352);
    LAS float* LC = (LAS float*)(lds + 8448);
    LAS float* SEG = (LAS float*)(lds + 24832);
    LAS float* DEC = (LAS float*)(lds + 26880);
    LAS unsigned char* QP = lds + 29184;
    LAS unsigned char* KP = lds + 38400;
    LAS unsigned char* KPP = lds + 47616;
    LAS unsigned char* AIN = lds + 56832;
    LAS unsigned char* VS = lds + 66048;
    LAS unsigned char* OT = lds + 83456;
    constexpr int QS = 144, VSS = 272;
    for (int i = tid; i < 1024; i += NTHR) { const int r = i >> 6, d = i & 63; WUP[i] = P.w_alpha_up[((size_t)l * 16 + r) * 256 + h * 64 + d]; }
    if (tid < 64) BUP[tid] = P.b_alpha[(size_t)l * 256 + h * 64 + tid];
    f32x4 Sacc[4];
#pragma unroll
    for (int dt = 0; dt < 4; ++dt) Sacc[dt] = (f32x4){0.f, 0.f, 0.f, 0.f};
    const int rowb = b * 2048 + seg * 256;
    const int t_ = tid >> 3, d8 = (tid & 7) * 8;
    u32x4 nq, nk, nv0, nv1; f32x4 na = (f32x4){0.f, 0.f, 0.f, 0.f};
    {
        const size_t r0 = (size_t)(rowb + t_) * ZC;
        nq = *(const u32x4*)(Z + r0 + ZQ + h * 64 + d8); nk = *(const u32x4*)(Z + r0 + ZK + h * 64 + d8);
        nv0 = *(const u32x4*)(Z + (size_t)(rowb + (tid >> 4)) * ZC + ZV + h * 128 + (tid & 15) * 8);
        nv1 = *(const u32x4*)(Z + (size_t)(rowb + 32 + (tid >> 4)) * ZC + ZV + h * 128 + (tid & 15) * 8);
        if (tid < 256) na = *(const f32x4*)(AL + (size_t)(rowb + (tid >> 2)) * 16 + (tid & 3) * 4);
    }
    float Lseg[8];
#pragma unroll
    for (int j = 0; j < 8; ++j) Lseg[j] = 0.f;
    float* DSEG = (float*)(P.ws + WS_DSEG);
    for (int n = 0; n < 4; ++n) {
        if ((n & 3) == 0) {
#pragma unroll
            for (int dt = 0; dt < 4; ++dt) Sacc[dt] = (f32x4){0.f, 0.f, 0.f, 0.f};
#pragma unroll
            for (int j = 0; j < 8; ++j) Lseg[j] = 0.f;
        }
        const int row0 = rowb + n * 64;
        const u32x4 cq = nq, ck = nk;
        *(LAS u32x4*)(VS + (tid >> 4) * VSS + (tid & 15) * 16) = nv0;
        *(LAS u32x4*)(VS + (32 + (tid >> 4)) * VSS + (tid & 15) * 16) = nv1;
        if (tid < 256) *(LAS f32x4*)(ARAW + (tid >> 2) * 16 + (tid & 3) * 4) = na;
        if (n + 1 < 4) {
            const int rn = row0 + 64; const size_t r0 = (size_t)(rn + t_) * ZC;
            nq = *(const u32x4*)(Z + r0 + ZQ + h * 64 + d8); nk = *(const u32x4*)(Z + r0 + ZK + h * 64 + d8);
            nv0 = *(const u32x4*)(Z + (size_t)(rn + (tid >> 4)) * ZC + ZV + h * 128 + (tid & 15) * 8);
            nv1 = *(const u32x4*)(Z + (size_t)(rn + 32 + (tid >> 4)) * ZC + ZV + h * 128 + (tid & 15) * 8);
            if (tid < 256) na = *(const f32x4*)(AL + (size_t)(rn + (tid >> 2)) * 16 + (tid & 3) * 4);
        }
        LBAR();
        {
            float x[8];
#pragma unroll
            for (int j = 0; j < 8; ++j) x[j] = BUP[d8 + j];
#pragma unroll
            for (int r = 0; r < 16; ++r) { const float a = ARAW[t_ * 16 + r]; const f32x4 w0 = *(const LAS f32x4*)(WUP + r * 64 + d8), w1 = *(const LAS f32x4*)(WUP + r * 64 + d8 + 4);
#pragma unroll
                for (int j = 0; j < 4; ++j) { x[j] += a * w0[j]; x[4 + j] += a * w1[j]; } }
            f32x4 o0, o1;
#pragma unroll
            for (int j = 0; j < 4; ++j) { o0[j] = logsig16(x[j]); o1[j] = logsig16(x[4 + j]); }
            *(LAS f32x4*)(LC + t_ * 64 + d8) = o0; *(LAS f32x4*)(LC + t_ * 64 + d8 + 4) = o1;
        }
        LBAR();
        {
            const int d = tid & 63, sg = tid >> 6; float cum[8]; float run = 0.f;
#pragma unroll
            for (int i = 0; i < 8; ++i) { run += LC[(sg * 8 + i) * 64 + d]; cum[i] = run; }
            SEG[sg * 64 + d] = run;
            LBAR();
            float off = 0.f;
#pragma unroll
            for (int s = 0; s < 7; ++s) off += (s < sg) ? SEG[s * 64 + d] : 0.f;
#pragma unroll
            for (int i = 0; i < 8; ++i) LC[(sg * 8 + i) * 64 + d] = cum[i] + off;
        }
        LBAR();
        {
            const f32x4 L0 = *(const LAS f32x4*)(LC + t_ * 64 + d8), L1 = *(const LAS f32x4*)(LC + t_ * 64 + d8 + 4);
            const f32x4 E0 = *(const LAS f32x4*)(LC + 63 * 64 + d8), E1 = *(const LAS f32x4*)(LC + 63 * 64 + d8 + 4);
            float qf[8], kf[8], qo[8], ko[8], k2[8], q2[8];
            unpack8(cq, qf); unpack8(ck, kf);
#pragma unroll
            for (int j = 0; j < 8; ++j) { const float L = (j < 4) ? L0[j & 3] : L1[j & 3], Le = (j < 4) ? E0[j & 3] : E1[j & 3];
                qo[j] = qf[j] * __expf(L) * 0.125f; ko[j] = kf[j] * __expf(-L); k2[j] = kf[j] * __expf(Le - L); q2[j] = qf[j] * __expf(L + Lseg[j]) * 0.125f; Lseg[j] += Le; }
            *(LAS u32x4*)(QP + t_ * QS + d8 * 2) = pack8(qo); *(LAS u32x4*)(KP + t_ * QS + d8 * 2) = pack8(ko); *(LAS u32x4*)(KPP + t_ * QS + d8 * 2) = pack8(k2);
            *(u32x4*)(Z + (size_t)(row0 + t_) * ZC + ZQ + h * 64 + d8) = pack8(q2);
            if (t_ == 0) {
#pragma unroll
                for (int j = 0; j < 8; ++j) DEC[d8 + j] = __expf((j < 4) ? E0[j & 3] : E1[j & 3]); }
        }
        LBAR();
#pragma unroll
        for (int q = 0; q < 2; ++q) {
            const int idx = 2 * w + q, it = idx >> 2, jt = idx & 3;
            f32x4 A = (f32x4){0.f, 0.f, 0.f, 0.f};
            if (jt <= it) {
#pragma unroll
                for (int ks = 0; ks < 2; ++ks) { const bf16x8 a = *(const LAS bf16x8*)(QP + (it * 16 + c) * QS + (ks * 32 + 8 * g) * 2), bb = *(const LAS bf16x8*)(KP + (jt * 16 + c) * QS + (ks * 32 + 8 * g) * 2);
                    A = __builtin_amdgcn_mfma_f32_16x16x32_bf16(a, bb, A, 0, 0, 0); }
            }
#pragma unroll
            for (int jj = 0; jj < 4; ++jj) { const int i = it * 16 + 4 * g + jj, j = jt * 16 + c; const float v = (j <= i) ? A[jj] : 0.f;
                *(LAS unsigned short*)(AIN + i * QS + j * 2) = f2bf(v); }
        }
        LBAR();
        bf16x8 Vb[2];
#pragma unroll
        for (int ks = 0; ks < 2; ++ks) { unsigned short e[8];
#pragma unroll
            for (int j = 0; j < 8; ++j) e[j] = *(const LAS unsigned short*)(VS + (ks * 32 + 8 * g + j) * VSS + (16 * w + c) * 2);
            u32x4 pw; pw.x = e[0] | ((unsigned)e[1] << 16); pw.y = e[2] | ((unsigned)e[3] << 16); pw.z = e[4] | ((unsigned)e[5] << 16); pw.w = e[6] | ((unsigned)e[7] << 16); Vb[ks] = as_bf16x8(pw); }
        bf16x8 Sb[2];
#pragma unroll
        for (int k2 = 0; k2 < 2; ++k2) { u32x4 pw; pw.x = cvt_pk_bf16(Sacc[2 * k2][0], Sacc[2 * k2][1]); pw.y = cvt_pk_bf16(Sacc[2 * k2][2], Sacc[2 * k2][3]);
            pw.z = cvt_pk_bf16(Sacc[2 * k2 + 1][0], Sacc[2 * k2 + 1][1]); pw.w = cvt_pk_bf16(Sacc[2 * k2 + 1][2], Sacc[2 * k2 + 1][3]); Sb[k2] = as_bf16x8(pw); }
        f32x4 Oacc[4];
#pragma unroll
        for (int it = 0; it < 4; ++it) {
            Oacc[it] = (f32x4){0.f, 0.f, 0.f, 0.f};
#pragma unroll
            for (int ks = 0; ks < 2; ++ks) { const bf16x8 a = *(const LAS bf16x8*)(AIN + (it * 16 + c) * QS + (ks * 32 + 8 * g) * 2); Oacc[it] = __builtin_amdgcn_mfma_f32_16x16x32_bf16(a, Vb[ks], Oacc[it], 0, 0, 0); }
#pragma unroll
            for (int k2 = 0; k2 < 2; ++k2) { const u32x2 lo = *(const LAS u32x2*)(QP + (it * 16 + c) * QS + (32 * k2 + 4 * g) * 2), hi = *(const LAS u32x2*)(QP + (it * 16 + c) * QS + (32 * k2 + 16 + 4 * g) * 2);
                const bf16x8 a = as_bf16x8((u32x4){lo.x, lo.y, hi.x, hi.y}); Oacc[it] = __builtin_amdgcn_mfma_f32_16x16x32_bf16(a, Sb[k2], Oacc[it], 0, 0, 0); }
        }
#pragma unroll
        for (int dt = 0; dt < 4; ++dt) {
            const f32x4 dc = *(const LAS f32x4*)(DEC + dt * 16 + 4 * g);
            Sacc[dt] = Sacc[dt] * dc;
#pragma unroll
            for (int ks = 0; ks < 2; ++ks) { unsigned short e[8];
#pragma unroll
                for (int j = 0; j < 8; ++j) e[j] = *(const LAS unsigned short*)(KPP + (ks * 32 + 8 * g + j) * QS + (dt * 16 + c) * 2);
                u32x4 pw; pw.x = e[0] | ((unsigned)e[1] << 16); pw.y = e[2] | ((unsigned)e[3] << 16); pw.z = e[4] | ((unsigned)e[5] << 16); pw.w = e[6] | ((unsigned)e[7] << 16);
                Sacc[dt] = __builtin_amdgcn_mfma_f32_16x16x32_bf16(as_bf16x8(pw), Vb[ks], Sacc[dt], 0, 0, 0); }
        }
#pragma unroll
        for (int it = 0; it < 4; ++it)
#pragma unroll
            for (int jj = 0; jj < 4; ++jj) *(LAS unsigned short*)(OT + (it * 16 + 4 * g + jj) * VSS + (16 * w + c) * 2) = f2bf(Oacc[it][jj]);
        LBAR();
        {
            const u32x4 o0 = *(const LAS u32x4*)(OT + (tid >> 4) * VSS + (tid & 15) * 16), o1 = *(const LAS u32x4*)(OT + (32 + (tid >> 4)) * VSS + (tid & 15) * 16);
            *(u32x4*)(Z + (size_t)(row0 + (tid >> 4)) * ZC + ZV + h * 128 + (tid & 15) * 8) = o0;
            *(u32x4*)(Z + (size_t)(row0 + 32 + (tid >> 4)) * ZC + ZV + h * 128 + (tid & 15) * 8) = o1;
        }
        if ((n & 3) == 3) {
            const int rs0 = rowb;
#pragma unroll
            for (int dt = 0; dt < 4; ++dt)
#pragma unroll
                for (int jj = 0; jj < 4; ++jj) { const int d = dt * 16 + 4 * g + jj, dv = 16 * w + c; *((float*)(Z + (size_t)(rs0 + d * 4 + (dv >> 5)) * ZC + ZK + h * 64) + (dv & 31)) = Sacc[dt][jj]; }            if (t_ == 0) {
#pragma unroll
                for (int j = 0; j < 8; ++j) DSEG[(size_t)((b * 4 + h) * 8 + seg) * 64 + d8 + j] = __expf(Lseg[j]); }
        }
    }
    __syncthreads();
}


__device__ __forceinline__ float dpp_row_sum16(float v) {
    v += __int_as_float(__builtin_amdgcn_update_dpp(0, __float_as_int(v), 0xB1, 0xf, 0xf, false));
    v += __int_as_float(__builtin_amdgcn_update_dpp(0, __float_as_int(v), 0x4E, 0xf, 0xf, false));
    v += __int_as_float(__builtin_amdgcn_update_dpp(0, __float_as_int(v), 0x141, 0xf, 0xf, false));
    v += __int_as_float(__builtin_amdgcn_update_dpp(0, __float_as_int(v), 0x140, 0xf, 0xf, false));
    return v;
}
__device__ void gla_C(const Params& P, int l, int item, LAS unsigned char* lds) {
    const int tid = get_tid(), lane = tid & 63, w = __builtin_amdgcn_readfirstlane(tid >> 6), g = lane >> 4, c = lane & 15;
    const int seg = item & 7, bh = item >> 3, b = bh >> 2, h = bh & 3;
    bf16_t* Z = (bf16_t*)(P.ws + WS_Z);
    LAS float* SSQ = (LAS float*)lds;
    LAS unsigned char* OT = lds + 8192;
    const float ng = P.gla_norm_g[(size_t)l * 128 + 16 * w + c];
    const float* DSEG = (const float*)(P.ws + WS_DSEG);
    float Sin[2][8];
#pragma unroll
    for (int ks = 0; ks < 2; ++ks)
#pragma unroll
        for (int e = 0; e < 8; ++e) Sin[ks][e] = 0.f;
    for (int sq = 0; sq < seg; ++sq) {
        const int rs0 = b * 2048 + sq * 256; const size_t it2 = (size_t)bh * 8 + sq;
#pragma unroll
        for (int ks = 0; ks < 2; ++ks)
#pragma unroll
            for (int e = 0; e < 8; ++e) { const int d = ks * 32 + 8 * g + e, dv = 16 * w + c;
                Sin[ks][e] = DSEG[it2 * 64 + d] * Sin[ks][e] + *((const float*)(Z + (size_t)(rs0 + d * 4 + (dv >> 5)) * ZC + ZK + h * 64) + (dv & 31)); }
    }
    bf16x8 Sb[2];
#pragma unroll
    for (int ks = 0; ks < 2; ++ks) Sb[ks] = as_bf16x8(pack8(Sin[ks]));
    const int row0 = b * 2048 + seg * 256;
    unsigned short gtr[16][4], olr[16][4];
#pragma unroll
    for (int rt = 0; rt < 16; ++rt)
#pragma unroll
        for (int jj = 0; jj < 4; ++jj) { const bf16_t* zr = Z + (size_t)(row0 + rt * 16 + 4 * g + jj) * ZC + h * 128 + 16 * w + c; gtr[rt][jj] = zr[ZG]; olr[rt][jj] = zr[ZV]; }
    f32x4 O[16];
#pragma unroll
    for (int rt = 0; rt < 16; ++rt) {
#pragma unroll
        for (int jj = 0; jj < 4; ++jj) O[rt][jj] = bf2f(olr[rt][jj]);
        if (seg > 0) {
#pragma unroll
            for (int ks = 0; ks < 2; ++ks) { const bf16x8 a = as_bf16x8(*(const u32x4*)(Z + (size_t)(row0 + rt * 16 + c) * ZC + ZQ + h * 64 + ks * 32 + 8 * g)); O[rt] = __builtin_amdgcn_mfma_f32_16x16x32_bf16(a, Sb[ks], O[rt], 0, 0, 0); }
        }
    }
    {
#pragma unroll
        for (int rt = 0; rt < 16; ++rt) {
            float sv[4];
#pragma unroll
            for (int jj = 0; jj < 4; ++jj) sv[jj] = O[rt][jj] * O[rt][jj];
#pragma unroll
            for (int jj = 0; jj < 4; ++jj) sv[jj] = dpp_row_sum16(sv[jj]);
            if (c == 0) {
#pragma unroll
                for (int jj = 0; jj < 4; ++jj) SSQ[w * 256 + rt * 16 + 4 * g + jj] = sv[jj]; }
        }
    }
    __syncthreads();
#pragma unroll
    for (int rt = 0; rt < 16; ++rt)
#pragma unroll
        for (int jj = 0; jj < 4; ++jj) { const int t = rt * 16 + 4 * g + jj; float tot = 0.f;
#pragma unroll
            for (int ww = 0; ww < 8; ++ww) tot += SSQ[ww * 256 + t];
            const float rs = rsqrtf(tot * (1.0f / 128.0f) + EPS);
            const float gt = bf2f(gtr[rt][jj]);
            *(LAS unsigned short*)(OT + t * 272 + (16 * w + c) * 2) = f2bf(O[rt][jj] * rs * ng * (gt * __builtin_amdgcn_rcpf(1.0f + __expf(-gt)))); }
    __syncthreads();
#pragma unroll
    for (int i = 0; i < 8; ++i) { const int p = tid + i * NTHR, r = p >> 4, sg = p & 15;
        *(u32x4*)(Z + (size_t)(row0 + r) * ZC + ZG + h * 128 + sg * 8) = *(const LAS u32x4*)(OT + r * 272 + sg * 16); }
    __syncthreads();
}

__device__ __forceinline__ int next_item(unsigned* ctr, LAS unsigned char* lds) {
    __syncthreads();
    if (threadIdx.x == 0) *(LAS unsigned*)(lds + LDS_SLOT) = atomicAdd(ctr, 1u);
    __syncthreads();
    return (int)*(LAS unsigned*)(lds + LDS_SLOT);
}

__device__ void phase_branches(const Params& P, int l, int half, LAS unsigned char* lds) {
    unsigned* ctr = (unsigned*)(P.ws + WS_CTL) + 64 * (l * 2 + half);
    for (int it = blockIdx.x; it < 256; it += gridDim.x) gla_item(P, l, it >> 5, (it >> 3) & 3, it & 7, lds);
    int it = next_item(ctr, lds);
    while (it < 1536 + 128) {
        if (it < 1536) { attn_item(P, half, it, lds, ctr); it = (int)*(LAS unsigned*)(lds + LDS_SLOT); }
        else { sc_item(P, l, it - 1536); it = next_item(ctr, lds); }
    }
}


#define XB_TMO      128
#define XB_XCNT(j)  (256  + 64 * (j))
#define XB_XSUB(j)  (1280 + 64 * (j))
#define XB_XGEN(j)  (2304 + 64 * (j))
#define XB_TOP      3328
#define XB_TOPGEN   3392
#define XCD_BAR_WORDS 3456
#define XB_SPIN_CAP (1u << 20)
__device__ __forceinline__ unsigned xb_ld(unsigned* p)              { return __hip_atomic_load(p, __ATOMIC_RELAXED, __HIP_MEMORY_SCOPE_AGENT); }
__device__ __forceinline__ unsigned xb_add(unsigned* p, unsigned v) { return __hip_atomic_fetch_add(p, v, __ATOMIC_RELAXED, __HIP_MEMORY_SCOPE_AGENT); }
__device__ __forceinline__ unsigned xb_xcc_id() { return (unsigned)__builtin_amdgcn_s_getreg((3 << 11) | 20) & 0xFu; }
#define XB_SPIN(cond, bar) do { unsigned _sp = 0; while (cond) { __builtin_amdgcn_s_sleep(1); \
    if ((++_sp & 255u) == 0u) { if (xb_ld(&(bar)[XB_TMO])) break; if (_sp > XB_SPIN_CAP) { atomicAdd(&(bar)[XB_TMO], 1u); break; } } } } while (0)
struct XcdBarrier { unsigned* bar; unsigned x; volatile LAS unsigned* st; };
__device__ __forceinline__ XcdBarrier xcd_barrier_post(unsigned* bar, volatile LAS unsigned* st) {
    XcdBarrier b; b.bar = bar; b.x = xb_xcc_id(); b.st = st;
    if (threadIdx.x == 0) (void)xb_add(&bar[XB_XCNT(b.x)], 1u);
    return b;
}
__device__ __forceinline__ void xcd_barrier_complete(unsigned* bar, unsigned x, unsigned& nloc, unsigned& nx) {
    const unsigned G = gridDim.x * gridDim.y * gridDim.z;
    unsigned sum, cnt, mine, sp = 0u;
    for (;;) {
        sum = 0u; cnt = 0u; mine = 0u;
#pragma unroll
        for (unsigned j = 0; j < 16; ++j) { const unsigned c = xb_ld(&bar[XB_XCNT(j)]); sum += c; cnt += (c > 0u) ? 1u : 0u; mine = (j == x) ? c : mine; }
        if (sum == G) break;
        __builtin_amdgcn_s_sleep(1);
        if ((++sp & 255u) == 0u) { if (xb_ld(&bar[XB_TMO])) break; if (sp > XB_SPIN_CAP) { atomicAdd(&bar[XB_TMO], 1u); break; } }
    }
    nloc = mine > 0u ? mine : 1u; nx = cnt > 0u ? cnt : 1u;
}
__device__ __forceinline__ void xcd_barrier(const XcdBarrier& b) {
    asm volatile("s_waitcnt vmcnt(0)" ::: "memory");
    __syncthreads();
    if (threadIdx.x == 0) {
        unsigned* bar = b.bar;
        __builtin_amdgcn_s_waitcnt(0);
        unsigned nloc = b.st[0], nx = b.st[1];
        if (nloc == 0u) { xcd_barrier_complete(bar, b.x, nloc, nx); b.st[0] = nloc; b.st[1] = nx; }
        const unsigned old = xb_add(&bar[XB_XSUB(b.x)], 1u);
        const unsigned gen = old / nloc;
        if (old + 1u == (gen + 1u) * nloc) {
            __builtin_amdgcn_fence(__ATOMIC_RELEASE, "agent");
            asm volatile("s_waitcnt vmcnt(0)" ::: "memory");
            const unsigned og = xb_add(&bar[XB_TOP], 1u);
            const unsigned tg = og / nx;
            if (og + 1u == (tg + 1u) * nx) xb_add(&bar[XB_TOPGEN], 1u);
            else XB_SPIN(xb_ld(&bar[XB_TOPGEN]) == tg, bar);
            __builtin_amdgcn_fence(__ATOMIC_ACQUIRE, "agent");
            xb_add(&bar[XB_XGEN(b.x)], 1u);
            asm volatile("s_waitcnt vmcnt(0)" ::: "memory");
        } else {
            XB_SPIN(xb_ld(&bar[XB_XGEN(b.x)]) == gen, bar);
            __builtin_amdgcn_fence(__ATOMIC_ACQUIRE, "agent");
            asm volatile("s_waitcnt vmcnt(0)" ::: "memory");
        }
    }
    __syncthreads();
}

__global__ void __launch_bounds__(NTHR, 2) fwd_kernel(Params P) {
    extern __shared__ __attribute__((aligned(16))) unsigned char smem[];
    LAS unsigned char* lds = (LAS unsigned char*)smem;
    cg::grid_group grid = cg::this_grid();
    if (threadIdx.x < 4) ((LAS unsigned*)(lds + LDS_BYTES - 32))[threadIdx.x] = 0u;
    __syncthreads();
    const XcdBarrier xb = xcd_barrier_post((unsigned*)(P.ws + WS_BAR), (volatile LAS unsigned*)(lds + LDS_BYTES - 32));
    unsigned char* ws = P.ws;
    const int lo = P.ph_lo, hi = P.ph_hi;
    const bool fuse = (gridDim.x == 256);
    for (int ph = lo; ph < hi; ++ph) {
        const int l = ph / 19, q = ph % 19;
        const int half = (q >= 8 && q <= 14) ? 1 : 0;
        const int k = (q == 0) ? 0 : (q <= 14 ? 1 + (q - 1) % 7 : q - 7);
        switch (k) {
        case 0: if (l == 0) { phase_convert(P, l, lds); phase_norm_alow(P, 0, 0, lds); } break;
        case 1: break;
        case 2: { pg8::Gemm g{(const bf16_t*)(ws + WS_H) + (size_t)half * TH * DM, (const bf16_t*)(ws + WS_W1), 1024, 1024, 1024, 0, 0}; pg8::Order S; S.init(TH, 10752, gridDim.x, blockIdx.x, 1);
                  pg8::EpiSplit E{(bf16_t*)(ws + WS_Z), ZC, (bf16_t*)(ws + WS_GT), GC, 30, P.b_gate + (size_t)l * GC}; pg8::gemm_phase(lds, g, S, E); } break;
        case 3: phase_branches(P, l, half, lds); break;
        case 4: for (int it = blockIdx.x; it < 256; it += gridDim.x) gla_C(P, l, it, lds); phase_combine(P); break;
        case 5: { pg8::Gemm g{(const bf16_t*)(ws + WS_Z) + ZG, (const bf16_t*)(ws + WS_WBR), ZC, 512, 512, (size_t)1024, (size_t)1024 * 512};
                  pg8::Order S; S.init(TH, 1024, gridDim.x, blockIdx.x, 3);
                  pg8::EpiMerge E{(const bf16_t*)(ws + WS_GT), (bf16_t*)(ws + WS_MG)}; pg8::gemm_phase(lds, g, S, E); } break;
        case 6: if (fuse) {
                      const int inst = l * 2 + half;
                      pg8::Gemm g{(const bf16_t*)(ws + WS_MG), (const bf16_t*)(ws + WS_WMO), 1024, 1024, 1024, 0, 0}; pg8::Order S; S.init(TH, 1024, gridDim.x, blockIdx.x, 1);
                      pg8::EpiNormRes E{(l == 0 ? P.x : P.out) + (size_t)half * TH * DM, P.out + (size_t)half * TH * DM, (bf16_t*)(ws + WS_H) + (size_t)half * TH * DM,
                                        P.post_mix_g + (size_t)l * DM, P.pre_ffn_g + (size_t)l * DM,
                                        (unsigned*)(ws + WS_XS) + (size_t)(inst * 2) * TH * 4, (unsigned*)(ws + WS_XS) + (size_t)(inst * 2 + 1) * TH * 4,
                                        (unsigned*)(ws + WS_CTL) + 4608 + (inst * 2) * 256, (unsigned*)(ws + WS_CTL) + 4608 + (inst * 2 + 1) * 256};
                      pg8::gemm_phase(lds, g, S, E);
                      if (half == 0) phase_norm_alow(P, l, 1, lds);
                  } else { pg8::Gemm g{(const bf16_t*)(ws + WS_MG), (const bf16_t*)(ws + WS_WMO), 1024, 1024, 1024, 0, 0}; pg8::Order S; S.init(TH, 1024, gridDim.x, blockIdx.x, 1);
                      pg8::EpiSplit E{(bf16_t*)(ws + WS_Y), 1024, (bf16_t*)(ws + WS_Y), 1024, 1 << 20, nullptr}; pg8::gemm_phase(lds, g, S, E); } break;
        case 7: if (!fuse) { phase_resid((l == 0 ? P.x : P.out) + (size_t)half * TH * DM, P.out + (size_t)half * TH * DM, (const bf16_t*)(ws + WS_Y), P.post_mix_g + (size_t)l * DM, P.pre_ffn_g + (size_t)l * DM,
                            (bf16_t*)(ws + WS_H) + (size_t)half * TH * DM, TH);
                if (half == 0) phase_norm_alow(P, l, 1, lds); }
                break;
        case 8: { pg8::Gemm g{(const bf16_t*)(ws + WS_H), (const bf16_t*)(ws + WS_WFF), 1024, 1024, 1024, 0, 0}; pg8::Order S; S.init(T_ALL, 5632, gridDim.x, blockIdx.x, 1);
                  pg8::EpiFFN E{(bf16_t*)(ws + WS_U), (float*)(ws + WS_HG), (float*)(ws + WS_HU), P.ff_conv_w + (size_t)l * 3 * FF, P.ff_conv_b + (size_t)l * FF, lds + pg8::STAGE_BYTES};
                  pg8::gemm_phase(lds, g, S, E); } break;
        case 9: phase_ffn_fix(P, l); break;
        case 10: { pg8::Gemm g{(const bf16_t*)(ws + WS_U), (const bf16_t*)(ws + WS_WD), FF, FF, FF, 0, 0}; pg8::Order S; S.init(T_ALL, 1024, gridDim.x, blockIdx.x, 1);
                   pg8::EpiSplit E{(bf16_t*)(ws + WS_Y2), 1024, (bf16_t*)(ws + WS_Y2), 1024, 1 << 20, nullptr}; pg8::gemm_phase(lds, g, S, E); } break;
        default: phase_resid(P.out, P.out, (const bf16_t*)(ws + WS_Y2), P.post_ffn_g + (size_t)l * DM, nullptr, nullptr, T_ALL);
                 if (l == 0) { phase_convert(P, 1, lds); phase_norm_alow(P, 1, 0, lds); }
                 break;
        }
        const bool empty = (k == 0 && l == 1) || (k == 1) || (k == 7 && fuse);
        if (ph + 1 < hi && !empty) { if (hi < lo) grid.sync(); else xcd_barrier(xb); }
    }
}

constexpr int N_PHASES = 2 * (1 + 2 * 7 + 4);

#ifndef MULTI_LAUNCH
#define MULTI_LAUNCH 0
#endif

extern "C" void kernel_launch(void* const* d_in, const int* in_sizes, int n_in, void* d_out, int out_size, void* d_ws, size_t ws_size, hipStream_t stream) {
    static int grid = 0;
    if (grid == 0) {
        if (n_in != 20 || ws_size < WS_END) { fprintf(stderr, "kernel_launch: unexpected n_in %d / ws_size %zu (need %zu)\n", n_in, ws_size, (size_t)WS_END); grid = -1; return; }
        int dev = 0, cus = 0, per_cu = 0;
        hipGetDevice(&dev); hipDeviceGetAttribute(&cus, hipDeviceAttributeMultiprocessorCount, dev);
        if (hipFuncSetAttribute((const void*)fwd_kernel, hipFuncAttributeMaxDynamicSharedMemorySize, LDS_BYTES) != hipSuccess) { fprintf(stderr, "kernel_launch: hipFuncSetAttribute failed\n"); grid = -1; return; }
        if (hipOccupancyMaxActiveBlocksPerMultiprocessor(&per_cu, (const void*)fwd_kernel, NTHR, LDS_BYTES) != hipSuccess || per_cu < 1) per_cu = 1;
        (void)hipGetLastError();
        grid = cus * per_cu;
        if (grid > 256) grid = 256;
    }
    if (grid < 0) return;
    hipMemsetAsync((char*)d_ws + WS_CTL, 0, 32768, stream);
    Params p{};
    p.x = (const float*)d_in[0]; p.pos = (const int*)d_in[1]; p.w_in = (const float*)d_in[2]; p.w_alpha_up = (const float*)d_in[3]; p.b_alpha = (const float*)d_in[4];
    p.gla_norm_g = (const float*)d_in[5]; p.sc_conv_w = (const float*)d_in[6]; p.w_gate = (const float*)d_in[7]; p.b_gate = (const float*)d_in[8]; p.w_branch = (const float*)d_in[9];
    p.w_mix_out = (const float*)d_in[10]; p.pre_mix_g = (const float*)d_in[11]; p.post_mix_g = (const float*)d_in[12]; p.pre_ffn_g = (const float*)d_in[13]; p.post_ffn_g = (const float*)d_in[14];
    p.w_ff_gate = (const float*)d_in[15]; p.w_ff_up = (const float*)d_in[16]; p.ff_conv_w = (const float*)d_in[17]; p.ff_conv_b = (const float*)d_in[18]; p.w_ff_down = (const float*)d_in[19];
    p.out = (float*)d_out; p.ws = (unsigned char*)d_ws;
#if MULTI_LAUNCH
    for (int ph = 0; ph < N_PHASES; ++ph) { p.ph_lo = ph; p.ph_hi = ph + 1; hipLaunchKernelGGL(fwd_kernel, dim3(grid), dim3(NTHR), LDS_BYTES, stream, p); }
#else
    p.ph_lo = 0; p.ph_hi = N_PHASES;
    void* args[] = {&p};
    hipError_t e = hipLaunchCooperativeKernel((const void*)fwd_kernel, dim3(grid), dim3(NTHR), args, LDS_BYTES, stream);
    if (e != hipSuccess) fprintf(stderr, "cooperative launch failed: %s (grid %d)\n", hipGetErrorString(e), grid);
#endif
}
```

```cpp
#include <hip/hip_runtime.h>
#include <hip/hip_cooperative_groups.h>
#include <cstdint>
#include <cstdio>
namespace cg = cooperative_groups;

#define LAS __attribute__((address_space(3)))
typedef unsigned short bf16_t;
typedef short bf16x8 __attribute__((ext_vector_type(8)));
typedef float f32x4 __attribute__((ext_vector_type(4)));
typedef float f32x2 __attribute__((ext_vector_type(2)));
typedef unsigned u32x4 __attribute__((ext_vector_type(4)));
typedef unsigned u32x2 __attribute__((ext_vector_type(2)));

constexpr int T_ALL = 32768, TH = 16384, DM = 1024, ZC = 7680, GC = 3072, FF = 2816;
constexpr int ZQ = 0, ZK = 256, ZV = 512, ZG = 1024, ZSC = 1536, ZSB = 2048, ZSX = 2560, ZDQ = 3072, ZDK = 4608, ZDV = 6144;
constexpr int IN_COLS = 7696;
constexpr float EPS = 1e-6f;
constexpr int NTHR = 512;
constexpr int LDS_BYTES = 147456;
constexpr int LDS_SLOT = LDS_BYTES - 16;

constexpr size_t WS_CTL = 0;
constexpr size_t WS_BAR = 4096;
constexpr size_t WS_W1 = 32768;
constexpr size_t WS_WBR = WS_W1 + (size_t)10752 * 1024 * 2;
constexpr size_t WS_WMO = WS_WBR + (size_t)3 * 1024 * 512 * 2;
constexpr size_t WS_WFF = WS_WMO + (size_t)1024 * 1024 * 2;
constexpr size_t WS_WD = WS_WFF + (size_t)5632 * 1024 * 2;
constexpr size_t WS_RC = WS_WD + (size_t)1024 * 2816 * 2;
constexpr size_t WS_XS = WS_RC + (size_t)1024 * 1024;
constexpr size_t WS_RS = WS_RC + (size_t)T_ALL * 64 * 4;
constexpr size_t WS_H = WS_RS + (size_t)T_ALL * 64 * 4;
constexpr size_t WS_ALOW = WS_H + (size_t)T_ALL * 1024 * 2;
constexpr size_t WS_LSE = WS_ALOW + (size_t)TH * 16 * 4;
constexpr size_t WS_DSEG = WS_LSE + (size_t)TH * 12 * 4;
constexpr size_t WS_BIG = WS_DSEG + (size_t)256 * 64 * 4;
constexpr size_t WS_Z = WS_BIG;
constexpr size_t WS_GT = WS_Z + (size_t)TH * ZC * 2;
constexpr size_t WS_MG = WS_GT + (size_t)TH * GC * 2;
constexpr size_t WS_END = WS_MG + (size_t)TH * 1024 * 2;
constexpr size_t WS_Y = WS_BIG;
constexpr size_t WS_G = WS_BIG;
constexpr size_t WS_U = WS_BIG + (size_t)T_ALL * FF * 2;
constexpr size_t WS_Y2 = WS_BIG;
constexpr size_t WS_HG = WS_BIG + (size_t)T_ALL * 1024 * 4;
constexpr size_t WS_HU = WS_HG + (size_t)128 * 4 * FF * 4;
static_assert(WS_HU + (size_t)128 * 2 * FF * 4 <= WS_U, "halo fits between Y2 and the activation buffer");
static_assert(WS_U + (size_t)T_ALL * FF * 2 <= WS_END, "ffn overlay");

struct Params {
    const float* x; const int* pos; const float* w_in; const float* w_alpha_up; const float* b_alpha; const float* gla_norm_g; const float* sc_conv_w;
    const float* w_gate; const float* b_gate; const float* w_branch; const float* w_mix_out; const float* pre_mix_g; const float* post_mix_g;
    const float* pre_ffn_g; const float* post_ffn_g; const float* w_ff_gate; const float* w_ff_up; const float* ff_conv_w; const float* ff_conv_b; const float* w_ff_down;
    float* out; unsigned char* ws; int ph_lo, ph_hi;
};

__device__ __forceinline__ int get_tid() { int t = threadIdx.x; asm volatile("" : "+v"(t)); return t; }
__device__ __forceinline__ unsigned cvt_pk_bf16(float lo, float hi) { unsigned r; asm volatile("v_cvt_pk_bf16_f32 %0, %1, %2" : "=v"(r) : "v"(lo), "v"(hi)); return r; }
__device__ __forceinline__ float bflo(unsigned w) { return __uint_as_float(w << 16); }
__device__ __forceinline__ float bfhi(unsigned w) { return __uint_as_float(w & 0xffff0000u); }
__device__ __forceinline__ float bf2f(unsigned short b) { return __uint_as_float(((unsigned)b) << 16); }
__device__ __forceinline__ unsigned short f2bf(float f) { return (unsigned short)(cvt_pk_bf16(f, 0.f) & 0xffffu); }
__device__ __forceinline__ void unpack8(const u32x4 w, float (&f)[8]) { f[0] = bflo(w.x); f[1] = bfhi(w.x); f[2] = bflo(w.y); f[3] = bfhi(w.y); f[4] = bflo(w.z); f[5] = bfhi(w.z); f[6] = bflo(w.w); f[7] = bfhi(w.w); }
__device__ __forceinline__ u32x4 pack8(const float (&f)[8]) { u32x4 w; w.x = cvt_pk_bf16(f[0], f[1]); w.y = cvt_pk_bf16(f[2], f[3]); w.z = cvt_pk_bf16(f[4], f[5]); w.w = cvt_pk_bf16(f[6], f[7]); return w; }
__device__ __forceinline__ bf16x8 as_bf16x8(const u32x4 w) { union { u32x4 u; bf16x8 b; } c; c.u = w; return c.b; }

namespace pg8 {
constexpr int BM = 256, BK = 64, HALF = 128, HTB = HALF * BK * 2, STAGE_BYTES = 8 * HTB, NXCD = 8, WGM = 8;
__device__ __forceinline__ int lds_byte(int r, int c) { const int st = (r >> 4) * 2 + (c >> 5), rr = r & 15, cc = c & 31, ob = rr * 64 + cc * 2; return st * 1024 + (ob ^ (((ob >> 9) & 1) << 5)); }
__device__ __forceinline__ void stage_rc(int b, int& R, int& C) { const int st = b / 1024, sb = b % 1024, swz = sb ^ (((sb >> 9) & 1) << 5); R = (st >> 1) * 16 + swz / 64; C = (st & 1) * 32 + (swz % 64) / 2; }
__device__ __forceinline__ int perm32(int rho) { const int n = rho >> 4, i = rho & 15; return 8 * (i >> 2) + 4 * n + (i & 3); }

struct Unit { int pm, pn, g; };
struct Gemm { const bf16_t* A; const bf16_t* Bt; int lda, ldb, K; size_t gA, gB; };

struct Order {
    int nM, nN, nwg, G, c, ng;
    __device__ void init(int M, int N, int G_, int c_, int ng_) { nM = M / BM; nN = N / BM; nwg = nM * nN; G = G_; c = c_; ng = ng_; }
    __device__ bool next(int i, Unit& u) const {
        const int ti = i / ng; u.g = i - ti * ng;
        const long L = (long)ti * G + c; if (L >= nwg) return false;
        int wgid = (int)L; { const int q = nwg / NXCD, r = nwg % NXCD, xcd = wgid % NXCD, off = wgid / NXCD; wgid = (xcd < r ? xcd * (q + 1) : r * (q + 1) + (xcd - r) * q) + off; }
        const int nig = WGM * nN, gid = wgid / nig, fm = gid * WGM, gsz = (nM - fm) < WGM ? (nM - fm) : WGM;
        u.pm = fm + ((wgid % nig) % gsz); u.pn = (wgid % nig) / gsz; return true;
    }
};

template <class Epi>
__device__ __forceinline__ void gemm_phase(LAS unsigned char* lds, const Gemm g, const Order& S, const Epi& E) {
    const int tid = get_tid(), wid = __builtin_amdgcn_readfirstlane(tid >> 6), lane = tid & 63, wr = wid >> 2, wc = wid & 3, fr = lane & 15, fq = lane >> 4;
    const int K = g.K, nt = K / BK;
    unsigned voffA[2], voffB[2];
#pragma unroll
    for (int i = 0; i < 2; ++i) { int R, C; stage_rc(tid * 16 + i * 8192, R, C); const int Rb = Epi::PERM ? ((R & ~31) + perm32(R & 31)) : R;
        voffA[i] = (unsigned)(R * g.lda + C) * 2u; voffB[i] = (unsigned)(Rb * g.ldb + C) * 2u; }
    const size_t kstep = (size_t)(BK * 2);
    const size_t hstepA = (size_t)HALF * g.lda * 2, hstepB = (size_t)HALF * g.ldb * 2;
    const size_t tstepA = 2 * hstepA, tstepB = 2 * hstepB;
    const unsigned ldsw = (unsigned)wid * 1024u;
    const int aoff = lds_byte(wr * 64 + fr, fq * 8), boff = lds_byte(wc * 32 + fr, fq * 8);
#define PG8_SA(b, h) (((b) * 2 + (h)) * HTB)
#define PG8_SB(b, h) ((4 + (b) * 2 + (h)) * HTB)
#define PG8_STAGE(bufoff, gbase, voff) do { _Pragma("unroll") for (int _i = 0; _i < 2; ++_i) \
        __builtin_amdgcn_global_load_lds((const unsigned*)((const char*)(gbase) + (voff)[_i]), (LAS unsigned*)(lds + (bufoff) + ldsw + _i * 8192), 16, 0, 0); } while (0)
#define PG8_LDA(dst, b, h) do { _Pragma("unroll") for (int m = 0; m < 4; ++m) _Pragma("unroll") for (int k = 0; k < 2; ++k) dst[m][k] = *(const LAS bf16x8*)(lds + PG8_SA(b, h) + aoff + m * 2048 + k * 1024); } while (0)
#define PG8_LDB(dst, b, h) do { _Pragma("unroll") for (int n = 0; n < 2; ++n) _Pragma("unroll") for (int k = 0; k < 2; ++k) dst[n][k] = *(const LAS bf16x8*)(lds + PG8_SB(b, h) + boff + n * 2048 + k * 1024); } while (0)
#define PG8_MMA(ai, bj, At, Bt) do { __builtin_amdgcn_s_setprio(1); _Pragma("unroll") for (int m = 0; m < 4; ++m) _Pragma("unroll") for (int n = 0; n < 2; ++n) _Pragma("unroll") for (int k = 0; k < 2; ++k) \
        acc[ai][bj][m][n] = __builtin_amdgcn_mfma_f32_16x16x32_bf16(Bt[n][k], At[m][k], acc[ai][bj][m][n], 0, 0, 0); __builtin_amdgcn_s_setprio(0); } while (0)
#define PG8_WAIT_V(n) asm volatile("s_waitcnt vmcnt(" #n ")" ::: "memory")
#define PG8_WAIT_L(n) asm volatile("s_waitcnt lgkmcnt(" #n ")" ::: "memory")
#define PG8_BAR __builtin_amdgcn_s_barrier()
#define PG8_SCHED __builtin_amdgcn_sched_barrier(0)
    Unit cur, nxt; int ui = 0;
    if (!S.next(0, cur)) return;
    f32x4 acc[2][2][4][2];
#pragma unroll
    for (int a = 0; a < 2; ++a)
#pragma unroll
        for (int b = 0; b < 2; ++b)
#pragma unroll
            for (int m = 0; m < 4; ++m)
#pragma unroll
                for (int n = 0; n < 2; ++n) acc[a][b][m][n] = (f32x4){0.f, 0.f, 0.f, 0.f};
    bf16x8 At[4][2], B0[2][2], B1[2][2];
    const char* cA = (const char*)(g.A + (size_t)cur.g * g.gA) + (size_t)cur.pm * tstepA; const char* cB = (const char*)(g.Bt + (size_t)cur.g * g.gB) + (size_t)cur.pn * tstepB;
    PG8_STAGE(PG8_SB(0, 0), cB, voffB); PG8_STAGE(PG8_SB(0, 1), cB + hstepB, voffB); PG8_STAGE(PG8_SA(0, 0), cA, voffA); PG8_STAGE(PG8_SA(0, 1), cA + hstepA, voffA);
    if (wr == 1) PG8_BAR;
    PG8_WAIT_V(2); PG8_BAR;
    PG8_STAGE(PG8_SB(1, 0), cB + kstep, voffB); PG8_STAGE(PG8_SA(1, 0), cA + kstep, voffA); PG8_STAGE(PG8_SB(1, 1), cB + hstepB + kstep, voffB);
    PG8_WAIT_V(6); PG8_BAR;
    for (;;) {
        const bool has_next = S.next(ui + 1, nxt);
        const char* nA = has_next ? (const char*)(g.A + (size_t)nxt.g * g.gA) + (size_t)nxt.pm * tstepA : cA; const char* nB = has_next ? (const char*)(g.Bt + (size_t)nxt.g * g.gB) + (size_t)nxt.pn * tstepB : cB;
        for (int t = 0; t < nt; t += 2) {
            const bool last = (t == nt - 2);
            const char* a1 = cA + (size_t)(t + 1) * kstep;
            const char* a2 = last ? nA : cA + (size_t)(t + 2) * kstep; const char* b2 = last ? nB : cB + (size_t)(t + 2) * kstep;
            const char* a3 = a2 + kstep; const char* b3 = b2 + kstep;
            PG8_LDB(B0, 0, 0); PG8_LDB(B1, 0, 1); PG8_SCHED; PG8_LDA(At, 0, 0); PG8_STAGE(PG8_SA(1, 1), a1 + hstepA, voffA);
            PG8_WAIT_V(8); PG8_WAIT_L(0); PG8_BAR; PG8_MMA(0, 0, At, B0); PG8_MMA(0, 1, At, B1); PG8_BAR; PG8_SCHED;
            PG8_LDA(At, 0, 1); PG8_STAGE(PG8_SB(0, 0), b2, voffB); PG8_STAGE(PG8_SB(0, 1), b2 + hstepB, voffB); PG8_STAGE(PG8_SA(0, 0), a2, voffA);
            PG8_WAIT_V(8); PG8_WAIT_L(0); PG8_BAR; PG8_MMA(1, 0, At, B0); PG8_MMA(1, 1, At, B1); PG8_BAR; PG8_SCHED;
            PG8_LDB(B0, 1, 0); PG8_LDB(B1, 1, 1); PG8_SCHED; PG8_LDA(At, 1, 0); PG8_STAGE(PG8_SA(0, 1), a2 + hstepA, voffA);
            PG8_WAIT_V(8); PG8_WAIT_L(0); PG8_BAR; PG8_MMA(0, 0, At, B0); PG8_MMA(0, 1, At, B1); PG8_BAR; PG8_SCHED;
            PG8_LDA(At, 1, 1); PG8_STAGE(PG8_SB(1, 0), b3, voffB); PG8_STAGE(PG8_SB(1, 1), b3 + hstepB, voffB); PG8_STAGE(PG8_SA(1, 0), a3, voffA);
            PG8_WAIT_V(8); PG8_WAIT_L(0); PG8_BAR; PG8_MMA(1, 0, At, B0); PG8_MMA(1, 1, At, B1); PG8_BAR; PG8_SCHED;
        }
        if (wr == 0) PG8_BAR;
        if constexpr (!Epi::AFTER_DRAIN) E(acc, cur, wr, wc, fr, fq);
        if (!has_next) break;
        if constexpr (!Epi::KEEP_ACC) {
#pragma unroll
        for (int a = 0; a < 2; ++a)
#pragma unroll
            for (int b = 0; b < 2; ++b)
#pragma unroll
                for (int m = 0; m < 4; ++m)
#pragma unroll
                    for (int n = 0; n < 2; ++n) acc[a][b][m][n] = (f32x4){0.f, 0.f, 0.f, 0.f};
        }
        cur = nxt; cA = nA; cB = nB; ++ui;
        if (wr == 1) PG8_BAR;
    }
    PG8_WAIT_V(0);
    PG8_BAR;
    if constexpr (Epi::AFTER_DRAIN) E.fused(acc, cur, wr, wc, fr, fq, lds);
#undef PG8_SA
#undef PG8_SB
#undef PG8_STAGE
#undef PG8_LDA
#undef PG8_LDB
#undef PG8_MMA
#undef PG8_WAIT_V
#undef PG8_WAIT_L
#undef PG8_BAR
#undef PG8_SCHED
}

struct EpiF32 {
    static constexpr bool PERM = false, AFTER_DRAIN = false, KEEP_ACC = false;
    float* C; int ldc;
    __device__ __forceinline__ void operator()(const f32x4 (&acc)[2][2][4][2], const Unit& u, int wr, int wc, int fr, int fq) const {
        const int row0 = u.pm * BM + wr * 64 + fr, col0 = u.pn * BM + wc * 32 + 4 * fq;
#pragma unroll
        for (int ai = 0; ai < 2; ++ai)
#pragma unroll
            for (int m = 0; m < 4; ++m) { float* rowp = C + (size_t)(row0 + ai * HALF + m * 16) * ldc + col0;
#pragma unroll
                for (int bj = 0; bj < 2; ++bj)
#pragma unroll
                    for (int n = 0; n < 2; ++n) *(f32x4*)(rowp + bj * HALF + n * 16) = acc[ai][bj][m][n]; }
    }
};
struct EpiSplit {
    static constexpr bool PERM = true, AFTER_DRAIN = false, KEEP_ACC = false;
    bf16_t* O0; int ld0; bf16_t* O1; int ld1; int split; const float* bias1;
    __device__ __forceinline__ void operator()(const f32x4 (&acc)[2][2][4][2], const Unit& u, int wr, int wc, int fr, int fq) const {
        const int row0 = u.pm * BM + wr * 64 + fr;
        const bool second = u.pn >= split;
        bf16_t* base = second ? O1 : O0; const int ld = second ? ld1 : ld0;
        const int col0 = (second ? (u.pn - split) : u.pn) * BM + wc * 32 + 8 * fq;
        const bool sig = second && (bias1 != nullptr);
        f32x4 bv[2][2];
#pragma unroll
        for (int bj = 0; bj < 2; ++bj)
#pragma unroll
            for (int n = 0; n < 2; ++n) bv[bj][n] = sig ? *(const f32x4*)(bias1 + col0 + bj * HALF + 4 * n) : (f32x4){0.f, 0.f, 0.f, 0.f};
#pragma unroll
        for (int ai = 0; ai < 2; ++ai)
#pragma unroll
            for (int m = 0; m < 4; ++m) { bf16_t* rowp = base + (size_t)(row0 + ai * HALF + m * 16) * ld + col0;
#pragma unroll
                for (int bj = 0; bj < 2; ++bj) { f32x4 v0 = acc[ai][bj][m][0] + bv[bj][0], v1 = acc[ai][bj][m][1] + bv[bj][1];
                    if (sig) {
#pragma unroll
                        for (int j = 0; j < 4; ++j) { v0[j] = __builtin_amdgcn_rcpf(1.0f + __expf(-v0[j])); v1[j] = __builtin_amdgcn_rcpf(1.0f + __expf(-v1[j])); } }
                    u32x4 w; w.x = cvt_pk_bf16(v0[0], v0[1]); w.y = cvt_pk_bf16(v0[2], v0[3]); w.z = cvt_pk_bf16(v1[0], v1[1]); w.w = cvt_pk_bf16(v1[2], v1[3]);
                    *(u32x4*)(rowp + bj * HALF) = w; } }
    }
};
struct EpiMerge {
    static constexpr bool PERM = true, AFTER_DRAIN = false, KEEP_ACC = true;
    const bf16_t* GT; bf16_t* MG;
    __device__ __forceinline__ void operator()(f32x4 (&acc)[2][2][4][2], const Unit& u, int wr, int wc, int fr, int fq) const {
        const int row0 = u.pm * BM + wr * 64 + fr, col0 = u.pn * BM + wc * 32 + 8 * fq;
        const bool last = (u.g == 2);
#pragma unroll
        for (int ai = 0; ai < 2; ++ai) {
            u32x4 gw[4][2], gn[4][2];
#pragma unroll
            for (int m = 0; m < 4; ++m)
#pragma unroll
                for (int bj = 0; bj < 2; ++bj) { const size_t row = (size_t)(row0 + ai * HALF + m * 16); const int col = col0 + bj * HALF;
                    gw[m][bj] = *(const u32x4*)(GT + row * GC + u.g * 1024 + col);
                    gn[m][bj] = last ? (u32x4){0x3f803f80u, 0x3f803f80u, 0x3f803f80u, 0x3f803f80u} : *(const u32x4*)(GT + row * GC + (u.g + 1) * 1024 + col); }
#pragma unroll
            for (int m = 0; m < 4; ++m)
#pragma unroll
                for (int bj = 0; bj < 2; ++bj) { const size_t row = (size_t)(row0 + ai * HALF + m * 16); const int col = col0 + bj * HALF;
                    float gf[8], nf[8], v[8]; unpack8(gw[m][bj], gf); unpack8(gn[m][bj], nf);
#pragma unroll
                    for (int j = 0; j < 4; ++j) { v[j] = gf[j] * acc[ai][bj][m][0][j]; v[4 + j] = gf[4 + j] * acc[ai][bj][m][1][j]; }
                    if (last) { *(u32x4*)(MG + row * 1024 + col) = pack8(v); acc[ai][bj][m][0] = (f32x4){0.f, 0.f, 0.f, 0.f}; acc[ai][bj][m][1] = (f32x4){0.f, 0.f, 0.f, 0.f}; }
                    else {
#pragma unroll
                        for (int j = 0; j < 4; ++j) { acc[ai][bj][m][0][j] = v[j] * __builtin_amdgcn_rcpf(fmaxf(nf[j], 1e-30f)); acc[ai][bj][m][1][j] = v[4 + j] * __builtin_amdgcn_rcpf(fmaxf(nf[4 + j], 1e-30f)); } }
                }
        }
    }
};

__device__ __forceinline__ float dpp_row_shr1(float x) { return __int_as_float(__builtin_amdgcn_update_dpp(0, __float_as_int(x), 0x111, 0xf, 0xf, false)); }
__device__ __forceinline__ float dpp_row_shr2(float x) { return __int_as_float(__builtin_amdgcn_update_dpp(0, __float_as_int(x), 0x112, 0xf, 0xf, false)); }
__device__ __forceinline__ float dpp_row_ror1(float x) { return __int_as_float(__builtin_amdgcn_update_dpp(0, __float_as_int(x), 0x121, 0xf, 0xf, false)); }
__device__ __forceinline__ float dpp_row_ror2(float x) { return __int_as_float(__builtin_amdgcn_update_dpp(0, __float_as_int(x), 0x122, 0xf, 0xf, false)); }
__device__ __forceinline__ f32x2 gelu_tanh_mul2(f32x2 gt, f32x2 up) {
    const f32x2 g2 = gt * gt;
    const f32x2 t = gt * (g2 * 0.044715f + 1.0f);
    const f32x2 sx = t * (-2.0f * 0.7978845608028654f * 1.4426950408889634f);
    f32x2 e; e.x = __builtin_amdgcn_exp2f(sx.x); e.y = __builtin_amdgcn_exp2f(sx.y);
    const f32x2 d = e + 1.0f;
    f32x2 r; r.x = __builtin_amdgcn_rcpf(d.x); r.y = __builtin_amdgcn_rcpf(d.y);
    return gt * r * up;
}
__device__ __forceinline__ float gelu_tanh_mul(float gt, float up) {
    const float uu = 0.7978845608028654f * (gt + 0.044715f * gt * gt * gt);
    return gt * __builtin_amdgcn_rcpf(1.0f + __expf(-2.0f * uu)) * up;
}
struct EpiFFN {
    static constexpr bool PERM = true, AFTER_DRAIN = false, KEEP_ACC = false;
    bf16_t* ACT; float* HG; float* HU; const float* cw; const float* cb; LAS unsigned char* xlds;
    __device__ __forceinline__ void operator()(const f32x4 (&acc)[2][2][4][2], const Unit& u, int wr, int wc, int fr, int fq) const {
        const int chl = wc * 32 + 8 * fq, chg = u.pn * 128 + chl;
        LAS float* XG = (LAS float*)xlds;
        if (fr >= 14) {
#pragma unroll
            for (int ai = 0; ai < 2; ++ai) { LAS float* p = XG + ((2 * ai + wr) * 2 + (fr - 14)) * 128 + chl; *(LAS f32x4*)p = acc[ai][0][3][0]; *(LAS f32x4*)(p + 4) = acc[ai][0][3][1]; }
            if (wr == 1) { float* hp = HG + ((size_t)u.pm * 4 + 2 + (fr - 14)) * FF + chg; *(f32x4*)hp = acc[1][0][3][0]; *(f32x4*)(hp + 4) = acc[1][0][3][1]; }
        }
        if (fr < 2 && wr == 0) {
            float* hp = HG + ((size_t)u.pm * 4 + fr) * FF + chg; *(f32x4*)hp = acc[0][0][0][0]; *(f32x4*)(hp + 4) = acc[0][0][0][1];
            float* up = HU + ((size_t)u.pm * 2 + fr) * FF + chg; *(f32x4*)up = acc[0][1][0][0]; *(f32x4*)(up + 4) = acc[0][1][0][1];
        }
        asm volatile("s_waitcnt lgkmcnt(0)" ::: "memory"); __builtin_amdgcn_s_barrier(); asm volatile("" ::: "memory");
        float w0[8], w1[8], w2[8], bb[8];
        { const f32x4 a0 = *(const f32x4*)(cw + chg), a1 = *(const f32x4*)(cw + chg + 4), b0 = *(const f32x4*)(cw + FF + chg), b1 = *(const f32x4*)(cw + FF + chg + 4),
                      c0 = *(const f32x4*)(cw + 2 * FF + chg), c1 = *(const f32x4*)(cw + 2 * FF + chg + 4), d0 = *(const f32x4*)(cb + chg), d1 = *(const f32x4*)(cb + chg + 4);
#pragma unroll
          for (int j = 0; j < 4; ++j) { w0[j] = a0[j]; w0[4 + j] = a1[j]; w1[j] = b0[j]; w1[4 + j] = b1[j]; w2[j] = c0[j]; w2[4 + j] = c1[j]; bb[j] = d0[j]; bb[4 + j] = d1[j]; } }
#pragma unroll
        for (int ai = 0; ai < 2; ++ai)
#pragma unroll
            for (int m = 0; m < 4; ++m) {
                const int B = 2 * ai + wr;
                float g8[8], u8[8], q15[8], q14[8], o[8];
#pragma unroll
                for (int j = 0; j < 4; ++j) { g8[j] = acc[ai][0][m][0][j]; g8[4 + j] = acc[ai][0][m][1][j]; u8[j] = acc[ai][1][m][0][j]; u8[4 + j] = acc[ai][1][m][1][j]; }
                if (m == 0) {
                    if (B > 0) { const LAS float* p = XG + ((B - 1) * 2) * 128 + chl; const f32x4 r0a = *(const LAS f32x4*)p, r0b = *(const LAS f32x4*)(p + 4), r1a = *(const LAS f32x4*)(p + 128), r1b = *(const LAS f32x4*)(p + 132);
#pragma unroll
                        for (int j = 0; j < 4; ++j) { q14[j] = r0a[j]; q14[4 + j] = r0b[j]; q15[j] = r1a[j]; q15[4 + j] = r1b[j]; } }
                    else {
#pragma unroll
                        for (int j = 0; j < 8; ++j) { q14[j] = 0.f; q15[j] = 0.f; } }
                    float p1a[8], p2a[8];
#pragma unroll
                    for (int e = 0; e < 8; ++e) { const float s1 = dpp_row_shr1(g8[e]), s2 = dpp_row_shr2(g8[e]);
                        p1a[e] = (fr >= 1) ? s1 : q15[e]; p2a[e] = (fr >= 2) ? s2 : ((fr == 1) ? q15[e] : q14[e]); }
#pragma unroll
                    for (int e = 0; e < 8; e += 2) { const f32x2 gt = (f32x2){w0[e], w0[e + 1]} * (f32x2){p2a[e], p2a[e + 1]} + (f32x2){w1[e], w1[e + 1]} * (f32x2){p1a[e], p1a[e + 1]} + (f32x2){w2[e], w2[e + 1]} * (f32x2){g8[e], g8[e + 1]} + (f32x2){bb[e], bb[e + 1]};
                        const f32x2 r = gelu_tanh_mul2(gt, (f32x2){u8[e], u8[e + 1]}); o[e] = r.x; o[e + 1] = r.y; }
                } else {
                    float p1a[8], p2a[8];
#pragma unroll
                    for (int e = 0; e < 8; ++e) { const float pv = (e < 4) ? acc[ai][0][m - 1][0][e & 3] : acc[ai][0][m - 1][1][e & 3];
                        const float s1 = dpp_row_shr1(g8[e]), s2 = dpp_row_shr2(g8[e]), r1 = dpp_row_ror1(pv), r2 = dpp_row_ror2(pv);
                        p1a[e] = (fr >= 1) ? s1 : r1; p2a[e] = (fr >= 2) ? s2 : r2; }
#pragma unroll
                    for (int e = 0; e < 8; e += 2) { const f32x2 gt = (f32x2){w0[e], w0[e + 1]} * (f32x2){p2a[e], p2a[e + 1]} + (f32x2){w1[e], w1[e + 1]} * (f32x2){p1a[e], p1a[e + 1]} + (f32x2){w2[e], w2[e + 1]} * (f32x2){g8[e], g8[e + 1]} + (f32x2){bb[e], bb[e + 1]};
                        const f32x2 r = gelu_tanh_mul2(gt, (f32x2){u8[e], u8[e + 1]}); o[e] = r.x; o[e + 1] = r.y; }
                }
                const int rloc = 128 * ai + 64 * wr + 16 * m + fr;
                if (!(B == 0 && m == 0 && fr < 2)) *(u32x4*)(ACT + (size_t)(u.pm * BM + rloc) * FF + chg) = pack8(o);
            }
    }
};

struct EpiNormRes {
    static constexpr bool PERM = false, AFTER_DRAIN = true, KEEP_ACC = false;
    const float* xin; float* xout; bf16_t* H2; const float* g1; const float* g2; unsigned* xs1; unsigned* xs2; unsigned* cnt1; unsigned* cnt2;
    __device__ __forceinline__ void exchange(const f32x4 (&v)[2][2][4][2], const Unit& u, int wr, int wc, int fr, int fq, LAS unsigned char* lds, unsigned* xs, unsigned* cnt) const {
        LAS float* Pp = (LAS float*)lds;
        LAS float* S = (LAS float*)(lds + 4096);
        const int tid = get_tid();
#pragma unroll
        for (int ai = 0; ai < 2; ++ai)
#pragma unroll
            for (int m = 0; m < 4; ++m) { float sq = 0.f;
#pragma unroll
                for (int bj = 0; bj < 2; ++bj)
#pragma unroll
                    for (int n = 0; n < 2; ++n) { const f32x4 x = v[ai][bj][m][n]; sq += (x[0] * x[0] + x[1] * x[1]) + (x[2] * x[2] + x[3] * x[3]); }
                sq += __shfl_xor(sq, 16); sq += __shfl_xor(sq, 32);
                if (fq == 0) Pp[(ai * HALF + wr * 64 + m * 16 + fr) * 4 + wc] = sq; }
        asm volatile("s_waitcnt lgkmcnt(0)" ::: "memory"); __builtin_amdgcn_s_barrier(); asm volatile("" ::: "memory");
        if (tid < 256) { const f32x4 p = *(const LAS f32x4*)(Pp + tid * 4);
            __hip_atomic_store(xs + ((size_t)(u.pm * BM + tid)) * 4 + u.pn, __float_as_uint((p[0] + p[1]) + (p[2] + p[3])), __ATOMIC_RELAXED, __HIP_MEMORY_SCOPE_AGENT); }
        asm volatile("s_waitcnt vmcnt(0)" ::: "memory");
        __syncthreads();
        if (tid == 0) {
            __hip_atomic_fetch_add(cnt + u.pm * 4, 1u, __ATOMIC_RELAXED, __HIP_MEMORY_SCOPE_AGENT);
            unsigned sp = 0u;
            while (__hip_atomic_load(cnt + u.pm * 4, __ATOMIC_RELAXED, __HIP_MEMORY_SCOPE_AGENT) < 4u) { __builtin_amdgcn_s_sleep(1); if (++sp > (1u << 22)) break; }
            __builtin_amdgcn_fence(__ATOMIC_ACQUIRE, "agent");
            asm volatile("s_waitcnt vmcnt(0)" ::: "memory");
        }
        __syncthreads();
        if (tid < 256) { const unsigned* q = xs + ((size_t)(u.pm * BM + tid)) * 4; float t = 0.f;
#pragma unroll
            for (int k = 0; k < 4; ++k) t += __uint_as_float(__hip_atomic_load(q + k, __ATOMIC_RELAXED, __HIP_MEMORY_SCOPE_AGENT));
            S[tid] = rsqrtf(t * (1.0f / 1024.0f) + EPS); }
        asm volatile("s_waitcnt lgkmcnt(0)" ::: "memory"); __syncthreads();
    }
    __device__ __forceinline__ void fused(f32x4 (&acc)[2][2][4][2], const Unit& u, int wr, int wc, int fr, int fq, LAS unsigned char* lds) const {
        const LAS float* S = (const LAS float*)(lds + 4096);
        const int col0 = u.pn * BM + wc * 32 + 4 * fq;
        exchange(acc, u, wr, wc, fr, fq, lds, xs1, cnt1);
        {
            f32x4 gv[2][2];
#pragma unroll
            for (int bj = 0; bj < 2; ++bj)
#pragma unroll
                for (int n = 0; n < 2; ++n) gv[bj][n] = *(const f32x4*)(g1 + col0 + bj * HALF + n * 16);
#pragma unroll
            for (int ai = 0; ai < 2; ++ai) {
                f32x4 xv[4][2][2];
#pragma unroll
                for (int m = 0; m < 4; ++m)
#pragma unroll
                    for (int bj = 0; bj < 2; ++bj)
#pragma unroll
                        for (int n = 0; n < 2; ++n) xv[m][bj][n] = *(const f32x4*)(xin + (size_t)(u.pm * BM + ai * HALF + wr * 64 + m * 16 + fr) * DM + col0 + bj * HALF + n * 16);
#pragma unroll
                for (int m = 0; m < 4; ++m) { const int r = ai * HALF + wr * 64 + m * 16 + fr; const float r1 = S[r];
#pragma unroll
                    for (int bj = 0; bj < 2; ++bj)
#pragma unroll
                        for (int n = 0; n < 2; ++n) { acc[ai][bj][m][n] = xv[m][bj][n] + acc[ai][bj][m][n] * r1 * gv[bj][n];
                            *(f32x4*)(xout + (size_t)(u.pm * BM + r) * DM + col0 + bj * HALF + n * 16) = acc[ai][bj][m][n]; } }
            }
        }
        asm volatile("s_waitcnt lgkmcnt(0)" ::: "memory"); __syncthreads();
        exchange(acc, u, wr, wc, fr, fq, lds, xs2, cnt2);
        {
            f32x4 gv[2][2];
#pragma unroll
            for (int bj = 0; bj < 2; ++bj)
#pragma unroll
                for (int n = 0; n < 2; ++n) gv[bj][n] = *(const f32x4*)(g2 + col0 + bj * HALF + n * 16);
#pragma unroll
            for (int ai = 0; ai < 2; ++ai)
#pragma unroll
                for (int m = 0; m < 4; ++m) { const int r = ai * HALF + wr * 64 + m * 16 + fr; const float r2 = S[r];
#pragma unroll
                    for (int bj = 0; bj < 2; ++bj)
#pragma unroll
                        for (int n = 0; n < 2; ++n) { const f32x4 h = acc[ai][bj][m][n] * r2 * gv[bj][n]; u32x2 w; w.x = cvt_pk_bf16(h[0], h[1]); w.y = cvt_pk_bf16(h[2], h[3]);
                            *(u32x2*)(H2 + (size_t)(u.pm * BM + r) * DM + col0 + bj * HALF + n * 16) = w; } }
        }
        asm volatile("s_waitcnt lgkmcnt(0)" ::: "memory"); __syncthreads();
    }
    __device__ __forceinline__ void operator()(const f32x4 (&)[2][2][4][2], const Unit&, int, int, int, int) const {}
};
}

__device__ __forceinline__ void transpose_tile(const float* src, int ld, int k0, int n0s, bf16_t* dst, int dk, int n0d, LAS float* tile) {
    const int tid = get_tid();
    { const int r = tid >> 4, c4 = (tid & 15) * 4;
#pragma unroll
      for (int i = 0; i < 2; ++i) { const f32x4 v = *(const f32x4*)(src + (size_t)(k0 + r + 32 * i) * ld + n0s + c4);
          LAS float* t = tile + (r + 32 * i) * 65 + c4; t[0] = v[0]; t[1] = v[1]; t[2] = v[2]; t[3] = v[3]; } }
    __syncthreads();
    { const int n = tid >> 3, ks = (tid & 7) * 8; float e[8];
#pragma unroll
      for (int j = 0; j < 8; ++j) e[j] = tile[(ks + j) * 65 + n];
      *(u32x4*)(dst + (size_t)(n0d + n) * dk + k0 + ks) = pack8(e); }
    __syncthreads();
}

__device__ void phase_convert(const Params& P, int l, LAS unsigned char* lds) {
    LAS float* tile = (LAS float*)lds;
    unsigned char* ws = P.ws;
    bf16_t* W1 = (bf16_t*)(ws + WS_W1); bf16_t* WBR = (bf16_t*)(ws + WS_WBR); bf16_t* WMO = (bf16_t*)(ws + WS_WMO); bf16_t* WFF = (bf16_t*)(ws + WS_WFF); bf16_t* WD = (bf16_t*)(ws + WS_WD);
    const float* win = P.w_in + (size_t)l * 1024 * IN_COLS;
#define SEG(src, ld, ktiles, ntiles, n0s, dst, dk, n0d) if (r < (ktiles) * (ntiles)) { const int kt = r / (ntiles), ntl = r % (ntiles); transpose_tile(src, ld, kt * 64, (n0s) + ntl * 64, dst, dk, (n0d) + ntl * 64, tile); continue; } r -= (ktiles) * (ntiles);
    constexpr int total = 16 * 120 + 16 * 48 + 3 * 8 * 16 + 16 * 16 + 16 * 44 + 16 * 44 + 44 * 16;
    for (int it = blockIdx.x; it < total; it += gridDim.x) {
        int r = it;
        SEG(win, IN_COLS, 16, 8, 0, W1, 1024, ZQ)
        SEG(win, IN_COLS, 16, 8, 512, W1, 1024, ZV)
        SEG(win, IN_COLS, 16, 8, 1024, W1, 1024, ZG)
        SEG(win, IN_COLS, 16, 8, 1552, W1, 1024, ZSB)
        SEG(win, IN_COLS, 16, 8, 2064, W1, 1024, ZSC)
        SEG(win, IN_COLS, 16, 8, 2576, W1, 1024, ZSX)
        SEG(win, IN_COLS, 16, 72, 3088, W1, 1024, ZDQ)
        SEG(P.w_gate + (size_t)l * 1024 * 3072, 3072, 16, 48, 0, W1, 1024, 7680)
        SEG(P.w_branch + ((size_t)l * 3 + 0) * 512 * 1024, 1024, 8, 16, 0, WBR, 512, 0)
        SEG(P.w_branch + ((size_t)l * 3 + 1) * 512 * 1024, 1024, 8, 16, 0, WBR + (size_t)1024 * 512, 512, 0)
        SEG(P.w_branch + ((size_t)l * 3 + 2) * 512 * 1024, 1024, 8, 16, 0, WBR + (size_t)2 * 1024 * 512, 512, 0)
        SEG(P.w_mix_out + (size_t)l * 1024 * 1024, 1024, 16, 16, 0, WMO, 1024, 0)
        if (r < 16 * 44) { const int kt = r / 44, ntl = r % 44; transpose_tile(P.w_ff_gate + (size_t)l * 1024 * FF, FF, kt * 64, ntl * 64, WFF, 1024, 256 * (ntl >> 1) + 64 * (ntl & 1), tile); continue; } r -= 16 * 44;
        if (r < 16 * 44) { const int kt = r / 44, ntl = r % 44; transpose_tile(P.w_ff_up + (size_t)l * 1024 * FF, FF, kt * 64, ntl * 64, WFF, 1024, 256 * (ntl >> 1) + 128 + 64 * (ntl & 1), tile); continue; } r -= 16 * 44;
        SEG(P.w_ff_down + (size_t)l * FF * 1024, 1024, 44, 16, 0, WD, FF, 0)
    }
#undef SEG
    { const int t = get_tid();
      if (l == 0 && blockIdx.x == 0 && t < 64) ((float*)(ws + WS_RC))[t] = exp2f(-(float)t * (13.287712379549449f / 64.0f)) * 0.15915494309189535f; }
}

__device__ __forceinline__ float wave_sum(float v) {
#pragma unroll
    for (int o = 32; o >= 1; o >>= 1) v += __shfl_xor(v, o);
    return v;
}

__device__ void phase_norm_alow(const Params& P, int l, int half, LAS unsigned char* lds) {
    const int tid = get_tid(), lane = tid & 63, wave = tid >> 6;
    LAS float* WaT = (LAS float*)lds;
    const float* win = P.w_in + (size_t)l * 1024 * IN_COLS + 1536;
    for (int i = tid; i < 1024 * 4; i += NTHR) { const int k = i >> 2, c4 = (i & 3) * 4; const f32x4 v = *(const f32x4*)(win + (size_t)k * IN_COLS + c4);
        WaT[(c4 + 0) * 1024 + k] = v[0]; WaT[(c4 + 1) * 1024 + k] = v[1]; WaT[(c4 + 2) * 1024 + k] = v[2]; WaT[(c4 + 3) * 1024 + k] = v[3]; }
    __syncthreads();
    const float* xs = (l == 0 ? P.x : P.out) + (size_t)half * TH * DM;
    const float* gg = P.pre_mix_g + (size_t)l * DM;
    bf16_t* H = (bf16_t*)(P.ws + WS_H) + (size_t)half * TH * DM; float* AL = (float*)(P.ws + WS_ALOW);
    f32x4 gv[4];
#pragma unroll
    for (int i = 0; i < 4; ++i) gv[i] = *(const f32x4*)(gg + i * 256 + lane * 4);
    const int rstride = gridDim.x * 8;
    int row = blockIdx.x * 8 + wave;
    f32x4 nv[4];
    if (row < TH) {
#pragma unroll
        for (int i = 0; i < 4; ++i) nv[i] = *(const f32x4*)(xs + (size_t)row * DM + i * 256 + lane * 4);
    }
    for (; row < TH; row += rstride) {
        f32x4 v[4]; float ss = 0.f;
#pragma unroll
        for (int i = 0; i < 4; ++i) { v[i] = nv[i]; ss += v[i][0] * v[i][0] + v[i][1] * v[i][1] + v[i][2] * v[i][2] + v[i][3] * v[i][3]; }
        if (row + rstride < TH) {
#pragma unroll
            for (int i = 0; i < 4; ++i) nv[i] = *(const f32x4*)(xs + (size_t)(row + rstride) * DM + i * 256 + lane * 4);
        }
        ss = wave_sum(ss);
        const float r = rsqrtf(ss * (1.0f / DM) + EPS);
        float a[16];
#pragma unroll
        for (int c = 0; c < 16; ++c) a[c] = 0.f;
#pragma unroll
        for (int i = 0; i < 4; ++i) { f32x4 h = v[i] * r * gv[i];
            u32x2 w; w.x = cvt_pk_bf16(h[0], h[1]); w.y = cvt_pk_bf16(h[2], h[3]);
            *(u32x2*)(H + (size_t)row * DM + i * 256 + lane * 4) = w;
#pragma unroll
            for (int c = 0; c < 16; ++c) { const f32x4 wv = *(const LAS f32x4*)(WaT + c * 1024 + i * 256 + lane * 4); a[c] += h[0] * wv[0] + h[1] * wv[1] + h[2] * wv[2] + h[3] * wv[3]; } }
        float b8[8], b4[4], b2[2], b1;
        { const bool up = (lane & 32) != 0;
#pragma unroll
          for (int c = 0; c < 8; ++c) { const float keep = up ? a[c + 8] : a[c], send = up ? a[c] : a[c + 8]; b8[c] = keep + __shfl_xor(send, 32); } }
        { const bool up = (lane & 16) != 0;
#pragma unroll
          for (int c = 0; c < 4; ++c) { const float keep = up ? b8[c + 4] : b8[c], send = up ? b8[c] : b8[c + 4]; b4[c] = keep + __shfl_xor(send, 16); } }
        { const bool up = (lane & 8) != 0;
#pragma unroll
          for (int c = 0; c < 2; ++c) { const float keep = up ? b4[c + 2] : b4[c], send = up ? b4[c] : b4[c + 2]; b2[c] = keep + __shfl_xor(send, 8); } }
        { const bool up = (lane & 4) != 0; const float keep = up ? b2[1] : b2[0], send = up ? b2[0] : b2[1]; b1 = keep + __shfl_xor(send, 4); }
        b1 += __shfl_xor(b1, 2); b1 += __shfl_xor(b1, 1);
        if ((lane & 3) == 0) { const int co = ((lane >> 5) & 1) * 8 + ((lane >> 4) & 1) * 4 + ((lane >> 3) & 1) * 2 + ((lane >> 2) & 1); AL[(size_t)row * 16 + co] = b1; }
    }
}

__device__ void phase_resid(const float* xin, float* xout, const bf16_t* Y, const float* pg, const float* ng, bf16_t* H2, int nrows) {
    const int tid = get_tid(), lane = tid & 63, wave = tid >> 6;
    f32x4 pgv[4], ngv[4];
#pragma unroll
    for (int i = 0; i < 4; ++i) { pgv[i] = *(const f32x4*)(pg + i * 256 + lane * 4); ngv[i] = ng ? *(const f32x4*)(ng + i * 256 + lane * 4) : (f32x4){0.f, 0.f, 0.f, 0.f}; }
    const int stride = gridDim.x * 8;
    int row = blockIdx.x * 8 + wave;
    u32x2 ny[4]; f32x4 nx[4];
    if (row < nrows) {
#pragma unroll
        for (int i = 0; i < 4; ++i) { ny[i] = *(const u32x2*)(Y + (size_t)row * DM + i * 256 + lane * 4); nx[i] = *(const f32x4*)(xin + (size_t)row * DM + i * 256 + lane * 4); }
    }
    for (; row < nrows; row += stride) {
        f32x4 y[4], xv[4];
#pragma unroll
        for (int i = 0; i < 4; ++i) { y[i] = (f32x4){bflo(ny[i].x), bfhi(ny[i].x), bflo(ny[i].y), bfhi(ny[i].y)}; xv[i] = nx[i]; }
        const int rn = row + stride;
        if (rn < nrows) {
#pragma unroll
            for (int i = 0; i < 4; ++i) { ny[i] = *(const u32x2*)(Y + (size_t)rn * DM + i * 256 + lane * 4); nx[i] = *(const f32x4*)(xin + (size_t)rn * DM + i * 256 + lane * 4); }
        }
        float ss = 0.f;
#pragma unroll
        for (int i = 0; i < 4; ++i) ss += y[i][0] * y[i][0] + y[i][1] * y[i][1] + y[i][2] * y[i][2] + y[i][3] * y[i][3];
        ss = wave_sum(ss);
        const float r = rsqrtf(ss * (1.0f / DM) + EPS);
        float s2 = 0.f;
#pragma unroll
        for (int i = 0; i < 4; ++i) { xv[i] = xv[i] + y[i] * r * pgv[i]; *(f32x4*)(xout + (size_t)row * DM + i * 256 + lane * 4) = xv[i];
            s2 += xv[i][0] * xv[i][0] + xv[i][1] * xv[i][1] + xv[i][2] * xv[i][2] + xv[i][3] * xv[i][3]; }
        if (ng) {
            s2 = wave_sum(s2);
            const float r2 = rsqrtf(s2 * (1.0f / DM) + EPS);
#pragma unroll
            for (int i = 0; i < 4; ++i) { const f32x4 h = xv[i] * r2 * ngv[i]; u32x2 w; w.x = cvt_pk_bf16(h[0], h[1]); w.y = cvt_pk_bf16(h[2], h[3]);
                *(u32x2*)(H2 + (size_t)row * DM + i * 256 + lane * 4) = w; }
        }
    }
}

__device__ void phase_combine(const Params& P) {
    bf16_t* Z = (bf16_t*)(P.ws + WS_Z); const float* LSE = (const float*)(P.ws + WS_LSE);
    const int stride = gridDim.x * NTHR;
    for (int idx0 = blockIdx.x * NTHR + get_tid(); idx0 < TH * 64; idx0 += 2 * stride) {
        float lw[2][3]; u32x4 va[2], vb[2], vc[2]; bf16_t* pp[2]; bool ok[2];
#pragma unroll
        for (int k = 0; k < 2; ++k) { const int idx = idx0 + k * stride; ok[k] = idx < TH * 64; const int id2 = ok[k] ? idx : idx0;
            const int tok = id2 >> 6, c8 = id2 & 63, hh = c8 >> 4, d0 = (c8 & 15) * 8;
            lw[k][0] = LSE[tok * 12 + hh]; lw[k][1] = LSE[tok * 12 + 4 + hh]; lw[k][2] = LSE[tok * 12 + 8 + hh];
            pp[k] = Z + (size_t)tok * ZC + ZDQ + hh * 128 + d0;
            va[k] = *(const u32x4*)pp[k]; vb[k] = *(const u32x4*)(pp[k] + 512); vc[k] = *(const u32x4*)(pp[k] + 1024); }
#pragma unroll
        for (int k = 0; k < 2; ++k) {
            const float mx = fmaxf(lw[k][0], fmaxf(lw[k][1], lw[k][2]));
            float w0 = __expf(lw[k][0] - mx), w1 = __expf(lw[k][1] - mx), w2 = __expf(lw[k][2] - mx);
            const float inv = 1.0f / (w0 + w1 + w2); w0 *= inv; w1 *= inv; w2 *= inv;
            float a[8], b[8], c[8], o[8];
            unpack8(va[k], a); unpack8(vb[k], b); unpack8(vc[k], c);
#pragma unroll
            for (int j = 0; j < 8; ++j) o[j] = w0 * a[j] + w1 * b[j] + w2 * c[j];
            if (ok[k]) *(u32x4*)pp[k] = pack8(o);
        }
    }
}

__device__ void phase_ffn_fix(const Params& P, int l) {
    bf16_t* ACT = (bf16_t*)(P.ws + WS_U); const float* HG = (const float*)(P.ws + WS_HG); const float* HU = (const float*)(P.ws + WS_HU);
    const float* cw = P.ff_conv_w + (size_t)l * 3 * FF; const float* cb = P.ff_conv_b + (size_t)l * FF;
    for (int idx = blockIdx.x * NTHR + get_tid(); idx < 128 * (FF / 8); idx += gridDim.x * NTHR) {
        const int pm = idx / (FF / 8), c0 = (idx % (FF / 8)) * 8;
        float o0[8], o1[8];
#pragma unroll
        for (int hf = 0; hf < 2; ++hf) {
            const int c = c0 + 4 * hf;
            const f32x4 z = (f32x4){0.f, 0.f, 0.f, 0.f};
            const bool first = (pm & 7) == 0;
            const f32x4 gm2 = first ? z : *(const f32x4*)(HG + ((size_t)(pm - 1) * 4 + 2) * FF + c), gm1 = first ? z : *(const f32x4*)(HG + ((size_t)(pm - 1) * 4 + 3) * FF + c);
            const f32x4 g0 = *(const f32x4*)(HG + ((size_t)pm * 4 + 0) * FF + c), g1 = *(const f32x4*)(HG + ((size_t)pm * 4 + 1) * FF + c);
            const f32x4 u0 = *(const f32x4*)(HU + ((size_t)pm * 2 + 0) * FF + c), u1 = *(const f32x4*)(HU + ((size_t)pm * 2 + 1) * FF + c);
            const f32x4 w0 = *(const f32x4*)(cw + c), w1 = *(const f32x4*)(cw + FF + c), w2 = *(const f32x4*)(cw + 2 * FF + c), bb = *(const f32x4*)(cb + c);
#pragma unroll
            for (int j = 0; j < 4; ++j) { o0[4 * hf + j] = pg8::gelu_tanh_mul(w0[j] * gm2[j] + w1[j] * gm1[j] + w2[j] * g0[j] + bb[j], u0[j]);
                                          o1[4 * hf + j] = pg8::gelu_tanh_mul(w0[j] * gm1[j] + w1[j] * g0[j] + w2[j] * g1[j] + bb[j], u1[j]); }
        }
        *(u32x4*)(ACT + (size_t)(pm * 256 + 0) * FF + c0) = pack8(o0);
        *(u32x4*)(ACT + (size_t)(pm * 256 + 1) * FF + c0) = pack8(o1);
    }
}

__device__ __forceinline__ void sc_item(const Params& P, int l, int si) {
    bf16_t* Z = (bf16_t*)(P.ws + WS_Z);
    const int tid = get_tid(), cgi = tid & 63, run = tid >> 6, c0 = cgi * 8, t0 = si * 128 + run * 16;
    const float* cw = P.sc_conv_w + (size_t)l * 3 * 512;
    float w0[8], w1[8], w2[8];
#pragma unroll
    for (int j = 0; j < 8; ++j) { w0[j] = cw[c0 + j]; w1[j] = cw[512 + c0 + j]; w2[j] = cw[1024 + c0 + j]; }
    float p1[8], p2[8];
    if ((t0 & 2047) != 0) {
        float a[8], b[8];
        unpack8(*(const u32x4*)(Z + (size_t)(t0 - 1) * ZC + ZSC + c0), a); unpack8(*(const u32x4*)(Z + (size_t)(t0 - 1) * ZC + ZSX + c0), b);
#pragma unroll
        for (int j = 0; j < 8; ++j) p1[j] = a[j] * b[j];
        unpack8(*(const u32x4*)(Z + (size_t)(t0 - 2) * ZC + ZSC + c0), a); unpack8(*(const u32x4*)(Z + (size_t)(t0 - 2) * ZC + ZSX + c0), b);
#pragma unroll
        for (int j = 0; j < 8; ++j) p2[j] = a[j] * b[j];
    } else {
#pragma unroll
        for (int j = 0; j < 8; ++j) { p1[j] = 0.f; p2[j] = 0.f; } }
    for (int tt = 0; tt < 16; tt += 4) {
        u32x4 va[4], vb[4], vs[4];
#pragma unroll
        for (int k = 0; k < 4; ++k) { const bf16_t* zr = Z + (size_t)(t0 + tt + k) * ZC; va[k] = *(const u32x4*)(zr + ZSC + c0); vb[k] = *(const u32x4*)(zr + ZSX + c0); vs[k] = *(const u32x4*)(zr + ZSB + c0); }
#pragma unroll
        for (int k = 0; k < 4; ++k) {
            float a[8], b[8], sb[8], o[8];
            unpack8(va[k], a); unpack8(vb[k], b); unpack8(vs[k], sb);
#pragma unroll
            for (int j = 0; j < 8; ++j) { const float p0 = a[j] * b[j]; o[j] = sb[j] * (w0[j] * p2[j] + w1[j] * p1[j] + w2[j] * p0); p2[j] = p1[j]; p1[j] = p0; }
            *(u32x4*)(Z + (size_t)(t0 + tt + k) * ZC + ZSB + c0) = pack8(o);
        }
    }
}

__device__ __forceinline__ void attn_item(const Params& P, int half, int item, LAS unsigned char* lds, unsigned* ctr) {
    const int tid = get_tid(), lane = tid & 63, w = __builtin_amdgcn_readfirstlane(tid >> 6), g = lane >> 4, c = lane & 15;
    const int b = item / 192, rem = item % 192, gi = rem / 64, r2 = rem % 64;
    const int dil = (gi == 0) ? 1 : (gi == 1 ? 4 : 16), nb = 16 / dil;
    const int n = r2 % nb, t2 = r2 / nb, hh = t2 & 3, rr = t2 >> 2;
    bf16_t* Z = (bf16_t*)(P.ws + WS_Z);
    const float* RC = (const float*)(P.ws + WS_RC); const float* RS = (const float*)(P.ws + WS_RS);
    float* LSE = (float*)(P.ws + WS_LSE);
    const int colq = ZDQ + gi * 512 + hh * 128, colk = ZDK + gi * 512 + hh * 128, colv = ZDV + gi * 512 + hh * 128;
    const int rowb = b * 2048, gtb = half * TH;
    constexpr int KSTR = 272, VSTR = 528;
    LAS unsigned char* Ks = lds; LAS unsigned char* Vt = lds + 256 * KSTR;
    constexpr float QSCALE = 0.08838834764831845f * 1.4426950408889634f;

    const int km = tid >> 1, khf = tid & 1, klk = (n - 1) * 128 + km;
    const int vkb = tid & 31, vdb = tid >> 5, vlk0 = (n - 1) * 128 + vkb * 8;
    const int qi = 16 * w + c, qrow = rowb + (n * 128 + qi) * dil + rr;
    u32x4 kx1[4], kx2[4]; f32x4 kinv[8]; float kpos = 0.f;
    u32x4 rv[8];
    u32x4 qx1[2], qx2[2]; f32x4 qinv[4]; float qpos;
    if (klk >= 0) {
        const int krow = rowb + klk * dil + rr;
        const bf16_t* kp = Z + (size_t)krow * ZC + colk + khf * 32;
        kpos = (float)P.pos[gtb + krow];
#pragma unroll
        for (int cc = 0; cc < 4; ++cc) { kx1[cc] = *(const u32x4*)(kp + cc * 8); kx2[cc] = *(const u32x4*)(kp + 64 + cc * 8);
            kinv[2 * cc] = *(const f32x4*)(RC + khf * 32 + cc * 8); kinv[2 * cc + 1] = *(const f32x4*)(RC + khf * 32 + cc * 8 + 4); }
    } else {
#pragma unroll
        for (int cc = 0; cc < 4; ++cc) { kx1[cc] = (u32x4){0u, 0u, 0u, 0u}; kx2[cc] = (u32x4){0u, 0u, 0u, 0u};
            kinv[2 * cc] = (f32x4){0.f, 0.f, 0.f, 0.f}; kinv[2 * cc + 1] = (f32x4){0.f, 0.f, 0.f, 0.f}; }
    }
    if (vlk0 >= 0) {
#pragma unroll
        for (int kk = 0; kk < 8; ++kk) { const int row = rowb + (vlk0 + kk) * dil + rr; rv[kk] = *(const u32x4*)(Z + (size_t)row * ZC + colv + vdb * 8); }
    } else {
#pragma unroll
        for (int kk = 0; kk < 8; ++kk) rv[kk] = (u32x4){0u, 0u, 0u, 0u};
    }
    {
        const bf16_t* qp = Z + (size_t)qrow * ZC + colq + 8 * g;
        qpos = (float)P.pos[gtb + qrow];
#pragma unroll
        for (int kh = 0; kh < 2; ++kh) { qx1[kh] = *(const u32x4*)(qp + kh * 32); qx2[kh] = *(const u32x4*)(qp + 64 + kh * 32);
            qinv[2 * kh] = *(const f32x4*)(RC + kh * 32 + 8 * g); qinv[2 * kh + 1] = *(const f32x4*)(RC + kh * 32 + 8 * g + 4); }
    }
    {
        LAS unsigned char* kd = Ks + km * KSTR;
#pragma unroll
        for (int cc = 0; cc < 4; ++cc) {
            float x1[8], x2[8], o1[8], o2[8];
            unpack8(kx1[cc], x1); unpack8(kx2[cc], x2);
            f32x4 c0, c1, s0, s1;
#pragma unroll
            for (int j = 0; j < 4; ++j) { const float r0 = __builtin_amdgcn_fractf(kpos * kinv[2 * cc][j]), r1 = __builtin_amdgcn_fractf(kpos * kinv[2 * cc + 1][j]);
                c0[j] = __builtin_amdgcn_cosf(r0); s0[j] = __builtin_amdgcn_sinf(r0); c1[j] = __builtin_amdgcn_cosf(r1); s1[j] = __builtin_amdgcn_sinf(r1); }
#pragma unroll
            for (int j = 0; j < 4; j += 2) {
                { const f32x2 X1 = (f32x2){x1[j], x1[j + 1]}, X2 = (f32x2){x2[j], x2[j + 1]}, C = (f32x2){c0[j], c0[j + 1]}, Sn = (f32x2){s0[j], s0[j + 1]};
                  const f32x2 A = X1 * C - X2 * Sn, B = X2 * C + X1 * Sn; o1[j] = A.x; o1[j + 1] = A.y; o2[j] = B.x; o2[j + 1] = B.y; }
                { const f32x2 X1 = (f32x2){x1[4 + j], x1[5 + j]}, X2 = (f32x2){x2[4 + j], x2[5 + j]}, C = (f32x2){c1[j], c1[j + 1]}, Sn = (f32x2){s1[j], s1[j + 1]};
                  const f32x2 A = X1 * C - X2 * Sn, B = X2 * C + X1 * Sn; o1[4 + j] = A.x; o1[5 + j] = A.y; o2[4 + j] = B.x; o2[5 + j] = B.y; } }
            *(LAS u32x4*)(kd + (khf * 32 + cc * 8) * 2) = pack8(o1); *(LAS u32x4*)(kd + (64 + khf * 32 + cc * 8) * 2) = pack8(o2);
        }
    }
    {
#pragma unroll
        for (int dd = 0; dd < 8; ++dd) {
            const int wi = dd >> 1; u32x4 o;
            if (dd & 1) { o.x = __builtin_amdgcn_perm(rv[1][wi], rv[0][wi], 0x07060302u); o.y = __builtin_amdgcn_perm(rv[3][wi], rv[2][wi], 0x07060302u); o.z = __builtin_amdgcn_perm(rv[5][wi], rv[4][wi], 0x07060302u); o.w = __builtin_amdgcn_perm(rv[7][wi], rv[6][wi], 0x07060302u); }
            else { o.x = __builtin_amdgcn_perm(rv[1][wi], rv[0][wi], 0x05040100u); o.y = __builtin_amdgcn_perm(rv[3][wi], rv[2][wi], 0x05040100u); o.z = __builtin_amdgcn_perm(rv[5][wi], rv[4][wi], 0x05040100u); o.w = __builtin_amdgcn_perm(rv[7][wi], rv[6][wi], 0x05040100u); }
            *(LAS u32x4*)(Vt + (vdb * 8 + dd) * VSTR + vkb * 16) = o;
        }
    }
    bf16x8 Qf[4];
    {
#pragma unroll
        for (int kh = 0; kh < 2; ++kh) {
            float x1[8], x2[8], o1[8], o2[8];
            unpack8(qx1[kh], x1); unpack8(qx2[kh], x2);
            f32x4 c0, c1, s0, s1;
#pragma unroll
            for (int j = 0; j < 4; ++j) { const float r0 = __builtin_amdgcn_fractf(qpos * qinv[2 * kh][j]), r1 = __builtin_amdgcn_fractf(qpos * qinv[2 * kh + 1][j]);
                c0[j] = __builtin_amdgcn_cosf(r0); s0[j] = __builtin_amdgcn_sinf(r0); c1[j] = __builtin_amdgcn_cosf(r1); s1[j] = __builtin_amdgcn_sinf(r1); }
#pragma unroll
            for (int j = 0; j < 4; j += 2) {
                { const f32x2 X1 = (f32x2){x1[j], x1[j + 1]} * QSCALE, X2 = (f32x2){x2[j], x2[j + 1]} * QSCALE, C = (f32x2){c0[j], c0[j + 1]}, Sn = (f32x2){s0[j], s0[j + 1]};
                  const f32x2 A = X1 * C - X2 * Sn, B = X2 * C + X1 * Sn; o1[j] = A.x; o1[j + 1] = A.y; o2[j] = B.x; o2[j + 1] = B.y; }
                { const f32x2 X1 = (f32x2){x1[4 + j], x1[5 + j]} * QSCALE, X2 = (f32x2){x2[4 + j], x2[5 + j]} * QSCALE, C = (f32x2){c1[j], c1[j + 1]}, Sn = (f32x2){s1[j], s1[j + 1]};
                  const f32x2 A = X1 * C - X2 * Sn, B = X2 * C + X1 * Sn; o1[4 + j] = A.x; o1[5 + j] = A.y; o2[4 + j] = B.x; o2[5 + j] = B.y; } }
            Qf[kh] = as_bf16x8(pack8(o1)); Qf[kh + 2] = as_bf16x8(pack8(o2));
        }
    }
    __syncthreads();
    unsigned nxt_id = 0u;
    if (tid == 0) nxt_id = atomicAdd(ctr, 1u);
    const int m0 = (16 * w < 96) ? 16 * w : 96;
    f32x4 S[10];
#pragma unroll
    for (int jt = 0; jt < 10; ++jt) {
        S[jt] = (f32x4){0.f, 0.f, 0.f, 0.f};
        const LAS unsigned char* kr = Ks + (m0 + jt * 16 + c) * KSTR + 16 * g;
#pragma unroll
        for (int ks = 0; ks < 4; ++ks) { const bf16x8 a = *(const LAS bf16x8*)(kr + ks * 64); S[jt] = __builtin_amdgcn_mfma_f32_16x16x32_bf16(a, Qf[ks], S[jt], 0, 0, 0); }
    }
    float mx = -INFINITY;
    const int dbase = qi + 128 - m0 - 4 * g;
    const unsigned dlim = (unsigned)((n == 0) ? (qi < 128 ? qi : 128) : 128);
#pragma unroll
    for (int jt = 0; jt < 10; ++jt)
#pragma unroll
        for (int jj = 0; jj < 4; ++jj) { const bool ok = (unsigned)(dbase - (jt * 16 + jj)) <= dlim;
            const float s = ok ? S[jt][jj] : -INFINITY; S[jt][jj] = s; mx = fmaxf(mx, s); }
    mx = fmaxf(mx, __shfl_xor(mx, 16)); mx = fmaxf(mx, __shfl_xor(mx, 32));
    float den = 0.f;
#pragma unroll
    for (int jt = 0; jt < 10; ++jt) { const f32x4 d = S[jt] - mx; f32x4 p; p[0] = __builtin_amdgcn_exp2f(d[0]); p[1] = __builtin_amdgcn_exp2f(d[1]); p[2] = __builtin_amdgcn_exp2f(d[2]); p[3] = __builtin_amdgcn_exp2f(d[3]);
        S[jt] = p; den += (p[0] + p[1]) + (p[2] + p[3]); }
    den += __shfl_xor(den, 16); den += __shfl_xor(den, 32);
    bf16x8 Pf[5];
#pragma unroll
    for (int k5 = 0; k5 < 5; ++k5) { u32x4 pw; pw.x = cvt_pk_bf16(S[2 * k5][0], S[2 * k5][1]); pw.y = cvt_pk_bf16(S[2 * k5][2], S[2 * k5][3]); pw.z = cvt_pk_bf16(S[2 * k5 + 1][0], S[2 * k5 + 1][1]); pw.w = cvt_pk_bf16(S[2 * k5 + 1][2], S[2 * k5 + 1][3]); Pf[k5] = as_bf16x8(pw); }
    const float inv = 1.0f / den;
    bf16_t* op = Z + (size_t)qrow * ZC + colq + 4 * g;
#pragma unroll
    for (int dt = 0; dt < 8; ++dt) {
        f32x4 O = (f32x4){0.f, 0.f, 0.f, 0.f};
        const LAS unsigned char* vr = Vt + (dt * 16 + c) * VSTR + (m0 + 4 * g) * 2;
#pragma unroll
        for (int k5 = 0; k5 < 5; ++k5) { const u32x2 lo = *(const LAS u32x2*)(vr + k5 * 64), hi = *(const LAS u32x2*)(vr + k5 * 64 + 32);
            const bf16x8 a = as_bf16x8((u32x4){lo.x, lo.y, hi.x, hi.y}); O = __builtin_amdgcn_mfma_f32_16x16x32_bf16(a, Pf[k5], O, 0, 0, 0); }
        u32x2 ow; ow.x = cvt_pk_bf16(O[0] * inv, O[1] * inv); ow.y = cvt_pk_bf16(O[2] * inv, O[3] * inv);
        *(u32x2*)(op + dt * 16) = ow;
    }
    if (g == 0) LSE[(size_t)qrow * 12 + gi * 4 + hh] = (mx + __builtin_amdgcn_logf(den)) * 0.6931471805599453f;
    if (tid == 0) *(LAS unsigned*)(lds + LDS_SLOT) = nxt_id;
    __syncthreads();
}

__device__ __forceinline__ float logsig16(float x) { return (fminf(x, 0.f) - __logf(1.0f + __expf(-fabsf(x)))) * (1.0f / 16.0f); }

#define LBAR() do { asm volatile("s_waitcnt lgkmcnt(0)" ::: "memory"); __builtin_amdgcn_s_barrier(); asm volatile("" ::: "memory"); } while (0)
__device__ void gla_item(const Params& P, int l, int b, int h, int seg, LAS unsigned char* lds) {
    const int tid = get_tid(), lane = tid & 63, w = __builtin_amdgcn_readfirstlane(tid >> 6), g = lane >> 4, c = lane & 15;
    bf16_t* Z = (bf16_t*)(P.ws + WS_Z); const float* AL = (const float*)(P.ws + WS_ALOW);
    LAS float* WUP = (LAS float*)(lds + 0);
    LAS float* BUP = (LAS float*)(lds + 4096);
    LAS float* ARAW = (LAS float*)(lds + 4352);
    LAS float* LC = (LAS float*)(lds + 8448);
    LAS float* SEG = (LAS float*)(lds + 24832);
    LAS float* DEC = (LAS float*)(lds + 26880);
    LAS unsigned char* QP = lds + 29184;
    LAS unsigned char* KP = lds + 38400;
    LAS unsigned char* KPP = lds + 47616;
    LAS unsigned char* AIN = lds + 56832;
    LAS unsigned char* VS = lds + 66048;
    LAS unsigned char* OT = lds + 83456;
    constexpr int QS = 144, VSS = 272;
    for (int i = tid; i < 1024; i += NTHR) { const int r = i >> 6, d = i & 63; WUP[i] = P.w_alpha_up[((size_t)l * 16 + r) * 256 + h * 64 + d]; }
    if (tid < 64) BUP[tid] = P.b_alpha[(size_t)l * 256 + h * 64 + tid];
    f32x4 Sacc[4];
#pragma unroll
    for (int dt = 0; dt < 4; ++dt) Sacc[dt] = (f32x4){0.f, 0.f, 0.f, 0.f};
    const int rowb = b * 2048 + seg * 256;
    const int t_ = tid >> 3, d8 = (tid & 7) * 8;
    u32x4 nq, nk, nv0, nv1; f32x4 na = (f32x4){0.f, 0.f, 0.f, 0.f};
    {
        const size_t r0 = (size_t)(rowb + t_) * ZC;
        nq = *(const u32x4*)(Z + r0 + ZQ + h * 64 + d8); nk = *(const u32x4*)(Z + r0 + ZK + h * 64 + d8);
        nv0 = *(const u32x4*)(Z + (size_t)(rowb + (tid >> 4)) * ZC + ZV + h * 128 + (tid & 15) * 8);
        nv1 = *(const u32x4*)(Z + (size_t)(rowb + 32 + (tid >> 4)) * ZC + ZV + h * 128 + (tid & 15) * 8);
        if (tid < 256) na = *(const f32x4*)(AL + (size_t)(rowb + (tid >> 2)) * 16 + (tid & 3) * 4);
    }
    float Lseg[8];
#pragma unroll
    for (int j = 0; j < 8; ++j) Lseg[j] = 0.f;
    float* DSEG = (float*)(P.ws + WS_DSEG);
    for (int n = 0; n < 4; ++n) {
        if ((n & 3) == 0) {
#pragma unroll
            for (int dt = 0; dt < 4; ++dt) Sacc[dt] = (f32x4){0.f, 0.f, 0.f, 0.f};
#pragma unroll
            for (int j = 0; j < 8; ++j) Lseg[j] = 0.f;
        }
        const int row0 = rowb + n * 64;
        const u32x4 cq = nq, ck = nk;
        *(LAS u32x4*)(VS + (tid >> 4) * VSS + (tid & 15) * 16) = nv0;
        *(LAS u32x4*)(VS + (32 + (tid >> 4)) * VSS + (tid & 15) * 16) = nv1;
        if (tid < 256) *(LAS f32x4*)(ARAW + (tid >> 2) * 16 + (tid & 3) * 4) = na;
        if (n + 1 < 4) {
            const int rn = row0 + 64; const size_t r0 = (size_t)(rn + t_) * ZC;
            nq = *(const u32x4*)(Z + r0 + ZQ + h * 64 + d8); nk = *(const u32x4*)(Z + r0 + ZK + h * 64 + d8);
            nv0 = *(const u32x4*)(Z + (size_t)(rn + (tid >> 4)) * ZC + ZV + h * 128 + (tid & 15) * 8);
            nv1 = *(const u32x4*)(Z + (size_t)(rn + 32 + (tid >> 4)) * ZC + ZV + h * 128 + (tid & 15) * 8);
            if (tid < 256) na = *(const f32x4*)(AL + (size_t)(rn + (tid >> 2)) * 16 + (tid & 3) * 4);
        }
        LBAR();
        {
            float x[8];
#pragma unroll
            for (int j = 0; j < 8; ++j) x[j] = BUP[d8 + j];
#pragma unroll
            for (int r = 0; r < 16; ++r) { const float a = ARAW[t_ * 16 + r]; const f32x4 w0 = *(const LAS f32x4*)(WUP + r * 64 + d8), w1 = *(const LAS f32x4*)(WUP + r * 64 + d8 + 4);
#pragma unroll
                for (int j = 0; j < 4; ++j) { x[j] += a * w0[j]; x[4 + j] += a * w1[j]; } }
            f32x4 o0, o1;
#pragma unroll
            for (int j = 0; j < 4; ++j) { o0[j] = logsig16(x[j]); o1[j] = logsig16(x[4 + j]); }
            *(LAS f32x4*)(LC + t_ * 64 + d8) = o0; *(LAS f32x4*)(LC + t_ * 64 + d8 + 4) = o1;
        }
        LBAR();
        {
            const int d = tid & 63, sg = tid >> 6; float cum[8]; float run = 0.f;
#pragma unroll
            for (int i = 0; i < 8; ++i) { run += LC[(sg * 8 + i) * 64 + d]; cum[i] = run; }
            SEG[sg * 64 + d] = run;
            LBAR();
            float off = 0.f;
#pragma unroll
            for (int s = 0; s < 7; ++s) off += (s < sg) ? SEG[s * 64 + d] : 0.f;
#pragma unroll
            for (int i = 0; i < 8; ++i) LC[(sg * 8 + i) * 64 + d] = cum[i] + off;
        }
        LBAR();
        {
            const f32x4 L0 = *(const LAS f32x4*)(LC + t_ * 64 + d8), L1 = *(const LAS f32x4*)(LC + t_ * 64 + d8 + 4);
            const f32x4 E0 = *(const LAS f32x4*)(LC + 63 * 64 + d8), E1 = *(const LAS f32x4*)(LC + 63 * 64 + d8 + 4);
            float qf[8], kf[8], qo[8], ko[8], k2[8], q2[8];
            unpack8(cq, qf); unpack8(ck, kf);
#pragma unroll
            for (int j = 0; j < 8; ++j) { const float L = (j < 4) ? L0[j & 3] : L1[j & 3], Le = (j < 4) ? E0[j & 3] : E1[j & 3];
                qo[j] = qf[j] * __expf(L) * 0.125f; ko[j] = kf[j] * __expf(-L); k2[j] = kf[j] * __expf(Le - L); q2[j] = qf[j] * __expf(L + Lseg[j]) * 0.125f; Lseg[j] += Le; }
            *(LAS u32x4*)(QP + t_ * QS + d8 * 2) = pack8(qo); *(LAS u32x4*)(KP + t_ * QS + d8 * 2) = pack8(ko); *(LAS u32x4*)(KPP + t_ * QS + d8 * 2) = pack8(k2);
            *(u32x4*)(Z + (size_t)(row0 + t_) * ZC + ZQ + h * 64 + d8) = pack8(q2);
            if (t_ == 0) {
#pragma unroll
                for (int j = 0; j < 8; ++j) DEC[d8 + j] = __expf((j < 4) ? E0[j & 3] : E1[j & 3]); }
        }
        LBAR();
#pragma unroll
        for (int q = 0; q < 2; ++q) {
            const int idx = 2 * w + q, it = idx >> 2, jt = idx & 3;
            f32x4 A = (f32x4){0.f, 0.f, 0.f, 0.f};
            if (jt <= it) {
#pragma unroll
                for (int ks = 0; ks < 2; ++ks) { const bf16x8 a = *(const LAS bf16x8*)(QP + (it * 16 + c) * QS + (ks * 32 + 8 * g) * 2), bb = *(const LAS bf16x8*)(KP + (jt * 16 + c) * QS + (ks * 32 + 8 * g) * 2);
                    A = __builtin_amdgcn_mfma_f32_16x16x32_bf16(a, bb, A, 0, 0, 0); }
            }
#pragma unroll
            for (int jj = 0; jj < 4; ++jj) { const int i = it * 16 + 4 * g + jj, j = jt * 16 + c; const float v = (j <= i) ? A[jj] : 0.f;
                *(LAS unsigned short*)(AIN + i * QS + j * 2) = f2bf(v); }
        }
        LBAR();
        bf16x8 Vb[2];
#pragma unroll
        for (int ks = 0; ks < 2; ++ks) { unsigned short e[8];
#pragma unroll
            for (int j = 0; j < 8; ++j) e[j] = *(const LAS unsigned short*)(VS + (ks * 32 + 8 * g + j) * VSS + (16 * w + c) * 2);
            u32x4 pw; pw.x = e[0] | ((unsigned)e[1] << 16); pw.y = e[2] | ((unsigned)e[3] << 16); pw.z = e[4] | ((unsigned)e[5] << 16); pw.w = e[6] | ((unsigned)e[7] << 16); Vb[ks] = as_bf16x8(pw); }
        bf16x8 Sb[2];
#pragma unroll
        for (int k2 = 0; k2 < 2; ++k2) { u32x4 pw; pw.x = cvt_pk_bf16(Sacc[2 * k2][0], Sacc[2 * k2][1]); pw.y = cvt_pk_bf16(Sacc[2 * k2][2], Sacc[2 * k2][3]);
            pw.z = cvt_pk_bf16(Sacc[2 * k2 + 1][0], Sacc[2 * k2 + 1][1]); pw.w = cvt_pk_bf16(Sacc[2 * k2 + 1][2], Sacc[2 * k2 + 1][3]); Sb[k2] = as_bf16x8(pw); }
        f32x4 Oacc[4];
#pragma unroll
        for (int it = 0; it < 4; ++it) {
            Oacc[it] = (f32x4){0.f, 0.f, 0.f, 0.f};
#pragma unroll
            for (int ks = 0; ks < 2; ++ks) { const bf16x8 a = *(const LAS bf16x8*)(AIN + (it * 16 + c) * QS + (ks * 32 + 8 * g) * 2); Oacc[it] = __builtin_amdgcn_mfma_f32_16x16x32_bf16(a, Vb[ks], Oacc[it], 0, 0, 0); }
#pragma unroll
            for (int k2 = 0; k2 < 2; ++k2) { const u32x2 lo = *(const LAS u32x2*)(QP + (it * 16 + c) * QS + (32 * k2 + 4 * g) * 2), hi = *(const LAS u32x2*)(QP + (it * 16 + c) * QS + (32 * k2 + 16 + 4 * g) * 2);
                const bf16x8 a = as_bf16x8((u32x4){lo.x, lo.y, hi.x, hi.y}); Oacc[it] = __builtin_amdgcn_mfma_f32_16x16x32_bf16(a, Sb[k2], Oacc[it], 0, 0, 0); }
        }
#pragma unroll
        for (int dt = 0; dt < 4; ++dt) {
            const f32x4 dc = *(const LAS f32x4*)(DEC + dt * 16 + 4 * g);
            Sacc[dt] = Sacc[dt] * dc;
#pragma unroll
            for (int ks = 0; ks < 2; ++ks) { unsigned short e[8];
#pragma unroll
                for (int j = 0; j < 8; ++j) e[j] = *(const LAS unsigned short*)(KPP + (ks * 32 + 8 * g + j) * QS + (dt * 16 + c) * 2);
                u32x4 pw; pw.x = e[0] | ((unsigned)e[1] << 16); pw.y = e[2] | ((unsigned)e[3] << 16); pw.z = e[4] | ((unsigned)e[5] << 16); pw.w = e[6] | ((unsigned)e[7] << 16);
                Sacc[dt] = __builtin_amdgcn_mfma_f32_16x16x32_bf16(as_bf16x8(pw), Vb[ks], Sacc[dt], 0, 0, 0); }
        }
#pragma unroll
        for (int it = 0; it < 4; ++it)
#pragma unroll
            for (int jj = 0; jj < 4; ++jj) *(LAS unsigned short*)(OT + (it * 16 + 4 * g + jj) * VSS + (16 * w + c) * 2) = f2bf(Oacc[it][jj]);
        LBAR();
        {
            const u32x4 o0 = *(const LAS u32x4*)(OT + (tid >> 4) * VSS + (tid & 15) * 16), o1 = *(const LAS u32x4*)(OT + (32 + (tid >> 4)) * VSS + (tid & 15) * 16);
            *(u32x4*)(Z + (size_t)(row0 + (tid >> 4)) * ZC + ZV + h * 128 + (tid & 15) * 8) = o0;
            *(u32x4*)(Z + (size_t)(row0 + 32 + (tid >> 4)) * ZC + ZV + h * 128 + (tid & 15) * 8) = o1;
        }
        if ((n & 3) == 3) {
            const int rs0 = rowb;
#pragma unroll
            for (int dt = 0; dt < 4; ++dt)
#pragma unroll
                for (int jj = 0; jj < 4; ++jj) { const int d = dt * 16 + 4 * g + jj, dv = 16 * w + c; *((float*)(Z + (size_t)(rs0 + d * 4 + (dv >> 5)) * ZC + ZK + h * 64) + (dv & 31)) = Sacc[dt][jj]; }            if (t_ == 0) {
#pragma unroll
                for (int j = 0; j < 8; ++j) DSEG[(size_t)((b * 4 + h) * 8 + seg) * 64 + d8 + j] = __expf(Lseg[j]); }
        }
    }
    __syncthreads();
}


__device__ __forceinline__ float dpp_row_sum16(float v) {
    v += __int_as_float(__builtin_amdgcn_update_dpp(0, __float_as_int(v), 0xB1, 0xf, 0xf, false));
    v += __int_as_float(__builtin_amdgcn_update_dpp(0, __float_as_int(v), 0x4E, 0xf, 0xf, false));
    v += __int_as_float(__builtin_amdgcn_update_dpp(0, __float_as_int(v), 0x141, 0xf, 0xf, false));
    v += __int_as_float(__builtin_amdgcn_update_dpp(0, __float_as_int(v), 0x140, 0xf, 0xf, false));
    return v;
}
__device__ void gla_C(const Params& P, int l, int item, LAS unsigned char* lds) {
    const int tid = get_tid(), lane = tid & 63, w = __builtin_amdgcn_readfirstlane(tid >> 6), g = lane >> 4, c = lane & 15;
    const int seg = item & 7, bh = item >> 3, b = bh >> 2, h = bh & 3;
    bf16_t* Z = (bf16_t*)(P.ws + WS_Z);
    LAS float* SSQ = (LAS float*)lds;
    LAS unsigned char* OT = lds + 8192;
    LAS unsigned char* GTL = lds + 8192 + 256 * 272;
    const float ng = P.gla_norm_g[(size_t)l * 128 + 16 * w + c];
    const float* DSEG = (const float*)(P.ws + WS_DSEG);
    float Sin[2][8];
#pragma unroll
    for (int ks = 0; ks < 2; ++ks)
#pragma unroll
        for (int e = 0; e < 8; ++e) Sin[ks][e] = 0.f;
    for (int sq = 0; sq < seg; ++sq) {
        const int rs0 = b * 2048 + sq * 256; const size_t it2 = (size_t)bh * 8 + sq;
#pragma unroll
        for (int ks = 0; ks < 2; ++ks)
#pragma unroll
            for (int e = 0; e < 8; ++e) { const int d = ks * 32 + 8 * g + e, dv = 16 * w + c;
                Sin[ks][e] = DSEG[it2 * 64 + d] * Sin[ks][e] + *((const float*)(Z + (size_t)(rs0 + d * 4 + (dv >> 5)) * ZC + ZK + h * 64) + (dv & 31)); }
    }
    bf16x8 Sb[2];
#pragma unroll
    for (int ks = 0; ks < 2; ++ks) Sb[ks] = as_bf16x8(pack8(Sin[ks]));
    const int row0 = b * 2048 + seg * 256;
    {
        u32x4 ov[8], gv[8];
#pragma unroll
        for (int i = 0; i < 8; ++i) { const int p = tid + i * NTHR, r = p >> 4, sg = p & 15; const bf16_t* zr = Z + (size_t)(row0 + r) * ZC + h * 128 + sg * 8; ov[i] = *(const u32x4*)(zr + ZV); gv[i] = *(const u32x4*)(zr + ZG); }
#pragma unroll
        for (int i = 0; i < 8; ++i) { const int p = tid + i * NTHR, r = p >> 4, sg = p & 15; *(LAS u32x4*)(OT + r * 272 + sg * 16) = ov[i]; *(LAS u32x2*)(GTL + r * 264 + sg * 16) = (u32x2){gv[i].x, gv[i].y}; *(LAS u32x2*)(GTL + r * 264 + sg * 16 + 8) = (u32x2){gv[i].z, gv[i].w}; }
    }
    __syncthreads();
    f32x4 O[16];
#pragma unroll
    for (int rt = 0; rt < 16; ++rt) {
#pragma unroll
        for (int jj = 0; jj < 4; ++jj) O[rt][jj] = bf2f(*(const LAS unsigned short*)(OT + (rt * 16 + 4 * g + jj) * 272 + (16 * w + c) * 2));
        if (seg > 0) {
#pragma unroll
            for (int ks = 0; ks < 2; ++ks) { const bf16x8 a = as_bf16x8(*(const u32x4*)(Z + (size_t)(row0 + rt * 16 + c) * ZC + ZQ + h * 64 + ks * 32 + 8 * g)); O[rt] = __builtin_amdgcn_mfma_f32_16x16x32_bf16(a, Sb[ks], O[rt], 0, 0, 0); }
        }
    }
    {
#pragma unroll
        for (int rt = 0; rt < 16; ++rt) {
            float sv[4];
#pragma unroll
            for (int jj = 0; jj < 4; ++jj) sv[jj] = O[rt][jj] * O[rt][jj];
#pragma unroll
            for (int jj = 0; jj < 4; ++jj) sv[jj] = dpp_row_sum16(sv[jj]);
            if (c == 0) {
#pragma unroll
                for (int jj = 0; jj < 4; ++jj) SSQ[w * 256 + rt * 16 + 4 * g + jj] = sv[jj]; }
        }
    }
    __syncthreads();
#pragma unroll
    for (int rt = 0; rt < 16; ++rt)
#pragma unroll
        for (int jj = 0; jj < 4; ++jj) { const int t = rt * 16 + 4 * g + jj; float tot = 0.f;
#pragma unroll
            for (int ww = 0; ww < 8; ++ww) tot += SSQ[ww * 256 + t];
            const float rs = rsqrtf(tot * (1.0f / 128.0f) + EPS);
            const float gt = bf2f(*(const LAS unsigned short*)(GTL + t * 264 + (16 * w + c) * 2));
            *(LAS unsigned short*)(OT + t * 272 + (16 * w + c) * 2) = f2bf(O[rt][jj] * rs * ng * (gt * __builtin_amdgcn_rcpf(1.0f + __expf(-gt)))); }
    __syncthreads();
#pragma unroll
    for (int i = 0; i < 8; ++i) { const int p = tid + i * NTHR, r = p >> 4, sg = p & 15;
        *(u32x4*)(Z + (size_t)(row0 + r) * ZC + ZG + h * 128 + sg * 8) = *(const LAS u32x4*)(OT + r * 272 + sg * 16); }
    __syncthreads();
}

__device__ __forceinline__ int next_item(unsigned* ctr, LAS unsigned char* lds) {
    __syncthreads();
    if (threadIdx.x == 0) *(LAS unsigned*)(lds + LDS_SLOT) = atomicAdd(ctr, 1u);
    __syncthreads();
    return (int)*(LAS unsigned*)(lds + LDS_SLOT);
}

__device__ void phase_branches(const Params& P, int l, int half, LAS unsigned char* lds) {
    unsigned* ctr = (unsigned*)(P.ws + WS_CTL) + 64 * (l * 2 + half);
    for (int it = blockIdx.x; it < 256; it += gridDim.x) gla_item(P, l, it >> 5, (it >> 3) & 3, it & 7, lds);
    int it = next_item(ctr, lds);
    while (it < 1536 + 128) {
        if (it < 1536) { attn_item(P, half, it, lds, ctr); it = (int)*(LAS unsigned*)(lds + LDS_SLOT); }
        else { sc_item(P, l, it - 1536); it = next_item(ctr, lds); }
    }
}


#define XB_TMO      128
#define XB_XCNT(j)  (256  + 64 * (j))
#define XB_XSUB(j)  (1280 + 64 * (j))
#define XB_XGEN(j)  (2304 + 64 * (j))
#define XB_TOP      3328
#define XB_TOPGEN   3392
#define XCD_BAR_WORDS 3456
#define XB_SPIN_CAP (1u << 20)
__device__ __forceinline__ unsigned xb_ld(unsigned* p)              { return __hip_atomic_load(p, __ATOMIC_RELAXED, __HIP_MEMORY_SCOPE_AGENT); }
__device__ __forceinline__ unsigned xb_add(unsigned* p, unsigned v) { return __hip_atomic_fetch_add(p, v, __ATOMIC_RELAXED, __HIP_MEMORY_SCOPE_AGENT); }
__device__ __forceinline__ unsigned xb_xcc_id() { return (unsigned)__builtin_amdgcn_s_getreg((3 << 11) | 20) & 0xFu; }
#define XB_SPIN(cond, bar) do { unsigned _sp = 0; while (cond) { __builtin_amdgcn_s_sleep(1); \
    if ((++_sp & 255u) == 0u) { if (xb_ld(&(bar)[XB_TMO])) break; if (_sp > XB_SPIN_CAP) { atomicAdd(&(bar)[XB_TMO], 1u); break; } } } } while (0)
struct XcdBarrier { unsigned* bar; unsigned x; volatile LAS unsigned* st; };
__device__ __forceinline__ XcdBarrier xcd_barrier_post(unsigned* bar, volatile LAS unsigned* st) {
    XcdBarrier b; b.bar = bar; b.x = xb_xcc_id(); b.st = st;
    if (threadIdx.x == 0) (void)xb_add(&bar[XB_XCNT(b.x)], 1u);
    return b;
}
__device__ __forceinline__ void xcd_barrier_complete(unsigned* bar, unsigned x, unsigned& nloc, unsigned& nx) {
    const unsigned G = gridDim.x * gridDim.y * gridDim.z;
    unsigned sum, cnt, mine, sp = 0u;
    for (;;) {
        sum = 0u; cnt = 0u; mine = 0u;
#pragma unroll
        for (unsigned j = 0; j < 16; ++j) { const unsigned c = xb_ld(&bar[XB_XCNT(j)]); sum += c; cnt += (c > 0u) ? 1u : 0u; mine = (j == x) ? c : mine; }
        if (sum == G) break;
        __builtin_amdgcn_s_sleep(1);
        if ((++sp & 255u) == 0u) { if (xb_ld(&bar[XB_TMO])) break; if (sp > XB_SPIN_CAP) { atomicAdd(&bar[XB_TMO], 1u); break; } }
    }
    nloc = mine > 0u ? mine : 1u; nx = cnt > 0u ? cnt : 1u;
}
__device__ __forceinline__ void xcd_barrier(const XcdBarrier& b) {
    asm volatile("s_waitcnt vmcnt(0)" ::: "memory");
    __syncthreads();
    if (threadIdx.x == 0) {
        unsigned* bar = b.bar;
        __builtin_amdgcn_s_waitcnt(0);
        unsigned nloc = b.st[0], nx = b.st[1];
        if (nloc == 0u) { xcd_barrier_complete(bar, b.x, nloc, nx); b.st[0] = nloc; b.st[1] = nx; }
        const unsigned old = xb_add(&bar[XB_XSUB(b.x)], 1u);
        const unsigned gen = old / nloc;
        if (old + 1u == (gen + 1u) * nloc) {
            __builtin_amdgcn_fence(__ATOMIC_RELEASE, "agent");
            asm volatile("s_waitcnt vmcnt(0)" ::: "memory");
            const unsigned og = xb_add(&bar[XB_TOP], 1u);
            const unsigned tg = og / nx;
            if (og + 1u == (tg + 1u) * nx) xb_add(&bar[XB_TOPGEN], 1u);
            else XB_SPIN(xb_ld(&bar[XB_TOPGEN]) == tg, bar);
            __builtin_amdgcn_fence(__ATOMIC_ACQUIRE, "agent");
            xb_add(&bar[XB_XGEN(b.x)], 1u);
            asm volatile("s_waitcnt vmcnt(0)" ::: "memory");
        } else {
            XB_SPIN(xb_ld(&bar[XB_XGEN(b.x)]) == gen, bar);
            __builtin_amdgcn_fence(__ATOMIC_ACQUIRE, "agent");
            asm volatile("s_waitcnt vmcnt(0)" ::: "memory");
        }
    }
    __syncthreads();
}

__global__ void __launch_bounds__(NTHR, 2) fwd_kernel(Params P) {
    extern __shared__ __attribute__((aligned(16))) unsigned char smem[];
    LAS unsigned char* lds = (LAS unsigned char*)smem;
    cg::grid_group grid = cg::this_grid();
    if (threadIdx.x < 4) ((LAS unsigned*)(lds + LDS_BYTES - 32))[threadIdx.x] = 0u;
    __syncthreads();
    const XcdBarrier xb = xcd_barrier_post((unsigned*)(P.ws + WS_BAR), (volatile LAS unsigned*)(lds + LDS_BYTES - 32));
    unsigned char* ws = P.ws;
    const int lo = P.ph_lo, hi = P.ph_hi;
    const bool fuse = (gridDim.x == 256);
    for (int ph = lo; ph < hi; ++ph) {
        const int l = ph / 19, q = ph % 19;
        const int half = (q >= 8 && q <= 14) ? 1 : 0;
        const int k = (q == 0) ? 0 : (q <= 14 ? 1 + (q - 1) % 7 : q - 7);
        switch (k) {
        case 0: if (l == 0) { phase_convert(P, l, lds); phase_norm_alow(P, 0, 0, lds); } break;
        case 1: break;
        case 2: { pg8::Gemm g{(const bf16_t*)(ws + WS_H) + (size_t)half * TH * DM, (const bf16_t*)(ws + WS_W1), 1024, 1024, 1024, 0, 0}; pg8::Order S; S.init(TH, 10752, gridDim.x, blockIdx.x, 1);
                  pg8::EpiSplit E{(bf16_t*)(ws + WS_Z), ZC, (bf16_t*)(ws + WS_GT), GC, 30, P.b_gate + (size_t)l * GC}; pg8::gemm_phase(lds, g, S, E); } break;
        case 3: phase_branches(P, l, half, lds); break;
        case 4: for (int it = blockIdx.x; it < 256; it += gridDim.x) gla_C(P, l, it, lds); phase_combine(P); break;
        case 5: { pg8::Gemm g{(const bf16_t*)(ws + WS_Z) + ZG, (const bf16_t*)(ws + WS_WBR), ZC, 512, 512, (size_t)1024, (size_t)1024 * 512};
                  pg8::Order S; S.init(TH, 1024, gridDim.x, blockIdx.x, 3);
                  pg8::EpiMerge E{(const bf16_t*)(ws + WS_GT), (bf16_t*)(ws + WS_MG)}; pg8::gemm_phase(lds, g, S, E); } break;
        case 6: if (fuse) {
                      const int inst = l * 2 + half;
                      pg8::Gemm g{(const bf16_t*)(ws + WS_MG), (const bf16_t*)(ws + WS_WMO), 1024, 1024, 1024, 0, 0}; pg8::Order S; S.init(TH, 1024, gridDim.x, blockIdx.x, 1);
                      pg8::EpiNormRes E{(l == 0 ? P.x : P.out) + (size_t)half * TH * DM, P.out + (size_t)half * TH * DM, (bf16_t*)(ws + WS_H) + (size_t)half * TH * DM,
                                        P.post_mix_g + (size_t)l * DM, P.pre_ffn_g + (size_t)l * DM,
                                        (unsigned*)(ws + WS_XS) + (size_t)(inst * 2) * TH * 4, (unsigned*)(ws + WS_XS) + (size_t)(inst * 2 + 1) * TH * 4,
                                        (unsigned*)(ws + WS_CTL) + 4608 + (inst * 2) * 256, (unsigned*)(ws + WS_CTL) + 4608 + (inst * 2 + 1) * 256};
                      pg8::gemm_phase(lds, g, S, E);
                      if (half == 0) phase_norm_alow(P, l, 1, lds);
                  } else { pg8::Gemm g{(const bf16_t*)(ws + WS_MG), (const bf16_t*)(ws + WS_WMO), 1024, 1024, 1024, 0, 0}; pg8::Order S; S.init(TH, 1024, gridDim.x, blockIdx.x, 1);
                      pg8::EpiSplit E{(bf16_t*)(ws + WS_Y), 1024, (bf16_t*)(ws + WS_Y), 1024, 1 << 20, nullptr}; pg8::gemm_phase(lds, g, S, E); } break;
        case 7: if (!fuse) { phase_resid((l == 0 ? P.x : P.out) + (size_t)half * TH * DM, P.out + (size_t)half * TH * DM, (const bf16_t*)(ws + WS_Y), P.post_mix_g + (size_t)l * DM, P.pre_ffn_g + (size_t)l * DM,
                            (bf16_t*)(ws + WS_H) + (size_t)half * TH * DM, TH);
                if (half == 0) phase_norm_alow(P, l, 1, lds); }
                break;
        case 8: { pg8::Gemm g{(const bf16_t*)(ws + WS_H), (const bf16_t*)(ws + WS_WFF), 1024, 1024, 1024, 0, 0}; pg8::Order S; S.init(T_ALL, 5632, gridDim.x, blockIdx.x, 1);
                  pg8::EpiFFN E{(bf16_t*)(ws + WS_U), (float*)(ws + WS_HG), (float*)(ws + WS_HU), P.ff_conv_w + (size_t)l * 3 * FF, P.ff_conv_b + (size_t)l * FF, lds + pg8::STAGE_BYTES};
                  pg8::gemm_phase(lds, g, S, E); } break;
        case 9: phase_ffn_fix(P, l); break;
        case 10: { pg8::Gemm g{(const bf16_t*)(ws + WS_U), (const bf16_t*)(ws + WS_WD), FF, FF, FF, 0, 0}; pg8::Order S; S.init(T_ALL, 1024, gridDim.x, blockIdx.x, 1);
                   pg8::EpiSplit E{(bf16_t*)(ws + WS_Y2), 1024, (bf16_t*)(ws + WS_Y2), 1024, 1 << 20, nullptr}; pg8::gemm_phase(lds, g, S, E); } break;
        default: phase_resid(P.out, P.out, (const bf16_t*)(ws + WS_Y2), P.post_ffn_g + (size_t)l * DM, nullptr, nullptr, T_ALL);
                 if (l == 0) { phase_convert(P, 1, lds); phase_norm_alow(P, 1, 0, lds); }
                 break;
        }
        const bool empty = (k == 0 && l == 1) || (k == 1) || (k == 7 && fuse);
        if (ph + 1 < hi && !empty) { if (hi < lo) grid.sync(); else xcd_barrier(xb); }
    }
}

constexpr int N_PHASES = 2 * (1 + 2 * 7 + 4);

#ifndef MULTI_LAUNCH
#define MULTI_LAUNCH 0
#endif

extern "C" void kernel_launch(void* const* d_in, const int* in_sizes, int n_in, void* d_out, int out_size, void* d_ws, size_t ws_size, hipStream_t stream) {
    static int grid = 0;
    if (grid == 0) {
        if (n_in != 20 || ws_size < WS_END) { fprintf(stderr, "kernel_launch: unexpected n_in %d / ws_size %zu (need %zu)\n", n_in, ws_size, (size_t)WS_END); grid = -1; return; }
        int dev = 0, cus = 0, per_cu = 0;
        hipGetDevice(&dev); hipDeviceGetAttribute(&cus, hipDeviceAttributeMultiprocessorCount, dev);
        if (hipFuncSetAttribute((const void*)fwd_kernel, hipFuncAttributeMaxDynamicSharedMemorySize, LDS_BYTES) != hipSuccess) { fprintf(stderr, "kernel_launch: hipFuncSetAttribute failed\n"); grid = -1; return; }
        if (hipOccupancyMaxActiveBlocksPerMultiprocessor(&per_cu, (const void*)fwd_kernel, NTHR, LDS_BYTES) != hipSuccess || per_cu < 1) per_cu = 1;
        (void)hipGetLastError();
        grid = cus * per_cu;
        if (grid > 256) grid = 256;
    }
    if (grid < 0) return;
    hipMemsetAsync((char*)d_ws + WS_CTL, 0, 32768, stream);
    Params p{};
    p.x = (const float*)d_in[0]; p.pos = (const int*)d_in[1]; p.w_in = (const float*)d_in[2]; p.w_alpha_up = (const float*)d_in[3]; p.b_alpha = (const float*)d_in[4];
    p.gla_norm_g = (const float*)d_in[5]; p.sc_conv_w = (const float*)d_in[6]; p.w_gate = (const float*)d_in[7]; p.b_gate = (const float*)d_in[8]; p.w_branch = (const float*)d_in[9];
    p.w_mix_out = (const float*)d_in[10]; p.pre_mix_g = (const float*)d_in[11]; p.post_mix_g = (const float*)d_in[12]; p.pre_ffn_g = (const float*)d_in[13]; p.post_ffn_g = (const float*)d_in[14];
    p.w_ff_gate = (const float*)d_in[15]; p.w_ff_up = (const float*)d_in[16]; p.ff_conv_w = (const float*)d_in[17]; p.ff_conv_b = (const float*)d_in[18]; p.w_ff_down = (const float*)d_in[19];
    p.out = (float*)d_out; p.ws = (unsigned char*)d_ws;
#if MULTI_LAUNCH
    for (int ph = 0; ph < N_PHASES; ++ph) { p.ph_lo = ph; p.ph_hi = ph + 1; hipLaunchKernelGGL(fwd_kernel, dim3(grid), dim3(NTHR), LDS_BYTES, stream, p); }
#else
    p.ph_lo = 0; p.ph_hi = N_PHASES;
    void* args[] = {&p};
    hipError_t e = hipLaunchCooperativeKernel((const void*)fwd_kernel, dim3(grid), dim3(NTHR), args, LDS_BYTES, stream);
    if (e != hipSuccess) fprintf(stderr, "cooperative launch failed: %s (grid %d)\n", hipGetErrorString(e), grid);
#endif
}
```

```cpp
#include <hip/hip_runtime.h>
#include <hip/hip_cooperative_groups.h>
#include <cstdint>
#include <cstdio>
namespace cg = cooperative_groups;

#define LAS __attribute__((address_space(3)))
typedef unsigned short bf16_t;
typedef short bf16x8 __attribute__((ext_vector_type(8)));
typedef float f32x4 __attribute__((ext_vector_type(4)));
typedef float f32x2 __attribute__((ext_vector_type(2)));
typedef unsigned u32x4 __attribute__((ext_vector_type(4)));
typedef unsigned u32x2 __attribute__((ext_vector_type(2)));

constexpr int T_ALL = 32768, TH = 16384, DM = 1024, ZC = 7680, GC = 3072, FF = 2816;
constexpr int ZQ = 0, ZK = 256, ZV = 512, ZG = 1024, ZSC = 1536, ZSB = 2048, ZSX = 2560, ZDQ = 3072, ZDK = 4608, ZDV = 6144;
constexpr int IN_COLS = 7696;
constexpr float EPS = 1e-6f;
constexpr int NTHR = 512;
constexpr int LDS_BYTES = 147456;
constexpr int LDS_SLOT = LDS_BYTES - 16;

constexpr size_t WS_CTL = 0;
constexpr size_t WS_BAR = 4096;
constexpr size_t WS_W1 = 32768;
constexpr size_t WS_WBR = WS_W1 + (size_t)10752 * 1024 * 2;
constexpr size_t WS_WMO = WS_WBR + (size_t)3 * 1024 * 512 * 2;
constexpr size_t WS_WFF = WS_WMO + (size_t)1024 * 1024 * 2;
constexpr size_t WS_WD = WS_WFF + (size_t)5632 * 1024 * 2;
constexpr size_t WS_RC = WS_WD + (size_t)1024 * 2816 * 2;
constexpr size_t WS_XS = WS_RC + (size_t)1024 * 1024;
constexpr size_t WS_RS = WS_RC + (size_t)T_ALL * 64 * 4;
constexpr size_t WS_H = WS_RS + (size_t)T_ALL * 64 * 4;
constexpr size_t WS_ALOW = WS_H + (size_t)T_ALL * 1024 * 2;
constexpr size_t WS_LSE = WS_ALOW + (size_t)TH * 16 * 4;
constexpr size_t WS_DSEG = WS_LSE + (size_t)TH * 12 * 4;
constexpr size_t WS_BIG = WS_DSEG + (size_t)256 * 64 * 4;
constexpr size_t WS_Z = WS_BIG;
constexpr size_t WS_GT = WS_Z + (size_t)TH * ZC * 2;
constexpr size_t WS_MG = WS_GT + (size_t)TH * GC * 2;
constexpr size_t WS_END = WS_MG + (size_t)TH * 1024 * 2;
constexpr size_t WS_Y = WS_BIG;
constexpr size_t WS_G = WS_BIG;
constexpr size_t WS_U = WS_BIG + (size_t)T_ALL * FF * 2;
constexpr size_t WS_Y2 = WS_BIG;
constexpr size_t WS_HG = WS_BIG + (size_t)T_ALL * 1024 * 4;
constexpr size_t WS_HU = WS_HG + (size_t)128 * 4 * FF * 4;
static_assert(WS_HU + (size_t)128 * 2 * FF * 4 <= WS_U, "halo fits between Y2 and the activation buffer");
static_assert(WS_U + (size_t)T_ALL * FF * 2 <= WS_END, "ffn overlay");

struct Params {
    const float* x; const int* pos; const float* w_in; const float* w_alpha_up; const float* b_alpha; const float* gla_norm_g; const float* sc_conv_w;
    const float* w_gate; const float* b_gate; const float* w_branch; const float* w_mix_out; const float* pre_mix_g; const float* post_mix_g;
    const float* pre_ffn_g; const float* post_ffn_g; const float* w_ff_gate; const float* w_ff_up; const float* ff_conv_w; const float* ff_conv_b; const float* w_ff_down;
    float* out; unsigned char* ws; int ph_lo, ph_hi;
};

__device__ __forceinline__ int get_tid() { int t = threadIdx.x; asm volatile("" : "+v"(t)); return t; }
__device__ __forceinline__ unsigned cvt_pk_bf16(float lo, float hi) { unsigned r; asm volatile("v_cvt_pk_bf16_f32 %0, %1, %2" : "=v"(r) : "v"(lo), "v"(hi)); return r; }
__device__ __forceinline__ float bflo(unsigned w) { return __uint_as_float(w << 16); }
__device__ __forceinline__ float bfhi(unsigned w) { return __uint_as_float(w & 0xffff0000u); }
__device__ __forceinline__ float bf2f(unsigned short b) { return __uint_as_float(((unsigned)b) << 16); }
__device__ __forceinline__ unsigned short f2bf(float f) { return (unsigned short)(cvt_pk_bf16(f, 0.f) & 0xffffu); }
__device__ __forceinline__ void unpack8(const u32x4 w, float (&f)[8]) { f[0] = bflo(w.x); f[1] = bfhi(w.x); f[2] = bflo(w.y); f[3] = bfhi(w.y); f[4] = bflo(w.z); f[5] = bfhi(w.z); f[6] = bflo(w.w); f[7] = bfhi(w.w); }
__device__ __forceinline__ u32x4 pack8(const float (&f)[8]) { u32x4 w; w.x = cvt_pk_bf16(f[0], f[1]); w.y = cvt_pk_bf16(f[2], f[3]); w.z = cvt_pk_bf16(f[4], f[5]); w.w = cvt_pk_bf16(f[6], f[7]); return w; }
__device__ __forceinline__ bf16x8 as_bf16x8(const u32x4 w) { union { u32x4 u; bf16x8 b; } c; c.u = w; return c.b; }

namespace pg8 {
constexpr int BM = 256, BK = 64, HALF = 128, HTB = HALF * BK * 2, STAGE_BYTES = 8 * HTB, NXCD = 8, WGM = 8;
__device__ __forceinline__ int lds_byte(int r, int c) { const int st = (r >> 4) * 2 + (c >> 5), rr = r & 15, cc = c & 31, ob = rr * 64 + cc * 2; return st * 1024 + (ob ^ (((ob >> 9) & 1) << 5)); }
__device__ __forceinline__ void stage_rc(int b, int& R, int& C) { const int st = b / 1024, sb = b % 1024, swz = sb ^ (((sb >> 9) & 1) << 5); R = (st >> 1) * 16 + swz / 64; C = (st & 1) * 32 + (swz % 64) / 2; }
__device__ __forceinline__ int perm32(int rho) { const int n = rho >> 4, i = rho & 15; return 8 * (i >> 2) + 4 * n + (i & 3); }

struct Unit { int pm, pn, g; };
struct Gemm { const bf16_t* A; const bf16_t* Bt; int lda, ldb, K; size_t gA, gB; };

struct Order {
    int nM, nN, nwg, G, c, ng;
    __device__ void init(int M, int N, int G_, int c_, int ng_) { nM = M / BM; nN = N / BM; nwg = nM * nN; G = G_; c = c_; ng = ng_; }
    __device__ bool next(int i, Unit& u) const {
        const int ti = i / ng; u.g = i - ti * ng;
        const long L = (long)ti * G + c; if (L >= nwg) return false;
        int wgid = (int)L; { const int q = nwg / NXCD, r = nwg % NXCD, xcd = wgid % NXCD, off = wgid / NXCD; wgid = (xcd < r ? xcd * (q + 1) : r * (q + 1) + (xcd - r) * q) + off; }
        const int nig = WGM * nN, gid = wgid / nig, fm = gid * WGM, gsz = (nM - fm) < WGM ? (nM - fm) : WGM;
        u.pm = fm + ((wgid % nig) % gsz); u.pn = (wgid % nig) / gsz; return true;
    }
};

template <class Epi>
__device__ __forceinline__ void gemm_phase(LAS unsigned char* lds, const Gemm g, const Order& S, const Epi& E) {
    const int tid = get_tid(), wid = __builtin_amdgcn_readfirstlane(tid >> 6), lane = tid & 63, wr = wid >> 2, wc = wid & 3, fr = lane & 15, fq = lane >> 4;
    const int K = g.K, nt = K / BK;
    unsigned voffA[2], voffB[2];
#pragma unroll
    for (int i = 0; i < 2; ++i) { int R, C; stage_rc(tid * 16 + i * 8192, R, C); const int Rb = Epi::PERM ? ((R & ~31) + perm32(R & 31)) : R;
        voffA[i] = (unsigned)(R * g.lda + C) * 2u; voffB[i] = (unsigned)(Rb * g.ldb + C) * 2u; }
    const size_t kstep = (size_t)(BK * 2);
    const size_t hstepA = (size_t)HALF * g.lda * 2, hstepB = (size_t)HALF * g.ldb * 2;
    const size_t tstepA = 2 * hstepA, tstepB = 2 * hstepB;
    const unsigned ldsw = (unsigned)wid * 1024u;
    const int aoff = lds_byte(wr * 64 + fr, fq * 8), boff = lds_byte(wc * 32 + fr, fq * 8);
#define PG8_SA(b, h) (((b) * 2 + (h)) * HTB)
#define PG8_SB(b, h) ((4 + (b) * 2 + (h)) * HTB)
#define PG8_STAGE(bufoff, gbase, voff) do { _Pragma("unroll") for (int _i = 0; _i < 2; ++_i) \
        __builtin_amdgcn_global_load_lds((const unsigned*)((const char*)(gbase) + (voff)[_i]), (LAS unsigned*)(lds + (bufoff) + ldsw + _i * 8192), 16, 0, 0); } while (0)
#define PG8_LDA(dst, b, h) do { _Pragma("unroll") for (int m = 0; m < 4; ++m) _Pragma("unroll") for (int k = 0; k < 2; ++k) dst[m][k] = *(const LAS bf16x8*)(lds + PG8_SA(b, h) + aoff + m * 2048 + k * 1024); } while (0)
#define PG8_LDB(dst, b, h) do { _Pragma("unroll") for (int n = 0; n < 2; ++n) _Pragma("unroll") for (int k = 0; k < 2; ++k) dst[n][k] = *(const LAS bf16x8*)(lds + PG8_SB(b, h) + boff + n * 2048 + k * 1024); } while (0)
#define PG8_MMA(ai, bj, At, Bt) do { __builtin_amdgcn_s_setprio(1); _Pragma("unroll") for (int m = 0; m < 4; ++m) _Pragma("unroll") for (int n = 0; n < 2; ++n) _Pragma("unroll") for (int k = 0; k < 2; ++k) \
        acc[ai][bj][m][n] = __builtin_amdgcn_mfma_f32_16x16x32_bf16(Bt[n][k], At[m][k], acc[ai][bj][m][n], 0, 0, 0); __builtin_amdgcn_s_setprio(0); } while (0)
#define PG8_WAIT_V(n) asm volatile("s_waitcnt vmcnt(" #n ")" ::: "memory")
#define PG8_WAIT_L(n) asm volatile("s_waitcnt lgkmcnt(" #n ")" ::: "memory")
#define PG8_BAR __builtin_amdgcn_s_barrier()
#define PG8_SCHED __builtin_amdgcn_sched_barrier(0)
    Unit cur, nxt; int ui = 0;
    if (!S.next(0, cur)) return;
    f32x4 acc[2][2][4][2];
#pragma unroll
    for (int a = 0; a < 2; ++a)
#pragma unroll
        for (int b = 0; b < 2; ++b)
#pragma unroll
            for (int m = 0; m < 4; ++m)
#pragma unroll
                for (int n = 0; n < 2; ++n) acc[a][b][m][n] = (f32x4){0.f, 0.f, 0.f, 0.f};
    bf16x8 At[4][2], B0[2][2], B1[2][2];
    const char* cA = (const char*)(g.A + (size_t)cur.g * g.gA) + (size_t)cur.pm * tstepA; const char* cB = (const char*)(g.Bt + (size_t)cur.g * g.gB) + (size_t)cur.pn * tstepB;
    PG8_STAGE(PG8_SB(0, 0), cB, voffB); PG8_STAGE(PG8_SB(0, 1), cB + hstepB, voffB); PG8_STAGE(PG8_SA(0, 0), cA, voffA); PG8_STAGE(PG8_SA(0, 1), cA + hstepA, voffA);
    if (wr == 1) PG8_BAR;
    PG8_WAIT_V(2); PG8_BAR;
    PG8_STAGE(PG8_SB(1, 0), cB + kstep, voffB); PG8_STAGE(PG8_SA(1, 0), cA + kstep, voffA); PG8_STAGE(PG8_SB(1, 1), cB + hstepB + kstep, voffB);
    PG8_WAIT_V(6); PG8_BAR;
    for (;;) {
        const bool has_next = S.next(ui + 1, nxt);
        const char* nA = has_next ? (const char*)(g.A + (size_t)nxt.g * g.gA) + (size_t)nxt.pm * tstepA : cA; const char* nB = has_next ? (const char*)(g.Bt + (size_t)nxt.g * g.gB) + (size_t)nxt.pn * tstepB : cB;
        for (int t = 0; t < nt; t += 2) {
            const bool last = (t == nt - 2);
            const char* a1 = cA + (size_t)(t + 1) * kstep;
            const char* a2 = last ? nA : cA + (size_t)(t + 2) * kstep; const char* b2 = last ? nB : cB + (size_t)(t + 2) * kstep;
            const char* a3 = a2 + kstep; const char* b3 = b2 + kstep;
            PG8_LDB(B0, 0, 0); PG8_LDB(B1, 0, 1); PG8_SCHED; PG8_LDA(At, 0, 0); PG8_STAGE(PG8_SA(1, 1), a1 + hstepA, voffA);
            PG8_WAIT_V(8); PG8_WAIT_L(0); PG8_BAR; PG8_MMA(0, 0, At, B0); PG8_MMA(0, 1, At, B1); PG8_BAR; PG8_SCHED;
            PG8_LDA(At, 0, 1); PG8_STAGE(PG8_SB(0, 0), b2, voffB); PG8_STAGE(PG8_SB(0, 1), b2 + hstepB, voffB); PG8_STAGE(PG8_SA(0, 0), a2, voffA);
            PG8_WAIT_V(8); PG8_WAIT_L(0); PG8_BAR; PG8_MMA(1, 0, At, B0); PG8_MMA(1, 1, At, B1); PG8_BAR; PG8_SCHED;
            PG8_LDB(B0, 1, 0); PG8_LDB(B1, 1, 1); PG8_SCHED; PG8_LDA(At, 1, 0); PG8_STAGE(PG8_SA(0, 1), a2 + hstepA, voffA);
            PG8_WAIT_V(8); PG8_WAIT_L(0); PG8_BAR; PG8_MMA(0, 0, At, B0); PG8_MMA(0, 1, At, B1); PG8_BAR; PG8_SCHED;
            PG8_LDA(At, 1, 1); PG8_STAGE(PG8_SB(1, 0), b3, voffB); PG8_STAGE(PG8_SB(1, 1), b3 + hstepB, voffB); PG8_STAGE(PG8_SA(1, 0), a3, voffA);
            PG8_WAIT_V(8); PG8_WAIT_L(0); PG8_BAR; PG8_MMA(1, 0, At, B0); PG8_MMA(1, 1, At, B1); PG8_BAR; PG8_SCHED;
        }
        if (wr == 0) PG8_BAR;
        if constexpr (!Epi::AFTER_DRAIN) E(acc, cur, wr, wc, fr, fq);
        if (!has_next) break;
        if constexpr (!Epi::KEEP_ACC) {
#pragma unroll
        for (int a = 0; a < 2; ++a)
#pragma unroll
            for (int b = 0; b < 2; ++b)
#pragma unroll
                for (int m = 0; m < 4; ++m)
#pragma unroll
                    for (int n = 0; n < 2; ++n) acc[a][b][m][n] = (f32x4){0.f, 0.f, 0.f, 0.f};
        }
        cur = nxt; cA = nA; cB = nB; ++ui;
        if (wr == 1) PG8_BAR;
    }
    PG8_WAIT_V(0);
    PG8_BAR;
    if constexpr (Epi::AFTER_DRAIN) E.fused(acc, cur, wr, wc, fr, fq, lds);
#undef PG8_SA
#undef PG8_SB
#undef PG8_STAGE
#undef PG8_LDA
#undef PG8_LDB
#undef PG8_MMA
#undef PG8_WAIT_V
#undef PG8_WAIT_L
#undef PG8_BAR
#undef PG8_SCHED
}

struct EpiF32 {
    static constexpr bool PERM = false, AFTER_DRAIN = false, KEEP_ACC = false;
    float* C; int ldc;
    __device__ __forceinline__ void operator()(const f32x4 (&acc)[2][2][4][2], const Unit& u, int wr, int wc, int fr, int fq) const {
        const int row0 = u.pm * BM + wr * 64 + fr, col0 = u.pn * BM + wc * 32 + 4 * fq;
#pragma unroll
        for (int ai = 0; ai < 2; ++ai)
#pragma unroll
            for (int m = 0; m < 4; ++m) { float* rowp = C + (size_t)(row0 + ai * HALF + m * 16) * ldc + col0;
#pragma unroll
                for (int bj = 0; bj < 2; ++bj)
#pragma unroll
                    for (int n = 0; n < 2; ++n) *(f32x4*)(rowp + bj * HALF + n * 16) = acc[ai][bj][m][n]; }
    }
};
struct EpiSplit {
    static constexpr bool PERM = true, AFTER_DRAIN = false, KEEP_ACC = false;
    bf16_t* O0; int ld0; bf16_t* O1; int ld1; int split; const float* bias1;
    __device__ __forceinline__ void operator()(const f32x4 (&acc)[2][2][4][2], const Unit& u, int wr, int wc, int fr, int fq) const {
        const int row0 = u.pm * BM + wr * 64 + fr;
        const bool second = u.pn >= split;
        bf16_t* base = second ? O1 : O0; const int ld = second ? ld1 : ld0;
        const int col0 = (second ? (u.pn - split) : u.pn) * BM + wc * 32 + 8 * fq;
        const bool sig = second && (bias1 != nullptr);
        f32x4 bv[2][2];
#pragma unroll
        for (int bj = 0; bj < 2; ++bj)
#pragma unroll
            for (int n = 0; n < 2; ++n) bv[bj][n] = sig ? *(const f32x4*)(bias1 + col0 + bj * HALF + 4 * n) : (f32x4){0.f, 0.f, 0.f, 0.f};
#pragma unroll
        for (int ai = 0; ai < 2; ++ai)
#pragma unroll
            for (int m = 0; m < 4; ++m) { bf16_t* rowp = base + (size_t)(row0 + ai * HALF + m * 16) * ld + col0;
#pragma unroll
                for (int bj = 0; bj < 2; ++bj) { f32x4 v0 = acc[ai][bj][m][0] + bv[bj][0], v1 = acc[ai][bj][m][1] + bv[bj][1];
                    if (sig) {
#pragma unroll
                        for (int j = 0; j < 4; ++j) { v0[j] = __builtin_amdgcn_rcpf(1.0f + __expf(-v0[j])); v1[j] = __builtin_amdgcn_rcpf(1.0f + __expf(-v1[j])); } }
                    u32x4 w; w.x = cvt_pk_bf16(v0[0], v0[1]); w.y = cvt_pk_bf16(v0[2], v0[3]); w.z = cvt_pk_bf16(v1[0], v1[1]); w.w = cvt_pk_bf16(v1[2], v1[3]);
                    *(u32x4*)(rowp + bj * HALF) = w; } }
    }
};
struct EpiMerge {
    static constexpr bool PERM = true, AFTER_DRAIN = false, KEEP_ACC = true;
    const bf16_t* GT; bf16_t* MG;
    __device__ __forceinline__ void operator()(f32x4 (&acc)[2][2][4][2], const Unit& u, int wr, int wc, int fr, int fq) const {
        const int row0 = u.pm * BM + wr * 64 + fr, col0 = u.pn * BM + wc * 32 + 8 * fq;
        const bool last = (u.g == 2);
#pragma unroll
        for (int ai = 0; ai < 2; ++ai) {
            u32x4 gw[4][2], gn[4][2];
#pragma unroll
            for (int m = 0; m < 4; ++m)
#pragma unroll
                for (int bj = 0; bj < 2; ++bj) { const size_t row = (size_t)(row0 + ai * HALF + m * 16); const int col = col0 + bj * HALF;
                    gw[m][bj] = *(const u32x4*)(GT + row * GC + u.g * 1024 + col);
                    gn[m][bj] = last ? (u32x4){0x3f803f80u, 0x3f803f80u, 0x3f803f80u, 0x3f803f80u} : *(const u32x4*)(GT + row * GC + (u.g + 1) * 1024 + col); }
#pragma unroll
            for (int m = 0; m < 4; ++m)
#pragma unroll
                for (int bj = 0; bj < 2; ++bj) { const size_t row = (size_t)(row0 + ai * HALF + m * 16); const int col = col0 + bj * HALF;
                    float gf[8], nf[8], v[8]; unpack8(gw[m][bj], gf); unpack8(gn[m][bj], nf);
#pragma unroll
                    for (int j = 0; j < 4; ++j) { v[j] = gf[j] * acc[ai][bj][m][0][j]; v[4 + j] = gf[4 + j] * acc[ai][bj][m][1][j]; }
                    if (last) { *(u32x4*)(MG + row * 1024 + col) = pack8(v); acc[ai][bj][m][0] = (f32x4){0.f, 0.f, 0.f, 0.f}; acc[ai][bj][m][1] = (f32x4){0.f, 0.f, 0.f, 0.f}; }
                    else {
#pragma unroll
                        for (int j = 0; j < 4; ++j) { acc[ai][bj][m][0][j] = v[j] * __builtin_amdgcn_rcpf(fmaxf(nf[j], 1e-30f)); acc[ai][bj][m][1][j] = v[4 + j] * __builtin_amdgcn_rcpf(fmaxf(nf[4 + j], 1e-30f)); } }
                }
        }
    }
};

__device__ __forceinline__ float dpp_row_shr1(float x) { return __int_as_float(__builtin_amdgcn_update_dpp(0, __float_as_int(x), 0x111, 0xf, 0xf, false)); }
__device__ __forceinline__ float dpp_row_shr2(float x) { return __int_as_float(__builtin_amdgcn_update_dpp(0, __float_as_int(x), 0x112, 0xf, 0xf, false)); }
__device__ __forceinline__ float dpp_row_ror1(float x) { return __int_as_float(__builtin_amdgcn_update_dpp(0, __float_as_int(x), 0x121, 0xf, 0xf, false)); }
__device__ __forceinline__ float dpp_row_ror2(float x) { return __int_as_float(__builtin_amdgcn_update_dpp(0, __float_as_int(x), 0x122, 0xf, 0xf, false)); }
__device__ __forceinline__ f32x2 gelu_tanh_mul2(f32x2 gt, f32x2 up) {
    const f32x2 g2 = gt * gt;
    const f32x2 t = gt * (g2 * 0.044715f + 1.0f);
    const f32x2 sx = t * (-2.0f * 0.7978845608028654f * 1.4426950408889634f);
    f32x2 e; e.x = __builtin_amdgcn_exp2f(sx.x); e.y = __builtin_amdgcn_exp2f(sx.y);
    const f32x2 d = e + 1.0f;
    f32x2 r; r.x = __builtin_amdgcn_rcpf(d.x); r.y = __builtin_amdgcn_rcpf(d.y);
    return gt * r * up;
}
__device__ __forceinline__ float gelu_tanh_mul(float gt, float up) {
    const float uu = 0.7978845608028654f * (gt + 0.044715f * gt * gt * gt);
    return gt * __builtin_amdgcn_rcpf(1.0f + __expf(-2.0f * uu)) * up;
}
struct EpiFFN {
    static constexpr bool PERM = true, AFTER_DRAIN = false, KEEP_ACC = false;
    bf16_t* ACT; float* HG; float* HU; const float* cw; const float* cb; LAS unsigned char* xlds;
    __device__ __forceinline__ void operator()(const f32x4 (&acc)[2][2][4][2], const Unit& u, int wr, int wc, int fr, int fq) const {
        const int chl = wc * 32 + 8 * fq, chg = u.pn * 128 + chl;
        LAS float* XG = (LAS float*)xlds;
        if (fr >= 14) {
#pragma unroll
            for (int ai = 0; ai < 2; ++ai) { LAS float* p = XG + ((2 * ai + wr) * 2 + (fr - 14)) * 128 + chl; *(LAS f32x4*)p = acc[ai][0][3][0]; *(LAS f32x4*)(p + 4) = acc[ai][0][3][1]; }
            if (wr == 1) { float* hp = HG + ((size_t)u.pm * 4 + 2 + (fr - 14)) * FF + chg; *(f32x4*)hp = acc[1][0][3][0]; *(f32x4*)(hp + 4) = acc[1][0][3][1]; }
        }
        if (fr < 2 && wr == 0) {
            float* hp = HG + ((size_t)u.pm * 4 + fr) * FF + chg; *(f32x4*)hp = acc[0][0][0][0]; *(f32x4*)(hp + 4) = acc[0][0][0][1];
            float* up = HU + ((size_t)u.pm * 2 + fr) * FF + chg; *(f32x4*)up = acc[0][1][0][0]; *(f32x4*)(up + 4) = acc[0][1][0][1];
        }
        asm volatile("s_waitcnt lgkmcnt(0)" ::: "memory"); __builtin_amdgcn_s_barrier(); asm volatile("" ::: "memory");
        float w0[8], w1[8], w2[8], bb[8];
        { const f32x4 a0 = *(const f32x4*)(cw + chg), a1 = *(const f32x4*)(cw + chg + 4), b0 = *(const f32x4*)(cw + FF + chg), b1 = *(const f32x4*)(cw + FF + chg + 4),
                      c0 = *(const f32x4*)(cw + 2 * FF + chg), c1 = *(const f32x4*)(cw + 2 * FF + chg + 4), d0 = *(const f32x4*)(cb + chg), d1 = *(const f32x4*)(cb + chg + 4);
#pragma unroll
          for (int j = 0; j < 4; ++j) { w0[j] = a0[j]; w0[4 + j] = a1[j]; w1[j] = b0[j]; w1[4 + j] = b1[j]; w2[j] = c0[j]; w2[4 + j] = c1[j]; bb[j] = d0[j]; bb[4 + j] = d1[j]; } }
#pragma unroll
        for (int ai = 0; ai < 2; ++ai)
#pragma unroll
            for (int m = 0; m < 4; ++m) {
                const int B = 2 * ai + wr;
                float g8[8], u8[8], q15[8], q14[8], o[8];
#pragma unroll
                for (int j = 0; j < 4; ++j) { g8[j] = acc[ai][0][m][0][j]; g8[4 + j] = acc[ai][0][m][1][j]; u8[j] = acc[ai][1][m][0][j]; u8[4 + j] = acc[ai][1][m][1][j]; }
                if (m == 0) {
                    if (B > 0) { const LAS float* p = XG + ((B - 1) * 2) * 128 + chl; const f32x4 r0a = *(const LAS f32x4*)p, r0b = *(const LAS f32x4*)(p + 4), r1a = *(const LAS f32x4*)(p + 128), r1b = *(const LAS f32x4*)(p + 132);
#pragma unroll
                        for (int j = 0; j < 4; ++j) { q14[j] = r0a[j]; q14[4 + j] = r0b[j]; q15[j] = r1a[j]; q15[4 + j] = r1b[j]; } }
                    else {
#pragma unroll
                        for (int j = 0; j < 8; ++j) { q14[j] = 0.f; q15[j] = 0.f; } }
                    float p1a[8], p2a[8];
#pragma unroll
                    for (int e = 0; e < 8; ++e) { const float s1 = dpp_row_shr1(g8[e]), s2 = dpp_row_shr2(g8[e]);
                        p1a[e] = (fr >= 1) ? s1 : q15[e]; p2a[e] = (fr >= 2) ? s2 : ((fr == 1) ? q15[e] : q14[e]); }
#pragma unroll
                    for (int e = 0; e < 8; e += 2) { const f32x2 gt = (f32x2){w0[e], w0[e + 1]} * (f32x2){p2a[e], p2a[e + 1]} + (f32x2){w1[e], w1[e + 1]} * (f32x2){p1a[e], p1a[e + 1]} + (f32x2){w2[e], w2[e + 1]} * (f32x2){g8[e], g8[e + 1]} + (f32x2){bb[e], bb[e + 1]};
                        const f32x2 r = gelu_tanh_mul2(gt, (f32x2){u8[e], u8[e + 1]}); o[e] = r.x; o[e + 1] = r.y; }
                } else {
                    float p1a[8], p2a[8];
#pragma unroll
                    for (int e = 0; e < 8; ++e) { const float pv = (e < 4) ? acc[ai][0][m - 1][0][e & 3] : acc[ai][0][m - 1][1][e & 3];
                        const float s1 = dpp_row_shr1(g8[e]), s2 = dpp_row_shr2(g8[e]), r1 = dpp_row_ror1(pv), r2 = dpp_row_ror2(pv);
                        p1a[e] = (fr >= 1) ? s1 : r1; p2a[e] = (fr >= 2) ? s2 : r2; }
#pragma unroll
                    for (int e = 0; e < 8; e += 2) { const f32x2 gt = (f32x2){w0[e], w0[e + 1]} * (f32x2){p2a[e], p2a[e + 1]} + (f32x2){w1[e], w1[e + 1]} * (f32x2){p1a[e], p1a[e + 1]} + (f32x2){w2[e], w2[e + 1]} * (f32x2){g8[e], g8[e + 1]} + (f32x2){bb[e], bb[e + 1]};
                        const f32x2 r = gelu_tanh_mul2(gt, (f32x2){u8[e], u8[e + 1]}); o[e] = r.x; o[e + 1] = r.y; }
                }
                const int rloc = 128 * ai + 64 * wr + 16 * m + fr;
                if (!(B == 0 && m == 0 && fr < 2)) *(u32x4*)(ACT + (size_t)(u.pm * BM + rloc) * FF + chg) = pack8(o);
            }
    }
};

struct EpiNormRes {
    static constexpr bool PERM = false, AFTER_DRAIN = true, KEEP_ACC = false;
    const float* xin; float* xout; bf16_t* H2; const float* g1; const float* g2; unsigned* xs1; unsigned* xs2; unsigned* cnt1; unsigned* cnt2;
    __device__ __forceinline__ void exchange(const f32x4 (&v)[2][2][4][2], const Unit& u, int wr, int wc, int fr, int fq, LAS unsigned char* lds, unsigned* xs, unsigned* cnt) const {
        LAS float* Pp = (LAS float*)lds;
        LAS float* S = (LAS float*)(lds + 4096);
        const int tid = get_tid();
#pragma unroll
        for (int ai = 0; ai < 2; ++ai)
#pragma unroll
            for (int m = 0; m < 4; ++m) { float sq = 0.f;
#pragma unroll
                for (int bj = 0; bj < 2; ++bj)
#pragma unroll
                    for (int n = 0; n < 2; ++n) { const f32x4 x = v[ai][bj][m][n]; sq += (x[0] * x[0] + x[1] * x[1]) + (x[2] * x[2] + x[3] * x[3]); }
                sq += __shfl_xor(sq, 16); sq += __shfl_xor(sq, 32);
                if (fq == 0) Pp[(ai * HALF + wr * 64 + m * 16 + fr) * 4 + wc] = sq; }
        asm volatile("s_waitcnt lgkmcnt(0)" ::: "memory"); __builtin_amdgcn_s_barrier(); asm volatile("" ::: "memory");
        if (tid < 256) { const f32x4 p = *(const LAS f32x4*)(Pp + tid * 4);
            __hip_atomic_store(xs + ((size_t)(u.pm * BM + tid)) * 4 + u.pn, __float_as_uint((p[0] + p[1]) + (p[2] + p[3])), __ATOMIC_RELAXED, __HIP_MEMORY_SCOPE_AGENT); }
        asm volatile("s_waitcnt vmcnt(0)" ::: "memory");
        __syncthreads();
        if (tid == 0) {
            __hip_atomic_fetch_add(cnt + u.pm * 4, 1u, __ATOMIC_RELAXED, __HIP_MEMORY_SCOPE_AGENT);
            unsigned sp = 0u;
            while (__hip_atomic_load(cnt + u.pm * 4, __ATOMIC_RELAXED, __HIP_MEMORY_SCOPE_AGENT) < 4u) { __builtin_amdgcn_s_sleep(1); if (++sp > (1u << 22)) break; }
            __builtin_amdgcn_fence(__ATOMIC_ACQUIRE, "agent");
            asm volatile("s_waitcnt vmcnt(0)" ::: "memory");
        }
        __syncthreads();
        if (tid < 256) { const unsigned* q = xs + ((size_t)(u.pm * BM + tid)) * 4; float t = 0.f;
#pragma unroll
            for (int k = 0; k < 4; ++k) t += __uint_as_float(__hip_atomic_load(q + k, __ATOMIC_RELAXED, __HIP_MEMORY_SCOPE_AGENT));
            S[tid] = rsqrtf(t * (1.0f / 1024.0f) + EPS); }
        asm volatile("s_waitcnt lgkmcnt(0)" ::: "memory"); __syncthreads();
    }
    __device__ __forceinline__ void fused(f32x4 (&acc)[2][2][4][2], const Unit& u, int wr, int wc, int fr, int fq, LAS unsigned char* lds) const {
        const LAS float* S = (const LAS float*)(lds + 4096);
        const int col0 = u.pn * BM + wc * 32 + 4 * fq;
        exchange(acc, u, wr, wc, fr, fq, lds, xs1, cnt1);
        {
            f32x4 gv[2][2];
#pragma unroll
            for (int bj = 0; bj < 2; ++bj)
#pragma unroll
                for (int n = 0; n < 2; ++n) gv[bj][n] = *(const f32x4*)(g1 + col0 + bj * HALF + n * 16);
#pragma unroll
            for (int ai = 0; ai < 2; ++ai) {
                f32x4 xv[4][2][2];
#pragma unroll
                for (int m = 0; m < 4; ++m)
#pragma unroll
                    for (int bj = 0; bj < 2; ++bj)
#pragma unroll
                        for (int n = 0; n < 2; ++n) xv[m][bj][n] = *(const f32x4*)(xin + (size_t)(u.pm * BM + ai * HALF + wr * 64 + m * 16 + fr) * DM + col0 + bj * HALF + n * 16);
#pragma unroll
                for (int m = 0; m < 4; ++m) { const int r = ai * HALF + wr * 64 + m * 16 + fr; const float r1 = S[r];
#pragma unroll
                    for (int bj = 0; bj < 2; ++bj)
#pragma unroll
                        for (int n = 0; n < 2; ++n) { acc[ai][bj][m][n] = xv[m][bj][n] + acc[ai][bj][m][n] * r1 * gv[bj][n];
                            *(f32x4*)(xout + (size_t)(u.pm * BM + r) * DM + col0 + bj * HALF + n * 16) = acc[ai][bj][m][n]; } }
            }
        }
        asm volatile("s_waitcnt lgkmcnt(0)" ::: "memory"); __syncthreads();
        exchange(acc, u, wr, wc, fr, fq, lds, xs2, cnt2);
        {
            f32x4 gv[2][2];
#pragma unroll
            for (int bj = 0; bj < 2; ++bj)
#pragma unroll
                for (int n = 0; n < 2; ++n) gv[bj][n] = *(const f32x4*)(g2 + col0 + bj * HALF + n * 16);
#pragma unroll
            for (int ai = 0; ai < 2; ++ai)
#pragma unroll
                for (int m = 0; m < 4; ++m) { const int r = ai * HALF + wr * 64 + m * 16 + fr; const float r2 = S[r];
#pragma unroll
                    for (int bj = 0; bj < 2; ++bj)
#pragma unroll
                        for (int n = 0; n < 2; ++n) { const f32x4 h = acc[ai][bj][m][n] * r2 * gv[bj][n]; u32x2 w; w.x = cvt_pk_bf16(h[0], h[1]); w.y = cvt_pk_bf16(h[2], h[3]);
                            *(u32x2*)(H2 + (size_t)(u.pm * BM + r) * DM + col0 + bj * HALF + n * 16) = w; } }
        }
        asm volatile("s_waitcnt lgkmcnt(0)" ::: "memory"); __syncthreads();
    }
    __device__ __forceinline__ void operator()(const f32x4 (&)[2][2][4][2], const Unit&, int, int, int, int) const {}
};
}

__device__ __forceinline__ void transpose_tile(const float* src, int ld, int k0, int n0s, bf16_t* dst, int dk, int n0d, LAS float* tile) {
    const int tid = get_tid();
    { const int r = tid >> 4, c4 = (tid & 15) * 4;
#pragma unroll
      for (int i = 0; i < 2; ++i) { const f32x4 v = *(const f32x4*)(src + (size_t)(k0 + r + 32 * i) * ld + n0s + c4);
          LAS float* t = tile + (r + 32 * i) * 65 + c4; t[0] = v[0]; t[1] = v[1]; t[2] = v[2]; t[3] = v[3]; } }
    __syncthreads();
    { const int n = tid >> 3, ks = (tid & 7) * 8; float e[8];
#pragma unroll
      for (int j = 0; j < 8; ++j) e[j] = tile[(ks + j) * 65 + n];
      *(u32x4*)(dst + (size_t)(n0d + n) * dk + k0 + ks) = pack8(e); }
    __syncthreads();
}

__device__ void phase_convert(const Params& P, int l, LAS unsigned char* lds) {
    LAS float* tile = (LAS float*)lds;
    unsigned char* ws = P.ws;
    bf16_t* W1 = (bf16_t*)(ws + WS_W1); bf16_t* WBR = (bf16_t*)(ws + WS_WBR); bf16_t* WMO = (bf16_t*)(ws + WS_WMO); bf16_t* WFF = (bf16_t*)(ws + WS_WFF); bf16_t* WD = (bf16_t*)(ws + WS_WD);
    const float* win = P.w_in + (size_t)l * 1024 * IN_COLS;
#define SEG(src, ld, ktiles, ntiles, n0s, dst, dk, n0d) if (r < (ktiles) * (ntiles)) { const int kt = r / (ntiles), ntl = r % (ntiles); transpose_tile(src, ld, kt * 64, (n0s) + ntl * 64, dst, dk, (n0d) + ntl * 64, tile); continue; } r -= (ktiles) * (ntiles);
    constexpr int total = 16 * 120 + 16 * 48 + 3 * 8 * 16 + 16 * 16 + 16 * 44 + 16 * 44 + 44 * 16;
    for (int it = blockIdx.x; it < total; it += gridDim.x) {
        int r = it;
        SEG(win, IN_COLS, 16, 8, 0, W1, 1024, ZQ)
        SEG(win, IN_COLS, 16, 8, 512, W1, 1024, ZV)
        SEG(win, IN_COLS, 16, 8, 1024, W1, 1024, ZG)
        SEG(win, IN_COLS, 16, 8, 1552, W1, 1024, ZSB)
        SEG(win, IN_COLS, 16, 8, 2064, W1, 1024, ZSC)
        SEG(win, IN_COLS, 16, 8, 2576, W1, 1024, ZSX)
        SEG(win, IN_COLS, 16, 72, 3088, W1, 1024, ZDQ)
        SEG(P.w_gate + (size_t)l * 1024 * 3072, 3072, 16, 48, 0, W1, 1024, 7680)
        SEG(P.w_branch + ((size_t)l * 3 + 0) * 512 * 1024, 1024, 8, 16, 0, WBR, 512, 0)
        SEG(P.w_branch + ((size_t)l * 3 + 1) * 512 * 1024, 1024, 8, 16, 0, WBR + (size_t)1024 * 512, 512, 0)
        SEG(P.w_branch + ((size_t)l * 3 + 2) * 512 * 1024, 1024, 8, 16, 0, WBR + (size_t)2 * 1024 * 512, 512, 0)
        SEG(P.w_mix_out + (size_t)l * 1024 * 1024, 1024, 16, 16, 0, WMO, 1024, 0)
        if (r < 16 * 44) { const int kt = r / 44, ntl = r % 44; transpose_tile(P.w_ff_gate + (size_t)l * 1024 * FF, FF, kt * 64, ntl * 64, WFF, 1024, 256 * (ntl >> 1) + 64 * (ntl & 1), tile); continue; } r -= 16 * 44;
        if (r < 16 * 44) { const int kt = r / 44, ntl = r % 44; transpose_tile(P.w_ff_up + (size_t)l * 1024 * FF, FF, kt * 64, ntl * 64, WFF, 1024, 256 * (ntl >> 1) + 128 + 64 * (ntl & 1), tile); continue; } r -= 16 * 44;
        SEG(P.w_ff_down + (size_t)l * FF * 1024, 1024, 44, 16, 0, WD, FF, 0)
    }
#undef SEG
    { const int t = get_tid();
      if (l == 0 && blockIdx.x == 0 && t < 64) ((float*)(ws + WS_RC))[t] = exp2f(-(float)t * (13.287712379549449f / 64.0f)) * 0.15915494309189535f; }
}

__device__ __forceinline__ float wave_sum(float v) {
#pragma unroll
    for (int o = 32; o >= 1; o >>= 1) v += __shfl_xor(v, o);
    return v;
}

__device__ void phase_norm_alow(const Params& P, int l, int half, LAS unsigned char* lds) {
    const int tid = get_tid(), lane = tid & 63, wave = tid >> 6;
    LAS float* WaT = (LAS float*)lds;
    const float* win = P.w_in + (size_t)l * 1024 * IN_COLS + 1536;
    for (int i = tid; i < 1024 * 4; i += NTHR) { const int k = i >> 2, c4 = (i & 3) * 4; const f32x4 v = *(const f32x4*)(win + (size_t)k * IN_COLS + c4);
        WaT[(c4 + 0) * 1024 + k] = v[0]; WaT[(c4 + 1) * 1024 + k] = v[1]; WaT[(c4 + 2) * 1024 + k] = v[2]; WaT[(c4 + 3) * 1024 + k] = v[3]; }
    __syncthreads();
    const float* xs = (l == 0 ? P.x : P.out) + (size_t)half * TH * DM;
    const float* gg = P.pre_mix_g + (size_t)l * DM;
    bf16_t* H = (bf16_t*)(P.ws + WS_H) + (size_t)half * TH * DM; float* AL = (float*)(P.ws + WS_ALOW);
    f32x4 gv[4];
#pragma unroll
    for (int i = 0; i < 4; ++i) gv[i] = *(const f32x4*)(gg + i * 256 + lane * 4);
    const int rstride = gridDim.x * 8;
    int row = blockIdx.x * 8 + wave;
    f32x4 nv[4];
    if (row < TH) {
#pragma unroll
        for (int i = 0; i < 4; ++i) nv[i] = *(const f32x4*)(xs + (size_t)row * DM + i * 256 + lane * 4);
    }
    for (; row < TH; row += rstride) {
        f32x4 v[4]; float ss = 0.f;
#pragma unroll
        for (int i = 0; i < 4; ++i) { v[i] = nv[i]; ss += v[i][0] * v[i][0] + v[i][1] * v[i][1] + v[i][2] * v[i][2] + v[i][3] * v[i][3]; }
        if (row + rstride < TH) {
#pragma unroll
            for (int i = 0; i < 4; ++i) nv[i] = *(const f32x4*)(xs + (size_t)(row + rstride) * DM + i * 256 + lane * 4);
        }
        ss = wave_sum(ss);
        const float r = rsqrtf(ss * (1.0f / DM) + EPS);
        float a[16];
#pragma unroll
        for (int c = 0; c < 16; ++c) a[c] = 0.f;
#pragma unroll
        for (int i = 0; i < 4; ++i) { f32x4 h = v[i] * r * gv[i];
            u32x2 w; w.x = cvt_pk_bf16(h[0], h[1]); w.y = cvt_pk_bf16(h[2], h[3]);
            *(u32x2*)(H + (size_t)row * DM + i * 256 + lane * 4) = w;
#pragma unroll
            for (int c = 0; c < 16; ++c) { const f32x4 wv = *(const LAS f32x4*)(WaT + c * 1024 + i * 256 + lane * 4); a[c] += h[0] * wv[0] + h[1] * wv[1] + h[2] * wv[2] + h[3] * wv[3]; } }
        float b8[8], b4[4], b2[2], b1;
        { const bool up = (lane & 32) != 0;
#pragma unroll
          for (int c = 0; c < 8; ++c) { const float keep = up ? a[c + 8] : a[c], send = up ? a[c] : a[c + 8]; b8[c] = keep + __shfl_xor(send, 32); } }
        { const bool up = (lane & 16) != 0;
#pragma unroll
          for (int c = 0; c < 4; ++c) { const float keep = up ? b8[c + 4] : b8[c], send = up ? b8[c] : b8[c + 4]; b4[c] = keep + __shfl_xor(send, 16); } }
        { const bool up = (lane & 8) != 0;
#pragma unroll
          for (int c = 0; c < 2; ++c) { const float keep = up ? b4[c + 2] : b4[c], send = up ? b4[c] : b4[c + 2]; b2[c] = keep + __shfl_xor(send, 8); } }
        { const bool up = (lane & 4) != 0; const float keep = up ? b2[1] : b2[0], send = up ? b2[0] : b2[1]; b1 = keep + __shfl_xor(send, 4); }
        b1 += __shfl_xor(b1, 2); b1 += __shfl_xor(b1, 1);
        if ((lane & 3) == 0) { const int co = ((lane >> 5) & 1) * 8 + ((lane >> 4) & 1) * 4 + ((lane >> 3) & 1) * 2 + ((lane >> 2) & 1); AL[(size_t)row * 16 + co] = b1; }
    }
}

__device__ void phase_resid(const float* xin, float* xout, const bf16_t* Y, const float* pg, const float* ng, bf16_t* H2, int nrows) {
    const int tid = get_tid(), lane = tid & 63, wave = tid >> 6;
    f32x4 pgv[4], ngv[4];
#pragma unroll
    for (int i = 0; i < 4; ++i) { pgv[i] = *(const f32x4*)(pg + i * 256 + lane * 4); ngv[i] = ng ? *(const f32x4*)(ng + i * 256 + lane * 4) : (f32x4){0.f, 0.f, 0.f, 0.f}; }
    const int stride = gridDim.x * 8;
    int row = blockIdx.x * 8 + wave;
    u32x2 ny[4]; f32x4 nx[4];
    if (row < nrows) {
#pragma unroll
        for (int i = 0; i < 4; ++i) { ny[i] = *(const u32x2*)(Y + (size_t)row * DM + i * 256 + lane * 4); nx[i] = *(const f32x4*)(xin + (size_t)row * DM + i * 256 + lane * 4); }
    }
    for (; row < nrows; row += stride) {
        f32x4 y[4], xv[4];
#pragma unroll
        for (int i = 0; i < 4; ++i) { y[i] = (f32x4){bflo(ny[i].x), bfhi(ny[i].x), bflo(ny[i].y), bfhi(ny[i].y)}; xv[i] = nx[i]; }
        const int rn = row + stride;
        if (rn < nrows) {
#pragma unroll
            for (int i = 0; i < 4; ++i) { ny[i] = *(const u32x2*)(Y + (size_t)rn * DM + i * 256 + lane * 4); nx[i] = *(const f32x4*)(xin + (size_t)rn * DM + i * 256 + lane * 4); }
        }
        float ss = 0.f;
#pragma unroll
        for (int i = 0; i < 4; ++i) ss += y[i][0] * y[i][0] + y[i][1] * y[i][1] + y[i][2] * y[i][2] + y[i][3] * y[i][3];
        ss = wave_sum(ss);
        const float r = rsqrtf(ss * (1.0f / DM) + EPS);
        float s2 = 0.f;
#pragma unroll
        for (int i = 0; i < 4; ++i) { xv[i] = xv[i] + y[i] * r * pgv[i]; *(f32x4*)(xout + (size_t)row * DM + i * 256 + lane * 4) = xv[i];
            s2 += xv[i][0] * xv[i][0] + xv[i][1] * xv[i][1] + xv[i][2] * xv[i][2] + xv[i][3] * xv[i][3]; }
        if (ng) {
            s2 = wave_sum(s2);
            const float r2 = rsqrtf(s2 * (1.0f / DM) + EPS);
#pragma unroll
            for (int i = 0; i < 4; ++i) { const f32x4 h = xv[i] * r2 * ngv[i]; u32x2 w; w.x = cvt_pk_bf16(h[0], h[1]); w.y = cvt_pk_bf16(h[2], h[3]);
                *(u32x2*)(H2 + (size_t)row * DM + i * 256 + lane * 4) = w; }
        }
    }
}

__device__ void phase_combine(const Params& P) {
    bf16_t* Z = (bf16_t*)(P.ws + WS_Z); const float* LSE = (const float*)(P.ws + WS_LSE);
    const int stride = gridDim.x * NTHR;
    for (int idx0 = blockIdx.x * NTHR + get_tid(); idx0 < TH * 64; idx0 += 2 * stride) {
        float lw[2][3]; u32x4 va[2], vb[2], vc[2]; bf16_t* pp[2]; bool ok[2];
#pragma unroll
        for (int k = 0; k < 2; ++k) { const int idx = idx0 + k * stride; ok[k] = idx < TH * 64; const int id2 = ok[k] ? idx : idx0;
            const int tok = id2 >> 6, c8 = id2 & 63, hh = c8 >> 4, d0 = (c8 & 15) * 8;
            lw[k][0] = LSE[tok * 12 + hh]; lw[k][1] = LSE[tok * 12 + 4 + hh]; lw[k][2] = LSE[tok * 12 + 8 + hh];
            pp[k] = Z + (size_t)tok * ZC + ZDQ + hh * 128 + d0;
            va[k] = *(const u32x4*)pp[k]; vb[k] = *(const u32x4*)(pp[k] + 512); vc[k] = *(const u32x4*)(pp[k] + 1024); }
#pragma unroll
        for (int k = 0; k < 2; ++k) {
            const float mx = fmaxf(lw[k][0], fmaxf(lw[k][1], lw[k][2]));
            float w0 = __expf(lw[k][0] - mx), w1 = __expf(lw[k][1] - mx), w2 = __expf(lw[k][2] - mx);
            const float inv = 1.0f / (w0 + w1 + w2); w0 *= inv; w1 *= inv; w2 *= inv;
            float a[8], b[8], c[8], o[8];
            unpack8(va[k], a); unpack8(vb[k], b); unpack8(vc[k], c);
#pragma unroll
            for (int j = 0; j < 8; ++j) o[j] = w0 * a[j] + w1 * b[j] + w2 * c[j];
            if (ok[k]) *(u32x4*)pp[k] = pack8(o);
        }
    }
}

__device__ void phase_ffn_fix(const Params& P, int l) {
    bf16_t* ACT = (bf16_t*)(P.ws + WS_U); const float* HG = (const float*)(P.ws + WS_HG); const float* HU = (const float*)(P.ws + WS_HU);
    const float* cw = P.ff_conv_w + (size_t)l * 3 * FF; const float* cb = P.ff_conv_b + (size_t)l * FF;
    for (int idx = blockIdx.x * NTHR + get_tid(); idx < 128 * (FF / 8); idx += gridDim.x * NTHR) {
        const int pm = idx / (FF / 8), c0 = (idx % (FF / 8)) * 8;
        float o0[8], o1[8];
#pragma unroll
        for (int hf = 0; hf < 2; ++hf) {
            const int c = c0 + 4 * hf;
            const f32x4 z = (f32x4){0.f, 0.f, 0.f, 0.f};
            const bool first = (pm & 7) == 0;
            const f32x4 gm2 = first ? z : *(const f32x4*)(HG + ((size_t)(pm - 1) * 4 + 2) * FF + c), gm1 = first ? z : *(const f32x4*)(HG + ((size_t)(pm - 1) * 4 + 3) * FF + c);
            const f32x4 g0 = *(const f32x4*)(HG + ((size_t)pm * 4 + 0) * FF + c), g1 = *(const f32x4*)(HG + ((size_t)pm * 4 + 1) * FF + c);
            const f32x4 u0 = *(const f32x4*)(HU + ((size_t)pm * 2 + 0) * FF + c), u1 = *(const f32x4*)(HU + ((size_t)pm * 2 + 1) * FF + c);
            const f32x4 w0 = *(const f32x4*)(cw + c), w1 = *(const f32x4*)(cw + FF + c), w2 = *(const f32x4*)(cw + 2 * FF + c), bb = *(const f32x4*)(cb + c);
#pragma unroll
            for (int j = 0; j < 4; ++j) { o0[4 * hf + j] = pg8::gelu_tanh_mul(w0[j] * gm2[j] + w1[j] * gm1[j] + w2[j] * g0[j] + bb[j], u0[j]);
                                          o1[4 * hf + j] = pg8::gelu_tanh_mul(w0[j] * gm1[j] + w1[j] * g0[j] + w2[j] * g1[j] + bb[j], u1[j]); }
        }
        *(u32x4*)(ACT + (size_t)(pm * 256 + 0) * FF + c0) = pack8(o0);
        *(u32x4*)(ACT + (size_t)(pm * 256 + 1) * FF + c0) = pack8(o1);
    }
}

__device__ __forceinline__ void sc_item(const Params& P, int l, int si) {
    bf16_t* Z = (bf16_t*)(P.ws + WS_Z);
    const int tid = get_tid(), cgi = tid & 63, run = tid >> 6, c0 = cgi * 8, t0 = si * 128 + run * 16;
    const float* cw = P.sc_conv_w + (size_t)l * 3 * 512;
    float w0[8], w1[8], w2[8];
#pragma unroll
    for (int j = 0; j < 8; ++j) { w0[j] = cw[c0 + j]; w1[j] = cw[512 + c0 + j]; w2[j] = cw[1024 + c0 + j]; }
    float p1[8], p2[8];
    if ((t0 & 2047) != 0) {
        float a[8], b[8];
        unpack8(*(const u32x4*)(Z + (size_t)(t0 - 1) * ZC + ZSC + c0), a); unpack8(*(const u32x4*)(Z + (size_t)(t0 - 1) * ZC + ZSX + c0), b);
#pragma unroll
        for (int j = 0; j < 8; ++j) p1[j] = a[j] * b[j];
        unpack8(*(const u32x4*)(Z + (size_t)(t0 - 2) * ZC + ZSC + c0), a); unpack8(*(const u32x4*)(Z + (size_t)(t0 - 2) * ZC + ZSX + c0), b);
#pragma unroll
        for (int j = 0; j < 8; ++j) p2[j] = a[j] * b[j];
    } else {
#pragma unroll
        for (int j = 0; j < 8; ++j) { p1[j] = 0.f; p2[j] = 0.f; } }
    for (int tt = 0; tt < 16; tt += 4) {
        u32x4 va[4], vb[4], vs[4];
#pragma unroll
        for (int k = 0; k < 4; ++k) { const bf16_t* zr = Z + (size_t)(t0 + tt + k) * ZC; va[k] = *(const u32x4*)(zr + ZSC + c0); vb[k] = *(const u32x4*)(zr + ZSX + c0); vs[k] = *(const u32x4*)(zr + ZSB + c0); }
#pragma unroll
        for (int k = 0; k < 4; ++k) {
            float a[8], b[8], sb[8], o[8];
            unpack8(va[k], a); unpack8(vb[k], b); unpack8(vs[k], sb);
#pragma unroll
            for (int j = 0; j < 8; ++j) { const float p0 = a[j] * b[j]; o[j] = sb[j] * (w0[j] * p2[j] + w1[j] * p1[j] + w2[j] * p0); p2[j] = p1[j]; p1[j] = p0; }
            *(u32x4*)(Z + (size_t)(t0 + tt + k) * ZC + ZSB + c0) = pack8(o);
        }
    }
}

__device__ __forceinline__ void attn_item(const Params& P, int half, int item, LAS unsigned char* lds, unsigned* ctr) {
    const int tid = get_tid(), lane = tid & 63, w = __builtin_amdgcn_readfirstlane(tid >> 6), g = lane >> 4, c = lane & 15;
    const int b = item / 192, rem = item % 192, gi = rem / 64, r2 = rem % 64;
    const int dil = (gi == 0) ? 1 : (gi == 1 ? 4 : 16), nb = 16 / dil;
    const int n = r2 % nb, t2 = r2 / nb, hh = t2 & 3, rr = t2 >> 2;
    bf16_t* Z = (bf16_t*)(P.ws + WS_Z);
    const float* RC = (const float*)(P.ws + WS_RC); const float* RS = (const float*)(P.ws + WS_RS);
    float* LSE = (float*)(P.ws + WS_LSE);
    const int colq = ZDQ + gi * 512 + hh * 128, colk = ZDK + gi * 512 + hh * 128, colv = ZDV + gi * 512 + hh * 128;
    const int rowb = b * 2048, gtb = half * TH;
    constexpr int KSTR = 272, VSTR = 528;
    LAS unsigned char* Ks = lds; LAS unsigned char* Vt = lds + 256 * KSTR;
    constexpr float QSCALE = 0.08838834764831845f * 1.4426950408889634f;

    const int km = tid >> 1, khf = tid & 1, klk = (n - 1) * 128 + km;
    const int vkb = tid & 31, vdb = tid >> 5, vlk0 = (n - 1) * 128 + vkb * 8;
    const int qi = 16 * w + c, qrow = rowb + (n * 128 + qi) * dil + rr;
    u32x4 kx1[4], kx2[4]; f32x4 kinv[8]; float kpos = 0.f;
    u32x4 rv[8];
    u32x4 qx1[2], qx2[2]; f32x4 qinv[4]; float qpos;
    if (klk >= 0) {
        const int krow = rowb + klk * dil + rr;
        const bf16_t* kp = Z + (size_t)krow * ZC + colk + khf * 32;
        kpos = (float)P.pos[gtb + krow];
#pragma unroll
        for (int cc = 0; cc < 4; ++cc) { kx1[cc] = *(const u32x4*)(kp + cc * 8); kx2[cc] = *(const u32x4*)(kp + 64 + cc * 8);
            kinv[2 * cc] = *(const f32x4*)(RC + khf * 32 + cc * 8); kinv[2 * cc + 1] = *(const f32x4*)(RC + khf * 32 + cc * 8 + 4); }
    } else {
#pragma unroll
        for (int cc = 0; cc < 4; ++cc) { kx1[cc] = (u32x4){0u, 0u, 0u, 0u}; kx2[cc] = (u32x4){0u, 0u, 0u, 0u};
            kinv[2 * cc] = (f32x4){0.f, 0.f, 0.f, 0.f}; kinv[2 * cc + 1] = (f32x4){0.f, 0.f, 0.f, 0.f}; }
    }
    if (vlk0 >= 0) {
#pragma unroll
        for (int kk = 0; kk < 8; ++kk) { const int row = rowb + (vlk0 + kk) * dil + rr; rv[kk] = *(const u32x4*)(Z + (size_t)row * ZC + colv + vdb * 8); }
    } else {
#pragma unroll
        for (int kk = 0; kk < 8; ++kk) rv[kk] = (u32x4){0u, 0u, 0u, 0u};
    }
    {
        const bf16_t* qp = Z + (size_t)qrow * ZC + colq + 8 * g;
        qpos = (float)P.pos[gtb + qrow];
#pragma unroll
        for (int kh = 0; kh < 2; ++kh) { qx1[kh] = *(const u32x4*)(qp + kh * 32); qx2[kh] = *(const u32x4*)(qp + 64 + kh * 32);
            qinv[2 * kh] = *(const f32x4*)(RC + kh * 32 + 8 * g); qinv[2 * kh + 1] = *(const f32x4*)(RC + kh * 32 + 8 * g + 4); }
    }
    {
        LAS unsigned char* kd = Ks + km * KSTR;
#pragma unroll
        for (int cc = 0; cc < 4; ++cc) {
            float x1[8], x2[8], o1[8], o2[8];
            unpack8(kx1[cc], x1); unpack8(kx2[cc], x2);
            f32x4 c0, c1, s0, s1;
#pragma unroll
            for (int j = 0; j < 4; ++j) { const float r0 = __builtin_amdgcn_fractf(kpos * kinv[2 * cc][j]), r1 = __builtin_amdgcn_fractf(kpos * kinv[2 * cc + 1][j]);
                c0[j] = __builtin_amdgcn_cosf(r0); s0[j] = __builtin_amdgcn_sinf(r0); c1[j] = __builtin_amdgcn_cosf(r1); s1[j] = __builtin_amdgcn_sinf(r1); }
#pragma unroll
            for (int j = 0; j < 4; j += 2) {
                { const f32x2 X1 = (f32x2){x1[j], x1[j + 1]}, X2 = (f32x2){x2[j], x2[j + 1]}, C = (f32x2){c0[j], c0[j + 1]}, Sn = (f32x2){s0[j], s0[j + 1]};
                  const f32x2 A = X1 * C - X2 * Sn, B = X2 * C + X1 * Sn; o1[j] = A.x; o1[j + 1] = A.y; o2[j] = B.x; o2[j + 1] = B.y; }
                { const f32x2 X1 = (f32x2){x1[4 + j], x1[5 + j]}, X2 = (f32x2){x2[4 + j], x2[5 + j]}, C = (f32x2){c1[j], c1[j + 1]}, Sn = (f32x2){s1[j], s1[j + 1]};
                  const f32x2 A = X1 * C - X2 * Sn, B = X2 * C + X1 * Sn; o1[4 + j] = A.x; o1[5 + j] = A.y; o2[4 + j] = B.x; o2[5 + j] = B.y; } }
            *(LAS u32x4*)(kd + (khf * 32 + cc * 8) * 2) = pack8(o1); *(LAS u32x4*)(kd + (64 + khf * 32 + cc * 8) * 2) = pack8(o2);
        }
    }
    {
#pragma unroll
        for (int dd = 0; dd < 8; ++dd) {
            const int wi = dd >> 1; u32x4 o;
            if (dd & 1) { o.x = __builtin_amdgcn_perm(rv[1][wi], rv[0][wi], 0x07060302u); o.y = __builtin_amdgcn_perm(rv[3][wi], rv[2][wi], 0x07060302u); o.z = __builtin_amdgcn_perm(rv[5][wi], rv[4][wi], 0x07060302u); o.w = __builtin_amdgcn_perm(rv[7][wi], rv[6][wi], 0x07060302u); }
            else { o.x = __builtin_amdgcn_perm(rv[1][wi], rv[0][wi], 0x05040100u); o.y = __builtin_amdgcn_perm(rv[3][wi], rv[2][wi], 0x05040100u); o.z = __builtin_amdgcn_perm(rv[5][wi], rv[4][wi], 0x05040100u); o.w = __builtin_amdgcn_perm(rv[7][wi], rv[6][wi], 0x05040100u); }
            *(LAS u32x4*)(Vt + (vdb * 8 + dd) * VSTR + vkb * 16) = o;
        }
    }
    bf16x8 Qf[4];
    {
#pragma unroll
        for (int kh = 0; kh < 2; ++kh) {
            float x1[8], x2[8], o1[8], o2[8];
            unpack8(qx1[kh], x1); unpack8(qx2[kh], x2);
            f32x4 c0, c1, s0, s1;
#pragma unroll
            for (int j = 0; j < 4; ++j) { const float r0 = __builtin_amdgcn_fractf(qpos * qinv[2 * kh][j]), r1 = __builtin_amdgcn_fractf(qpos * qinv[2 * kh + 1][j]);
                c0[j] = __builtin_amdgcn_cosf(r0); s0[j] = __builtin_amdgcn_sinf(r0); c1[j] = __builtin_amdgcn_cosf(r1); s1[j] = __builtin_amdgcn_sinf(r1); }
#pragma unroll
            for (int j = 0; j < 4; j += 2) {
                { const f32x2 X1 = (f32x2){x1[j], x1[j + 1]} * QSCALE, X2 = (f32x2){x2[j], x2[j + 1]} * QSCALE, C = (f32x2){c0[j], c0[j + 1]}, Sn = (f32x2){s0[j], s0[j + 1]};
                  const f32x2 A = X1 * C - X2 * Sn, B = X2 * C + X1 * Sn; o1[j] = A.x; o1[j + 1] = A.y; o2[j] = B.x; o2[j + 1] = B.y; }
                { const f32x2 X1 = (f32x2){x1[4 + j], x1[5 + j]} * QSCALE, X2 = (f32x2){x2[4 + j], x2[5 + j]} * QSCALE, C = (f32x2){c1[j], c1[j + 1]}, Sn = (f32x2){s1[j], s1[j + 1]};
                  const f32x2 A = X1 * C - X2 * Sn, B = X2 * C + X1 * Sn; o1[4 + j] = A.x; o1[5 + j] = A.y; o2[4 + j] = B.x; o2[5 + j] = B.y; } }
            Qf[kh] = as_bf16x8(pack8(o1)); Qf[kh + 2] = as_bf16x8(pack8(o2));
        }
    }
    __syncthreads();
    unsigned nxt_id = 0u;
    if (tid == 0) nxt_id = atomicAdd(ctr, 1u);
    const int m0 = (16 * w < 96) ? 16 * w : 96;
    f32x4 S[10];
#pragma unroll
    for (int jt = 0; jt < 10; ++jt) {
        S[jt] = (f32x4){0.f, 0.f, 0.f, 0.f};
        const LAS unsigned char* kr = Ks + (m0 + jt * 16 + c) * KSTR + 16 * g;
#pragma unroll
        for (int ks = 0; ks < 4; ++ks) { const bf16x8 a = *(const LAS bf16x8*)(kr + ks * 64); S[jt] = __builtin_amdgcn_mfma_f32_16x16x32_bf16(a, Qf[ks], S[jt], 0, 0, 0); }
    }
    float mx = -INFINITY;
    const int dbase = qi + 128 - m0 - 4 * g;
    const unsigned dlim = (unsigned)((n == 0) ? (qi < 128 ? qi : 128) : 128);
#pragma unroll
    for (int jt = 0; jt < 10; ++jt)
#pragma unroll
        for (int jj = 0; jj < 4; ++jj) { const bool ok = (unsigned)(dbase - (jt * 16 + jj)) <= dlim;
            const float s = ok ? S[jt][jj] : -INFINITY; S[jt][jj] = s; mx = fmaxf(mx, s); }
    mx = fmaxf(mx, __shfl_xor(mx, 16)); mx = fmaxf(mx, __shfl_xor(mx, 32));
    float den = 0.f;
#pragma unroll
    for (int jt = 0; jt < 10; ++jt) { const f32x4 d = S[jt] - mx; f32x4 p; p[0] = __builtin_amdgcn_exp2f(d[0]); p[1] = __builtin_amdgcn_exp2f(d[1]); p[2] = __builtin_amdgcn_exp2f(d[2]); p[3] = __builtin_amdgcn_exp2f(d[3]);
        S[jt] = p; den += (p[0] + p[1]) + (p[2] + p[3]); }
    den += __shfl_xor(den, 16); den += __shfl_xor(den, 32);
    bf16x8 Pf[5];
#pragma unroll
    for (int k5 = 0; k5 < 5; ++k5) { u32x4 pw; pw.x = cvt_pk_bf16(S[2 * k5][0], S[2 * k5][1]); pw.y = cvt_pk_bf16(S[2 * k5][2], S[2 * k5][3]); pw.z = cvt_pk_bf16(S[2 * k5 + 1][0], S[2 * k5 + 1][1]); pw.w = cvt_pk_bf16(S[2 * k5 + 1][2], S[2 * k5 + 1][3]); Pf[k5] = as_bf16x8(pw); }
    const float inv = 1.0f / den;
    bf16_t* op = Z + (size_t)qrow * ZC + colq + 4 * g;
#pragma unroll
    for (int dt = 0; dt < 8; ++dt) {
        f32x4 O = (f32x4){0.f, 0.f, 0.f, 0.f};
        const LAS unsigned char* vr = Vt + (dt * 16 + c) * VSTR + (m0 + 4 * g) * 2;
#pragma unroll
        for (int k5 = 0; k5 < 5; ++k5) { const u32x2 lo = *(const LAS u32x2*)(vr + k5 * 64), hi = *(const LAS u32x2*)(vr + k5 * 64 + 32);
            const bf16x8 a = as_bf16x8((u32x4){lo.x, lo.y, hi.x, hi.y}); O = __builtin_amdgcn_mfma_f32_16x16x32_bf16(a, Pf[k5], O, 0, 0, 0); }
        u32x2 ow; ow.x = cvt_pk_bf16(O[0] * inv, O[1] * inv); ow.y = cvt_pk_bf16(O[2] * inv, O[3] * inv);
        *(u32x2*)(op + dt * 16) = ow;
    }
    if (g == 0) LSE[(size_t)qrow * 12 + gi * 4 + hh] = (mx + __builtin_amdgcn_logf(den)) * 0.6931471805599453f;
    if (tid == 0) *(LAS unsigned*)(lds + LDS_SLOT) = nxt_id;
    __syncthreads();
}

__device__ __forceinline__ float logsig16(float x) { return (fminf(x, 0.f) - __logf(1.0f + __expf(-fabsf(x)))) * (1.0f / 16.0f); }

#define LBAR() do { asm volatile("s_waitcnt lgkmcnt(0)" ::: "memory"); __builtin_amdgcn_s_barrier(); asm volatile("" ::: "memory"); } while (0)
__device__ void gla_item(const Params& P, int l, int b, int h, int seg, LAS unsigned char* lds) {
    const int tid = get_tid(), lane = tid & 63, w = __builtin_amdgcn_readfirstlane(tid >> 6), g = lane >> 4, c = lane & 15;
    bf16_t* Z = (bf16_t*)(P.ws + WS_Z); const float* AL = (const float*)(P.ws + WS_ALOW);
    LAS float* WUP = (LAS float*)(lds + 0);
    LAS float* BUP = (LAS float*)(lds + 4096);
    LAS float* ARAW = (LAS float*)(lds + 4352);
    LAS float* LC = (LAS float*)(lds + 8448);
    LAS float* SEG = (LAS float*)(lds + 24832);
    LAS float* DEC = (LAS float*)(lds + 26880);
    LAS unsigned char* QP = lds + 29184;
    LAS unsigned char* KP = lds + 38400;
    LAS unsigned char* KPP = lds + 47616;
    LAS unsigned char* AIN = lds + 56832;
    LAS unsigned char* VS = lds + 66048;
    LAS unsigned char* OT = lds + 83456;
    constexpr int QS = 144, VSS = 272;
    for (int i = tid; i < 1024; i += NTHR) { const int r = i >> 6, d = i & 63; WUP[i] = P.w_alpha_up[((size_t)l * 16 + r) * 256 + h * 64 + d]; }
    if (tid < 64) BUP[tid] = P.b_alpha[(size_t)l * 256 + h * 64 + tid];
    f32x4 Sacc[4];
#pragma unroll
    for (int dt = 0; dt < 4; ++dt) Sacc[dt] = (f32x4){0.f, 0.f, 0.f, 0.f};
    const int rowb = b * 2048 + seg * 256;
    const int t_ = tid >> 3, d8 = (tid & 7) * 8;
    u32x4 nq, nk, nv0, nv1; f32x4 na = (f32x4){0.f, 0.f, 0.f, 0.f};
    {
        const size_t r0 = (size_t)(rowb + t_) * ZC;
        nq = *(const u32x4*)(Z + r0 + ZQ + h * 64 + d8); nk = *(const u32x4*)(Z + r0 + ZK + h * 64 + d8);
        nv0 = *(const u32x4*)(Z + (size_t)(rowb + (tid >> 4)) * ZC + ZV + h * 128 + (tid & 15) * 8);
        nv1 = *(const u32x4*)(Z + (size_t)(rowb + 32 + (tid >> 4)) * ZC + ZV + h * 128 + (tid & 15) * 8);
        if (tid < 256) na = *(const f32x4*)(AL + (size_t)(rowb + (tid >> 2)) * 16 + (tid & 3) * 4);
    }
    float Lseg[8];
#pragma unroll
    for (int j = 0; j < 8; ++j) Lseg[j] = 0.f;
    float* DSEG = (float*)(P.ws + WS_DSEG);
    for (int n = 0; n < 4; ++n) {
        if ((n & 3) == 0) {
#pragma unroll
            for (int dt = 0; dt < 4; ++dt) Sacc[dt] = (f32x4){0.f, 0.f, 0.f, 0.f};
#pragma unroll
            for (int j = 0; j < 8; ++j) Lseg[j] = 0.f;
        }
        const int row0 = rowb + n * 64;
        const u32x4 cq = nq, ck = nk;
        *(LAS u32x4*)(VS + (tid >> 4) * VSS + (tid & 15) * 16) = nv0;
        *(LAS u32x4*)(VS + (32 + (tid >> 4)) * VSS + (tid & 15) * 16) = nv1;
        if (tid < 256) *(LAS f32x4*)(ARAW + (tid >> 2) * 16 + (tid & 3) * 4) = na;
        if (n + 1 < 4) {
            const int rn = row0 + 64; const size_t r0 = (size_t)(rn + t_) * ZC;
            nq = *(const u32x4*)(Z + r0 + ZQ + h * 64 + d8); nk = *(const u32x4*)(Z + r0 + ZK + h * 64 + d8);
            nv0 = *(const u32x4*)(Z + (size_t)(rn + (tid >> 4)) * ZC + ZV + h * 128 + (tid & 15) * 8);
            nv1 = *(const u32x4*)(Z + (size_t)(rn + 32 + (tid >> 4)) * ZC + ZV + h * 128 + (tid & 15) * 8);
            if (tid < 256) na = *(const f32x4*)(AL + (size_t)(rn + (tid >> 2)) * 16 + (tid & 3) * 4);
        }
        LBAR();
        {
            float x[8];
#pragma unroll
            for (int j = 0; j < 8; ++j) x[j] = BUP[d8 + j];
#pragma unroll
            for (int r = 0; r < 16; ++r) { const float a = ARAW[t_ * 16 + r]; const f32x4 w0 = *(const LAS f32x4*)(WUP + r * 64 + d8), w1 = *(const LAS f32x4*)(WUP + r * 64 + d8 + 4);
#pragma unroll
                for (int j = 0; j < 4; ++j) { x[j] += a * w0[j]; x[4 + j] += a * w1[j]; } }
            f32x4 o0, o1;
#pragma unroll
            for (int j = 0; j < 4; ++j) { o0[j] = logsig16(x[j]); o1[j] = logsig16(x[4 + j]); }
            *(LAS f32x4*)(LC + t_ * 64 + d8) = o0; *(LAS f32x4*)(LC + t_ * 64 + d8 + 4) = o1;
        }
        LBAR();
        {
            const int d = tid & 63, sg = tid >> 6; float cum[8]; float run = 0.f;
#pragma unroll
            for (int i = 0; i < 8; ++i) { run += LC[(sg * 8 + i) * 64 + d]; cum[i] = run; }
            SEG[sg * 64 + d] = run;
            LBAR();
            float off = 0.f;
#pragma unroll
            for (int s = 0; s < 7; ++s) off += (s < sg) ? SEG[s * 64 + d] : 0.f;
#pragma unroll
            for (int i = 0; i < 8; ++i) LC[(sg * 8 + i) * 64 + d] = cum[i] + off;
        }
        LBAR();
        {
            const f32x4 L0 = *(const LAS f32x4*)(LC + t_ * 64 + d8), L1 = *(const LAS f32x4*)(LC + t_ * 64 + d8 + 4);
            const f32x4 E0 = *(const LAS f32x4*)(LC + 63 * 64 + d8), E1 = *(const LAS f32x4*)(LC + 63 * 64 + d8 + 4);
            float qf[8], kf[8], qo[8], ko[8], k2[8], q2[8];
            unpack8(cq, qf); unpack8(ck, kf);
#pragma unroll
            for (int j = 0; j < 8; ++j) { const float L = (j < 4) ? L0[j & 3] : L1[j & 3], Le = (j < 4) ? E0[j & 3] : E1[j & 3];
                qo[j] = qf[j] * __expf(L) * 0.125f; ko[j] = kf[j] * __expf(-L); k2[j] = kf[j] * __expf(Le - L); q2[j] = qf[j] * __expf(L + Lseg[j]) * 0.125f; Lseg[j] += Le; }
            *(LAS u32x4*)(QP + t_ * QS + d8 * 2) = pack8(qo); *(LAS u32x4*)(KP + t_ * QS + d8 * 2) = pack8(ko); *(LAS u32x4*)(KPP + t_ * QS + d8 * 2) = pack8(k2);
            *(u32x4*)(Z + (size_t)(row0 + t_) * ZC + ZQ + h * 64 + d8) = pack8(q2);
            if (t_ == 0) {
#pragma unroll
                for (int j = 0; j < 8; ++j) DEC[d8 + j] = __expf((j < 4) ? E0[j & 3] : E1[j & 3]); }
        }
        LBAR();
#pragma unroll
        for (int q = 0; q < 2; ++q) {
            const int idx = 2 * w + q, it = idx >> 2, jt = idx & 3;
            f32x4 A = (f32x4){0.f, 0.f, 0.f, 0.f};
            if (jt <= it) {
#pragma unroll
                for (int ks = 0; ks < 2; ++ks) { const bf16x8 a = *(const LAS bf16x8*)(QP + (it * 16 + c) * QS + (ks * 32 + 8 * g) * 2), bb = *(const LAS bf16x8*)(KP + (jt * 16 + c) * QS + (ks * 32 + 8 * g) * 2);
                    A = __builtin_amdgcn_mfma_f32_16x16x32_bf16(a, bb, A, 0, 0, 0); }
            }
#pragma unroll
            for (int jj = 0; jj < 4; ++jj) { const int i = it * 16 + 4 * g + jj, j = jt * 16 + c; const float v = (j <= i) ? A[jj] : 0.f;
                *(LAS unsigned short*)(AIN + i * QS + j * 2) = f2bf(v); }
        }
        LBAR();
        bf16x8 Vb[2];
#pragma unroll
        for (int ks = 0; ks < 2; ++ks) { unsigned short e[8];
#pragma unroll
            for (int j = 0; j < 8; ++j) e[j] = *(const LAS unsigned short*)(VS + (ks * 32 + 8 * g + j) * VSS + (16 * w + c) * 2);
            u32x4 pw; pw.x = e[0] | ((unsigned)e[1] << 16); pw.y = e[2] | ((unsigned)e[3] << 16); pw.z = e[4] | ((unsigned)e[5] << 16); pw.w = e[6] | ((unsigned)e[7] << 16); Vb[ks] = as_bf16x8(pw); }
        bf16x8 Sb[2];
#pragma unroll
        for (int k2 = 0; k2 < 2; ++k2) { u32x4 pw; pw.x = cvt_pk_bf16(Sacc[2 * k2][0], Sacc[2 * k2][1]); pw.y = cvt_pk_bf16(Sacc[2 * k2][2], Sacc[2 * k2][3]);
            pw.z = cvt_pk_bf16(Sacc[2 * k2 + 1][0], Sacc[2 * k2 + 1][1]); pw.w = cvt_pk_bf16(Sacc[2 * k2 + 1][2], Sacc[2 * k2 + 1][3]); Sb[k2] = as_bf16x8(pw); }
        f32x4 Oacc[4];
#pragma unroll
        for (int it = 0; it < 4; ++it) {
            Oacc[it] = (f32x4){0.f, 0.f, 0.f, 0.f};
#pragma unroll
            for (int ks = 0; ks < 2; ++ks) { const bf16x8 a = *(const LAS bf16x8*)(AIN + (it * 16 + c) * QS + (ks * 32 + 8 * g) * 2); Oacc[it] = __builtin_amdgcn_mfma_f32_16x16x32_bf16(a, Vb[ks], Oacc[it], 0, 0, 0); }
#pragma unroll
            for (int k2 = 0; k2 < 2; ++k2) { const u32x2 lo = *(const LAS u32x2*)(QP + (it * 16 + c) * QS + (32 * k2 + 4 * g) * 2), hi = *(const LAS u32x2*)(QP + (it * 16 + c) * QS + (32 * k2 + 16 + 4 * g) * 2);
                const bf16x8 a = as_bf16x8((u32x4){lo.x, lo.y, hi.x, hi.y}); Oacc[it] = __builtin_amdgcn_mfma_f32_16x16x32_bf16(a, Sb[k2], Oacc[it], 0, 0, 0); }
        }
#pragma unroll
        for (int dt = 0; dt < 4; ++dt) {
            const f32x4 dc = *(const LAS f32x4*)(DEC + dt * 16 + 4 * g);
            Sacc[dt] = Sacc[dt] * dc;
#pragma unroll
            for (int ks = 0; ks < 2; ++ks) { unsigned short e[8];
#pragma unroll
                for (int j = 0; j < 8; ++j) e[j] = *(const LAS unsigned short*)(KPP + (ks * 32 + 8 * g + j) * QS + (dt * 16 + c) * 2);
                u32x4 pw; pw.x = e[0] | ((unsigned)e[1] << 16); pw.y = e[2] | ((unsigned)e[3] << 16); pw.z = e[4] | ((unsigned)e[5] << 16); pw.w = e[6] | ((unsigned)e[7] << 16);
                Sacc[dt] = __builtin_amdgcn_mfma_f32_16x16x32_bf16(as_bf16x8(pw), Vb[ks], Sacc[dt], 0, 0, 0); }
        }
#pragma unroll
        for (int it = 0; it < 4; ++it)
#pragma unroll
            for (int jj = 0; jj < 4; ++jj) *(LAS unsigned short*)(OT + (it * 16 + 4 * g + jj) * VSS + (16 * w + c) * 2) = f2bf(Oacc[it][jj]);
        LBAR();
        {
            const u32x4 o0 = *(const LAS u32x4*)(OT + (tid >> 4) * VSS + (tid & 15) * 16), o1 = *(const LAS u32x4*)(OT + (32 + (tid >> 4)) * VSS + (tid & 15) * 16);
            *(u32x4*)(Z + (size_t)(row0 + (tid >> 4)) * ZC + ZV + h * 128 + (tid & 15) * 8) = o0;
            *(u32x4*)(Z + (size_t)(row0 + 32 + (tid >> 4)) * ZC + ZV + h * 128 + (tid & 15) * 8) = o1;
        }
        if ((n & 3) == 3) {
            const int rs0 = rowb;
#pragma unroll
            for (int dt = 0; dt < 4; ++dt)
#pragma unroll
                for (int jj = 0; jj < 4; ++jj) { const int d = dt * 16 + 4 * g + jj, dv = 16 * w + c; *((float*)(Z + (size_t)(rs0 + d * 4 + (dv >> 5)) * ZC + ZK + h * 64) + (dv & 31)) = Sacc[dt][jj]; }            if (t_ == 0) {
#pragma unroll
                for (int j = 0; j < 8; ++j) DSEG[(size_t)((b * 4 + h) * 8 + seg) * 64 + d8 + j] = __expf(Lseg[j]); }
        }
    }
    __syncthreads();
}


__device__ __forceinline__ float dpp_row_sum16(float v) {
    v += __int_as_float(__builtin_amdgcn_update_dpp(0, __float_as_int(v), 0xB1, 0xf, 0xf, false));
    v += __int_as_float(__builtin_amdgcn_update_dpp(0, __float_as_int(v), 0x4E, 0xf, 0xf, false));
    v += __int_as_float(__builtin_amdgcn_update_dpp(0, __float_as_int(v), 0x141, 0xf, 0xf, false));
    v += __int_as_float(__builtin_amdgcn_update_dpp(0, __float_as_int(v), 0x140, 0xf, 0xf, false));
    return v;
}
__device__ void gla_C(const Params& P, int l, int item, LAS unsigned char* lds) {
    const int tid = get_tid(), lane = tid & 63, w = __builtin_amdgcn_readfirstlane(tid >> 6), g = lane >> 4, c = lane & 15;
    const int seg = item & 7, bh = item >> 3, b = bh >> 2, h = bh & 3;
    bf16_t* Z = (bf16_t*)(P.ws + WS_Z);
    LAS float* SSQ = (LAS float*)lds;
    LAS unsigned char* OT = lds + 8192;
    LAS unsigned char* GTL = lds + 8192 + 256 * 272;
    const float ng = P.gla_norm_g[(size_t)l * 128 + 16 * w + c];
    const float* DSEG = (const float*)(P.ws + WS_DSEG);
    float Sin[2][8];
#pragma unroll
    for (int ks = 0; ks < 2; ++ks)
#pragma unroll
        for (int e = 0; e < 8; ++e) Sin[ks][e] = 0.f;
    for (int sq = 0; sq < seg; sq += 2) {
        const bool two = (sq + 1 < seg);
        float Da[2][8], Sa[2][8], Db[2][8], Sbv[2][8];
        { const int rs0 = b * 2048 + sq * 256; const size_t it2 = (size_t)bh * 8 + sq;
#pragma unroll
          for (int ks = 0; ks < 2; ++ks)
#pragma unroll
            for (int e = 0; e < 8; ++e) { const int d = ks * 32 + 8 * g + e, dv = 16 * w + c; Da[ks][e] = DSEG[it2 * 64 + d]; Sa[ks][e] = *((const float*)(Z + (size_t)(rs0 + d * 4 + (dv >> 5)) * ZC + ZK + h * 64) + (dv & 31)); } }
        { const int s1 = two ? sq + 1 : sq; const int rs0 = b * 2048 + s1 * 256; const size_t it2 = (size_t)bh * 8 + s1;
#pragma unroll
          for (int ks = 0; ks < 2; ++ks)
#pragma unroll
            for (int e = 0; e < 8; ++e) { const int d = ks * 32 + 8 * g + e, dv = 16 * w + c; Db[ks][e] = DSEG[it2 * 64 + d]; Sbv[ks][e] = *((const float*)(Z + (size_t)(rs0 + d * 4 + (dv >> 5)) * ZC + ZK + h * 64) + (dv & 31)); } }
#pragma unroll
        for (int ks = 0; ks < 2; ++ks)
#pragma unroll
            for (int e = 0; e < 8; ++e) { float v = Da[ks][e] * Sin[ks][e] + Sa[ks][e]; if (two) v = Db[ks][e] * v + Sbv[ks][e]; Sin[ks][e] = v; }
    }
    bf16x8 Sb[2];
#pragma unroll
    for (int ks = 0; ks < 2; ++ks) Sb[ks] = as_bf16x8(pack8(Sin[ks]));
    const int row0 = b * 2048 + seg * 256;
    {
        u32x4 ov[8], gv[8];
#pragma unroll
        for (int i = 0; i < 8; ++i) { const int p = tid + i * NTHR, r = p >> 4, sg = p & 15; const bf16_t* zr = Z + (size_t)(row0 + r) * ZC + h * 128 + sg * 8; ov[i] = *(const u32x4*)(zr + ZV); gv[i] = *(const u32x4*)(zr + ZG); }
#pragma unroll
        for (int i = 0; i < 8; ++i) { const int p = tid + i * NTHR, r = p >> 4, sg = p & 15; *(LAS u32x4*)(OT + r * 272 + sg * 16) = ov[i]; *(LAS u32x2*)(GTL + r * 264 + sg * 16) = (u32x2){gv[i].x, gv[i].y}; *(LAS u32x2*)(GTL + r * 264 + sg * 16 + 8) = (u32x2){gv[i].z, gv[i].w}; }
    }
    __syncthreads();
    f32x4 O[16];
#pragma unroll
    for (int rt = 0; rt < 16; ++rt) {
#pragma unroll
        for (int jj = 0; jj < 4; ++jj) O[rt][jj] = bf2f(*(const LAS unsigned short*)(OT + (rt * 16 + 4 * g + jj) * 272 + (16 * w + c) * 2));
        if (seg > 0) {
#pragma unroll
            for (int ks = 0; ks < 2; ++ks) { const bf16x8 a = as_bf16x8(*(const u32x4*)(Z + (size_t)(row0 + rt * 16 + c) * ZC + ZQ + h * 64 + ks * 32 + 8 * g)); O[rt] = __builtin_amdgcn_mfma_f32_16x16x32_bf16(a, Sb[ks], O[rt], 0, 0, 0); }
        }
    }
    {
#pragma unroll
        for (int rt = 0; rt < 16; ++rt) {
            float sv[4];
#pragma unroll
            for (int jj = 0; jj < 4; ++jj) sv[jj] = O[rt][jj] * O[rt][jj];
#pragma unroll
            for (int jj = 0; jj < 4; ++jj) sv[jj] = dpp_row_sum16(sv[jj]);
            if (c == 0) {
#pragma unroll
                for (int jj = 0; jj < 4; ++jj) SSQ[w * 256 + rt * 16 + 4 * g + jj] = sv[jj]; }
        }
    }
    __syncthreads();
#pragma unroll
    for (int rt = 0; rt < 16; ++rt)
#pragma unroll
        for (int jj = 0; jj < 4; ++jj) { const int t = rt * 16 + 4 * g + jj; float tot = 0.f;
#pragma unroll
            for (int ww = 0; ww < 8; ++ww) tot += SSQ[ww * 256 + t];
            const float rs = rsqrtf(tot * (1.0f / 128.0f) + EPS);
            const float gt = bf2f(*(const LAS unsigned short*)(GTL + t * 264 + (16 * w + c) * 2));
            *(LAS unsigned short*)(OT + t * 272 + (16 * w + c) * 2) = f2bf(O[rt][jj] * rs * ng * (gt * __builtin_amdgcn_rcpf(1.0f + __expf(-gt)))); }
    __syncthreads();
#pragma unroll
    for (int i = 0; i < 8; ++i) { const int p = tid + i * NTHR, r = p >> 4, sg = p & 15;
        *(u32x4*)(Z + (size_t)(row0 + r) * ZC + ZG + h * 128 + sg * 8) = *(const LAS u32x4*)(OT + r * 272 + sg * 16); }
    __syncthreads();
}

__device__ __forceinline__ int next_item(unsigned* ctr, LAS unsigned char* lds) {
    __syncthreads();
    if (threadIdx.x == 0) *(LAS unsigned*)(lds + LDS_SLOT) = atomicAdd(ctr, 1u);
    __syncthreads();
    return (int)*(LAS unsigned*)(lds + LDS_SLOT);
}

__device__ void phase_branches(const Params& P, int l, int half, LAS unsigned char* lds) {
    unsigned* ctr = (unsigned*)(P.ws + WS_CTL) + 64 * (l * 2 + half);
    for (int it = blockIdx.x; it < 256; it += gridDim.x) gla_item(P, l, it >> 5, (it >> 3) & 3, it & 7, lds);
    int it = next_item(ctr, lds);
    while (it < 1536 + 128) {
        if (it < 1536) { attn_item(P, half, it, lds, ctr); it = (int)*(LAS unsigned*)(lds + LDS_SLOT); }
        else { sc_item(P, l, it - 1536); it = next_item(ctr, lds); }
    }
}


#define XB_TMO      128
#define XB_XCNT(j)  (256  + 64 * (j))
#define XB_XSUB(j)  (1280 + 64 * (j))
#define XB_XGEN(j)  (2304 + 64 * (j))
#define XB_TOP      3328
#define XB_TOPGEN   3392
#define XCD_BAR_WORDS 3456
#define XB_SPIN_CAP (1u << 20)
__device__ __forceinline__ unsigned xb_ld(unsigned* p)              { return __hip_atomic_load(p, __ATOMIC_RELAXED, __HIP_MEMORY_SCOPE_AGENT); }
__device__ __forceinline__ unsigned xb_add(unsigned* p, unsigned v) { return __hip_atomic_fetch_add(p, v, __ATOMIC_RELAXED, __HIP_MEMORY_SCOPE_AGENT); }
__device__ __forceinline__ unsigned xb_xcc_id() { return (unsigned)__builtin_amdgcn_s_getreg((3 << 11) | 20) & 0xFu; }
#define XB_SPIN(cond, bar) do { unsigned _sp = 0; while (cond) { __builtin_amdgcn_s_sleep(1); \
    if ((++_sp & 255u) == 0u) { if (xb_ld(&(bar)[XB_TMO])) break; if (_sp > XB_SPIN_CAP) { atomicAdd(&(bar)[XB_TMO], 1u); break; } } } } while (0)
struct XcdBarrier { unsigned* bar; unsigned x; volatile LAS unsigned* st; };
__device__ __forceinline__ XcdBarrier xcd_barrier_post(unsigned* bar, volatile LAS unsigned* st) {
    XcdBarrier b; b.bar = bar; b.x = xb_xcc_id(); b.st = st;
    if (threadIdx.x == 0) (void)xb_add(&bar[XB_XCNT(b.x)], 1u);
    return b;
}
__device__ __forceinline__ void xcd_barrier_complete(unsigned* bar, unsigned x, unsigned& nloc, unsigned& nx) {
    const unsigned G = gridDim.x * gridDim.y * gridDim.z;
    unsigned sum, cnt, mine, sp = 0u;
    for (;;) {
        sum = 0u; cnt = 0u; mine = 0u;
#pragma unroll
        for (unsigned j = 0; j < 16; ++j) { const unsigned c = xb_ld(&bar[XB_XCNT(j)]); sum += c; cnt += (c > 0u) ? 1u : 0u; mine = (j == x) ? c : mine; }
        if (sum == G) break;
        __builtin_amdgcn_s_sleep(1);
        if ((++sp & 255u) == 0u) { if (xb_ld(&bar[XB_TMO])) break; if (sp > XB_SPIN_CAP) { atomicAdd(&bar[XB_TMO], 1u); break; } }
    }
    nloc = mine > 0u ? mine : 1u; nx = cnt > 0u ? cnt : 1u;
}
__device__ __forceinline__ void xcd_barrier(const XcdBarrier& b) {
    asm volatile("s_waitcnt vmcnt(0)" ::: "memory");
    __syncthreads();
    if (threadIdx.x == 0) {
        unsigned* bar = b.bar;
        __builtin_amdgcn_s_waitcnt(0);
        unsigned nloc = b.st[0], nx = b.st[1];
        if (nloc == 0u) { xcd_barrier_complete(bar, b.x, nloc, nx); b.st[0] = nloc; b.st[1] = nx; }
        const unsigned old = xb_add(&bar[XB_XSUB(b.x)], 1u);
        const unsigned gen = old / nloc;
        if (old + 1u == (gen + 1u) * nloc) {
            __builtin_amdgcn_fence(__ATOMIC_RELEASE, "agent");
            asm volatile("s_waitcnt vmcnt(0)" ::: "memory");
            const unsigned og = xb_add(&bar[XB_TOP], 1u);
            const unsigned tg = og / nx;
            if (og + 1u == (tg + 1u) * nx) xb_add(&bar[XB_TOPGEN], 1u);
            else XB_SPIN(xb_ld(&bar[XB_TOPGEN]) == tg, bar);
            __builtin_amdgcn_fence(__ATOMIC_ACQUIRE, "agent");
            xb_add(&bar[XB_XGEN(b.x)], 1u);
            asm volatile("s_waitcnt vmcnt(0)" ::: "memory");
        } else {
            XB_SPIN(xb_ld(&bar[XB_XGEN(b.x)]) == gen, bar);
            __builtin_amdgcn_fence(__ATOMIC_ACQUIRE, "agent");
            asm volatile("s_waitcnt vmcnt(0)" ::: "memory");
        }
    }
    __syncthreads();
}

__global__ void __launch_bounds__(NTHR, 2) fwd_kernel(Params P) {
    extern __shared__ __attribute__((aligned(16))) unsigned char smem[];
    LAS unsigned char* lds = (LAS unsigned char*)smem;
    cg::grid_group grid = cg::this_grid();
    if (threadIdx.x < 4) ((LAS unsigned*)(lds + LDS_BYTES - 32))[threadIdx.x] = 0u;
    __syncthreads();
    const XcdBarrier xb = xcd_barrier_post((unsigned*)(P.ws + WS_BAR), (volatile LAS unsigned*)(lds + LDS_BYTES - 32));
    unsigned char* ws = P.ws;
    const int lo = P.ph_lo, hi = P.ph_hi;
    const bool fuse = (gridDim.x == 256);
    for (int ph = lo; ph < hi; ++ph) {
        const int l = ph / 19, q = ph % 19;
        const int half = (q >= 8 && q <= 14) ? 1 : 0;
        const int k = (q == 0) ? 0 : (q <= 14 ? 1 + (q - 1) % 7 : q - 7);
        switch (k) {
        case 0: if (l == 0) { phase_convert(P, l, lds); phase_norm_alow(P, 0, 0, lds); } break;
        case 1: break;
        case 2: { pg8::Gemm g{(const bf16_t*)(ws + WS_H) + (size_t)half * TH * DM, (const bf16_t*)(ws + WS_W1), 1024, 1024, 1024, 0, 0}; pg8::Order S; S.init(TH, 10752, gridDim.x, blockIdx.x, 1);
                  pg8::EpiSplit E{(bf16_t*)(ws + WS_Z), ZC, (bf16_t*)(ws + WS_GT), GC, 30, P.b_gate + (size_t)l * GC}; pg8::gemm_phase(lds, g, S, E); } break;
        case 3: phase_branches(P, l, half, lds); break;
        case 4: for (int it = blockIdx.x; it < 256; it += gridDim.x) gla_C(P, l, it, lds); phase_combine(P); break;
        case 5: { pg8::Gemm g{(const bf16_t*)(ws + WS_Z) + ZG, (const bf16_t*)(ws + WS_WBR), ZC, 512, 512, (size_t)1024, (size_t)1024 * 512};
                  pg8::Order S; S.init(TH, 1024, gridDim.x, blockIdx.x, 3);
                  pg8::EpiMerge E{(const bf16_t*)(ws + WS_GT), (bf16_t*)(ws + WS_MG)}; pg8::gemm_phase(lds, g, S, E); } break;
        case 6: if (fuse) {
                      const int inst = l * 2 + half;
                      pg8::Gemm g{(const bf16_t*)(ws + WS_MG), (const bf16_t*)(ws + WS_WMO), 1024, 1024, 1024, 0, 0}; pg8::Order S; S.init(TH, 1024, gridDim.x, blockIdx.x, 1);
                      pg8::EpiNormRes E{(l == 0 ? P.x : P.out) + (size_t)half * TH * DM, P.out + (size_t)half * TH * DM, (bf16_t*)(ws + WS_H) + (size_t)half * TH * DM,
                                        P.post_mix_g + (size_t)l * DM, P.pre_ffn_g + (size_t)l * DM,
                                        (unsigned*)(ws + WS_XS) + (size_t)(inst * 2) * TH * 4, (unsigned*)(ws + WS_XS) + (size_t)(inst * 2 + 1) * TH * 4,
                                        (unsigned*)(ws + WS_CTL) + 4608 + (inst * 2) * 256, (unsigned*)(ws + WS_CTL) + 4608 + (inst * 2 + 1) * 256};
                      pg8::gemm_phase(lds, g, S, E);
                      if (half == 0) phase_norm_alow(P, l, 1, lds);
                  } else { pg8::Gemm g{(const bf16_t*)(ws + WS_MG), (const bf16_t*)(ws + WS_WMO), 1024, 1024, 1024, 0, 0}; pg8::Order S; S.init(TH, 1024, gridDim.x, blockIdx.x, 1);
                      pg8::EpiSplit E{(bf16_t*)(ws + WS_Y), 1024, (bf16_t*)(ws + WS_Y), 1024, 1 << 20, nullptr}; pg8::gemm_phase(lds, g, S, E); } break;
        case 7: if (!fuse) { phase_resid((l == 0 ? P.x : P.out) + (size_t)half * TH * DM, P.out + (size_t)half * TH * DM, (const bf16_t*)(ws + WS_Y), P.post_mix_g + (size_t)l * DM, P.pre_ffn_g + (size_t)l * DM,
                            (bf16_t*)(ws + WS_H) + (size_t)half * TH * DM, TH);
                if (half == 0) phase_norm_alow(P, l, 1, lds); }
                break;
        case 8: { pg8::Gemm g{(const bf16_t*)(ws + WS_H), (const bf16_t*)(ws + WS_WFF), 1024, 1024, 1024, 0, 0}; pg8::Order S; S.init(T_ALL, 5632, gridDim.x, blockIdx.x, 1);
                  pg8::EpiFFN E{(bf16_t*)(ws + WS_U), (float*)(ws + WS_HG), (float*)(ws + WS_HU), P.ff_conv_w + (size_t)l * 3 * FF, P.ff_conv_b + (size_t)l * FF, lds + pg8::STAGE_BYTES};
                  pg8::gemm_phase(lds, g, S, E); } break;
        case 9: phase_ffn_fix(P, l); break;
        case 10: { pg8::Gemm g{(const bf16_t*)(ws + WS_U), (const bf16_t*)(ws + WS_WD), FF, FF, FF, 0, 0}; pg8::Order S; S.init(T_ALL, 1024, gridDim.x, blockIdx.x, 1);
                   pg8::EpiSplit E{(bf16_t*)(ws + WS_Y2), 1024, (bf16_t*)(ws + WS_Y2), 1024, 1 << 20, nullptr}; pg8::gemm_phase(lds, g, S, E); } break;
        default: phase_resid(P.out, P.out, (const bf16_t*)(ws + WS_Y2), P.post_ffn_g + (size_t)l * DM, nullptr, nullptr, T_ALL);
                 if (l == 0) { phase_convert(P, 1, lds); phase_norm_alow(P, 1, 0, lds); }
                 break;
        }
        const bool empty = (k == 0 && l == 1) || (k == 1) || (k == 7 && fuse);
        if (ph + 1 < hi && !empty) { if (hi < lo) grid.sync(); else xcd_barrier(xb); }
    }
}

constexpr int N_PHASES = 2 * (1 + 2 * 7 + 4);

#ifndef MULTI_LAUNCH
#define MULTI_LAUNCH 0
#endif

extern "C" void kernel_launch(void* const* d_in, const int* in_sizes, int n_in, void* d_out, int out_size, void* d_ws, size_t ws_size, hipStream_t stream) {
    static int grid = 0;
    if (grid == 0) {
        if (n_in != 20 || ws_size < WS_END) { fprintf(stderr, "kernel_launch: unexpected n_in %d / ws_size %zu (need %zu)\n", n_in, ws_size, (size_t)WS_END); grid = -1; return; }
        int dev = 0, cus = 0, per_cu = 0;
        hipGetDevice(&dev); hipDeviceGetAttribute(&cus, hipDeviceAttributeMultiprocessorCount, dev);
        if (hipFuncSetAttribute((const void*)fwd_kernel, hipFuncAttributeMaxDynamicSharedMemorySize, LDS_BYTES) != hipSuccess) { fprintf(stderr, "kernel_launch: hipFuncSetAttribute failed\n"); grid = -1; return; }
        if (hipOccupancyMaxActiveBlocksPerMultiprocessor(&per_cu, (const void*)fwd_kernel, NTHR, LDS_BYTES) != hipSuccess || per_cu < 1) per_cu = 1;
        (void)hipGetLastError();
        grid = cus * per_cu;
        if (grid > 256) grid = 256;
    }
    if (grid < 0) return;
    hipMemsetAsync((char*)d_ws + WS_CTL, 0, 32768, stream);
    Params p{};
    p.x = (const float*)d_in[0]; p.pos = (const int*)d_in[1]; p.w_in = (const float*)d_in[2]; p.w_alpha_up = (const float*)d_in[3]; p.b_alpha = (const float*)d_in[4];
    p.gla_norm_g = (const float*)d_in[5]; p.sc_conv_w = (const float*)d_in[6]; p.w_gate = (const float*)d_in[7]; p.b_gate = (const float*)d_in[8]; p.w_branch = (const float*)d_in[9];
    p.w_mix_out = (const float*)d_in[10]; p.pre_mix_g = (const float*)d_in[11]; p.post_mix_g = (const float*)d_in[12]; p.pre_ffn_g = (const float*)d_in[13]; p.post_ffn_g = (const float*)d_in[14];
    p.w_ff_gate = (const float*)d_in[15]; p.w_ff_up = (const float*)d_in[16]; p.ff_conv_w = (const float*)d_in[17]; p.ff_conv_b = (const float*)d_in[18]; p.w_ff_down = (const float*)d_in[19];
    p.out = (float*)d_out; p.ws = (unsigned char*)d_ws;
#if MULTI_LAUNCH
    for (int ph = 0; ph < N_PHASES; ++ph) { p.ph_lo = ph; p.ph_hi = ph + 1; hipLaunchKernelGGL(fwd_kernel, dim3(grid), dim3(NTHR), LDS_BYTES, stream, p); }
#else
    p.ph_lo = 0; p.ph_hi = N_PHASES;
    void* args[] = {&p};
    hipError_t e = hipLaunchCooperativeKernel((const void*)fwd_kernel, dim3(grid), dim3(NTHR), args, LDS_BYTES, stream);
    if (e != hipSuccess) fprintf(stderr, "cooperative launch failed: %s (grid %d)\n", hipGetErrorString(e), grid);
#endif
}
```
